# Optimizing an MI355X kernel written in HIP

```python
import math
import jax
import jax.numpy as jnp
from jax import lax
import numpy as np


D_MODEL = 1024
BATCH = 8
SEQ = 2048
DEPTH = 1
DEC_BATCH = 128
DEC_SEQ = 8
PAST_LEN = 16384
PAGE_SIZE = 128

HEAD_DIM = 128
DN_HEADS = D_MODEL // (2 * HEAD_DIM)
RET_HEADS = D_MODEL // (2 * HEAD_DIM)
DN_DK = HEAD_DIM
DN_DV = HEAD_DIM
RET_DK = HEAD_DIM
RET_DV = HEAD_DIM
DN_QK = DN_HEADS * DN_DK
DN_VD = DN_HEADS * DN_DV
RET_QK = RET_HEADS * RET_DK
RET_VD = RET_HEADS * RET_DV
D_IN = 3 * DN_QK + DN_VD + 2 * DN_HEADS + 2 * RET_QK + 2 * RET_VD
D_MIX = DN_VD + RET_VD
DN_CONV = 4
FFN_CONV = 3
D_FF = 2816
PLE_DIM = 256
CHUNK = 64
ROPE_BASE = 10000.0
EPS = 1e-6

kernel_name = 'hymba_gdn_retnet_convffn_step'


def _rmsnorm(x, w):
    xf = x.astype(jnp.float32)
    y = xf * lax.rsqrt(jnp.mean(xf * xf, axis=-1, keepdims=True) + EPS)
    return y * w.astype(jnp.float32)


def _l2norm(x):
    xf = x.astype(jnp.float32)
    return xf * lax.rsqrt(jnp.sum(xf * xf, axis=-1, keepdims=True) + EPS)


def _chunk_len(L):
    return CHUNK if L % CHUNK == 0 else L


def _causal_dwconv(x, buf, w):
    W = w.shape[0]
    L = x.shape[1]
    xp = jnp.concatenate([buf.astype(x.dtype), x], axis=1)
    y = xp[:, 0:L] * w[0]
    for j in range(1, W):
        y = y + xp[:, j:j + L] * w[j]
    return y, xp[:, -(W - 1):]


def _rotary(x, pos):
    d = x.shape[-1]
    inv = ROPE_BASE ** (-jnp.arange(0, d, 2, dtype=jnp.float32) / d)
    ang = pos.astype(jnp.float32)[:, None] * inv[None, :]
    cos = jnp.cos(ang)[None, :, None, :]
    sin = jnp.sin(ang)[None, :, None, :]
    xf = x.astype(jnp.float32)
    x1 = xf[..., 0::2]
    x2 = xf[..., 1::2]
    return jnp.stack([x1 * cos - x2 * sin, x1 * sin + x2 * cos], axis=-1).reshape(x.shape)


def _to_blocks(t, N, C):
    B, L, H, d = t.shape
    return t.reshape(B, N, C, H, d).transpose(0, 3, 1, 2, 4)


def _from_blocks(o):
    N, B, H, C, d = o.shape
    return o.transpose(1, 0, 3, 2, 4).reshape(B, N * C, H, d)


def _gated_delta_chunked(q, k, v, g, beta, S0):
    B, L, H, dk = q.shape
    dv = v.shape[-1]
    C = _chunk_len(L)
    N = L // C
    qb = _to_blocks(q, N, C) * (dk ** -0.5)
    kb = _to_blocks(k, N, C)
    vb = _to_blocks(v.astype(jnp.float32), N, C)
    gb = g.reshape(B, N, C, H).transpose(0, 3, 1, 2)
    bb = beta.reshape(B, N, C, H).transpose(0, 3, 1, 2)
    gc = jnp.cumsum(gb, axis=-1)
    causal = jnp.tril(jnp.ones((C, C), dtype=bool))
    strict = jnp.tril(jnp.ones((C, C), dtype=bool), -1)
    decay = jnp.exp(jnp.where(causal, gc[..., :, None] - gc[..., None, :], -jnp.inf))
    k_beta = kb * bb[..., None]
    A = jnp.where(strict, jnp.einsum('bhncd,bhnmd->bhncm', k_beta, kb) * decay, 0.0)
    T = A + jnp.eye(C, dtype=jnp.float32)
    rhs = jnp.concatenate([vb * bb[..., None], k_beta * jnp.exp(gc)[..., None]], axis=-1)
    sol = lax.linalg.triangular_solve(T, rhs, left_side=True, lower=True, unit_diagonal=True)
    u = sol[..., :dv]
    w = sol[..., dv:]
    qk = jnp.einsum('bhncd,bhnmd->bhncm', qb, kb) * decay
    q_dec = qb * jnp.exp(gc)[..., None]
    g_last = gc[..., -1]
    k_tail = kb * jnp.exp(g_last[..., None] - gc)[..., None]
    mv = lambda t: jnp.moveaxis(t, 2, 0)

    def step(S, xs):
        u_i, w_i, qk_i, qd_i, kt_i, gl_i = xs
        v_new = u_i - jnp.einsum('bhcd,bhde->bhce', w_i, S)
        o = jnp.einsum('bhcd,bhde->bhce', qd_i, S) + jnp.einsum('bhcm,bhme->bhce', qk_i, v_new)
        S = S * jnp.exp(gl_i)[..., None, None] + jnp.einsum('bhcd,bhce->bhde', kt_i, v_new)
        return S, o

    S, o = lax.scan(step, S0.astype(jnp.float32),
                    (mv(u), mv(w), mv(qk), mv(q_dec), mv(k_tail), jnp.moveaxis(g_last, 2, 0)))
    return _from_blocks(o), S


def _retention_chunked(q, k, v, R0):
    B, L, H, dk = q.shape
    C = _chunk_len(L)
    N = L // C
    log_gamma = jnp.log(1.0 - 2.0 ** (-5.0 - jnp.arange(H, dtype=jnp.float32)))
    bpos = (jnp.arange(C, dtype=jnp.float32) + 1.0)[None, :] * log_gamma[:, None]
    causal = jnp.tril(jnp.ones((C, C), dtype=bool))
    D = jnp.exp(jnp.where(causal, bpos[:, :, None] - bpos[:, None, :], -jnp.inf))
    qb = _to_blocks(q, N, C)
    kb = _to_blocks(k, N, C) * (dk ** -0.5)
    vb = _to_blocks(v.astype(jnp.float32), N, C)
    qk = jnp.einsum('bhncd,bhnmd->bhncm', qb, kb) * D[None, :, None]
    o_intra = jnp.einsum('bhncm,bhnme->bhnce', qk, vb)
    q_dec = qb * jnp.exp(bpos)[None, :, None, :, None]
    k_tail = kb * jnp.exp(bpos[:, -1:] - bpos)[None, :, None, :, None]
    chunk_decay = jnp.exp(bpos[:, -1])
    mv = lambda t: jnp.moveaxis(t, 2, 0)

    def step(R, xs):
        oi, qd, kt, vi = xs
        o = oi + jnp.einsum('bhcd,bhde->bhce', qd, R)
        R = R * chunk_decay[None, :, None, None] + jnp.einsum('bhcd,bhce->bhde', kt, vi)
        return R, o

    R, o = lax.scan(step, R0.astype(jnp.float32), (mv(o_intra), mv(q_dec), mv(k_tail), mv(vb)))
    return _from_blocks(o), R


def _split_points():
    sizes = [3 * DN_QK, DN_VD, DN_HEADS, DN_HEADS, RET_QK, RET_QK, RET_VD, RET_VD]
    return [int(s) for s in np.cumsum(sizes)[:-1]]


def _layer(h, p, conv_buf, S_dn, R_ret, ffn_buf, pos0, attn_norm_w, w_in, dn_conv_w,
           dn_A_log, dn_dt_bias, dn_norm_w, ret_norm_w, w_out, ffn_norm_w, w_up,
           ffn_conv_w, ffn_conv_b, w_down, ple_norm_w, w_ple_gate, w_ple):
    B, L, _ = h.shape
    dt = h.dtype
    a = _rmsnorm(h, attn_norm_w).astype(dt)
    proj = a @ w_in
    dn_qkv, dn_z, dn_b, dn_a, r_q, r_k, r_v, r_g = jnp.split(proj, _split_points(), axis=-1)
    qkv, conv_new = _causal_dwconv(dn_qkv, conv_buf, dn_conv_w)
    qkv = jax.nn.silu(qkv.astype(jnp.float32))
    q, k, v = jnp.split(qkv, [DN_QK, 2 * DN_QK], axis=-1)
    q = _l2norm(q.reshape(B, L, DN_HEADS, DN_DK))
    k = _l2norm(k.reshape(B, L, DN_HEADS, DN_DK))
    v = v.reshape(B, L, DN_HEADS, DN_DV)
    beta = jax.nn.sigmoid(dn_b.astype(jnp.float32))
    g = -jnp.exp(dn_A_log.astype(jnp.float32)) * jax.nn.softplus(
        dn_a.astype(jnp.float32) + dn_dt_bias.astype(jnp.float32))
    o_dn, S_new = _gated_delta_chunked(q, k, v, g, beta, S_dn)
    o_dn = _rmsnorm(o_dn, dn_norm_w) * jax.nn.silu(
        dn_z.astype(jnp.float32).reshape(B, L, DN_HEADS, DN_DV))
    pos = pos0 + jnp.arange(L)
    rq = _rotary(r_q.reshape(B, L, RET_HEADS, RET_DK), pos)
    rk = _rotary(r_k.reshape(B, L, RET_HEADS, RET_DK), pos)
    rv = r_v.reshape(B, L, RET_HEADS, RET_DV)
    o_ret, R_new = _retention_chunked(rq, rk, rv, R_ret)
    mu = jnp.mean(o_ret, axis=-1, keepdims=True)
    var = jnp.mean(jnp.square(o_ret - mu), axis=-1, keepdims=True)
    o_ret = (o_ret - mu) * lax.rsqrt(var + EPS) * ret_norm_w.astype(jnp.float32).reshape(RET_HEADS, RET_DV)
    o_ret = o_ret * jax.nn.silu(r_g.astype(jnp.float32).reshape(B, L, RET_HEADS, RET_DV))
    mix = jnp.concatenate([o_dn.reshape(B, L, DN_VD), o_ret.reshape(B, L, RET_VD)], axis=-1).astype(dt)
    h = h + mix @ w_out
    m = _rmsnorm(h, ffn_norm_w).astype(dt)
    u, ffn_new = _causal_dwconv(m @ w_up, ffn_buf, ffn_conv_w)
    u = u + ffn_conv_b
    ug, uv = jnp.split(u, 2, axis=-1)
    h = h + (jax.nn.silu(ug) * uv) @ w_down
    gate = jax.nn.sigmoid((_rmsnorm(h, ple_norm_w).astype(dt) @ w_ple_gate).astype(jnp.float32))
    h = h + (gate * (p @ w_ple).astype(jnp.float32)).astype(dt)
    return (h, conv_new.astype(dt), S_new.astype(dt), R_new.astype(dt), ffn_new.astype(dt))


def setup_inputs(seed: int = 0) -> dict:
    key = jax.random.key(seed)
    ks = jax.random.split(key, 32)
    f32 = jnp.float32
    nrm = lambda k, shape, s: jax.random.normal(k, shape, f32) * s
    gain = lambda k, shape: 1.0 + 0.05 * jax.random.normal(k, shape, f32)
    return {
        'x_prompt': nrm(ks[0], (BATCH, SEQ, D_MODEL), 1.0),
        'x_sample': nrm(ks[1], (DEC_BATCH, DEC_SEQ, D_MODEL), 1.0),
        'p_prompt': nrm(ks[2], (DEPTH, BATCH, SEQ, PLE_DIM), 1.0),
        'p_sample': nrm(ks[3], (DEPTH, DEC_BATCH, DEC_SEQ, PLE_DIM), 1.0),
        'state_dn_conv': nrm(ks[4], (DEPTH, DEC_BATCH, DN_CONV - 1, 3 * DN_QK), 1.0),
        'state_dn': nrm(ks[5], (DEPTH, DEC_BATCH, DN_HEADS, DN_DK, DN_DV), 0.1),
        'state_ret': nrm(ks[6], (DEPTH, DEC_BATCH, RET_HEADS, RET_DK, RET_DV), 0.5),
        'state_ffn_conv': nrm(ks[7], (DEPTH, DEC_BATCH, FFN_CONV - 1, 2 * D_FF), 1.0),
        'attn_norm_w': gain(ks[8], (DEPTH, D_MODEL)),
        'w_in': nrm(ks[9], (DEPTH, D_MODEL, D_IN), D_MODEL ** -0.5),
        'dn_conv_w': nrm(ks[10], (DEPTH, DN_CONV, 3 * DN_QK), DN_CONV ** -0.5),
        'dn_A_log': jnp.log(jax.random.uniform(ks[11], (DEPTH, DN_HEADS), f32, 1.0, 16.0)),
        'dn_dt_bias': nrm(ks[12], (DEPTH, DN_HEADS), 0.1),
        'dn_norm_w': gain(ks[13], (DEPTH, DN_DV)),
        'ret_norm_w': gain(ks[14], (DEPTH, RET_VD)),
        'w_out': nrm(ks[15], (DEPTH, D_MIX, D_MODEL), D_MIX ** -0.5),
        'ffn_norm_w': gain(ks[16], (DEPTH, D_MODEL)),
        'w_up': nrm(ks[17], (DEPTH, D_MODEL, 2 * D_FF), D_MODEL ** -0.5),
        'ffn_conv_w': nrm(ks[18], (DEPTH, FFN_CONV, 2 * D_FF), FFN_CONV ** -0.5),
        'ffn_conv_b': nrm(ks[19], (DEPTH, 2 * D_FF), 0.02),
        'w_down': nrm(ks[20], (DEPTH, D_FF, D_MODEL), D_FF ** -0.5),
        'ple_norm_w': gain(ks[21], (DEPTH, D_MODEL)),
        'w_ple_gate': nrm(ks[22], (DEPTH, D_MODEL, D_MODEL), D_MODEL ** -0.5),
        'w_ple': nrm(ks[23], (DEPTH, PLE_DIM, D_MODEL), PLE_DIM ** -0.5),
        'final_norm_w': gain(ks[24], (D_MODEL,)),
    }


def reference(x_prompt, x_sample, p_prompt, p_sample, state_dn_conv, state_dn, state_ret,
              state_ffn_conv, attn_norm_w, w_in, dn_conv_w, dn_A_log, dn_dt_bias, dn_norm_w,
              ret_norm_w, w_out, ffn_norm_w, w_up, ffn_conv_w, ffn_conv_b, w_down, ple_norm_w,
              w_ple_gate, w_ple, final_norm_w):
    dt = x_prompt.dtype
    Bp = x_prompt.shape[0]
    hp = x_prompt
    hs = x_sample
    outs_p = ([], [], [], [])
    outs_s = ([], [], [], [])
    for i in range(DEPTH):
        wts = (attn_norm_w[i], w_in[i], dn_conv_w[i], dn_A_log[i], dn_dt_bias[i], dn_norm_w[i],
               ret_norm_w[i], w_out[i], ffn_norm_w[i], w_up[i], ffn_conv_w[i], ffn_conv_b[i],
               w_down[i], ple_norm_w[i], w_ple_gate[i], w_ple[i])
        zc = jnp.zeros((Bp, DN_CONV - 1, 3 * DN_QK), dt)
        zs = jnp.zeros((Bp, DN_HEADS, DN_DK, DN_DV), jnp.float32)
        zr = jnp.zeros((Bp, RET_HEADS, RET_DK, RET_DV), jnp.float32)
        zf = jnp.zeros((Bp, FFN_CONV - 1, 2 * D_FF), dt)
        hp, c1, s1, r1, f1 = _layer(hp, p_prompt[i], zc, zs, zr, zf, 0, *wts)
        hs, c2, s2, r2, f2 = _layer(hs, p_sample[i], state_dn_conv[i], state_dn[i], state_ret[i],
                                    state_ffn_conv[i], PAST_LEN, *wts)
        for lst, val in zip(outs_p, (c1, s1, r1, f1)):
            lst.append(val)
        for lst, val in zip(outs_s, (c2, s2, r2, f2)):
            lst.append(val)
    y_prompt = _rmsnorm(hp, final_norm_w).astype(dt)
    y_sample = _rmsnorm(hs, final_norm_w).astype(dt)
    return (y_prompt, y_sample,
            jnp.stack(outs_p[0]), jnp.stack(outs_p[1]), jnp.stack(outs_p[2]), jnp.stack(outs_p[3]),
            jnp.stack(outs_s[0]), jnp.stack(outs_s[1]), jnp.stack(outs_s[2]), jnp.stack(outs_s[3]))
```

```cpp
#include <hip/hip_runtime.h>
#include <stdint.h>
#include <stdio.h>

typedef unsigned short bf16;
constexpr int TP = 16384, TS = 1024, T = TP + TS;
constexpr int D = 1024, NPROJ = 4096, DFF = 2816, NUP = 5632, PLE = 256;
constexpr int SEQ = 2048, DSEQ = 8, NB = 8, NSB = 128;
constexpr float EPS = 1e-6f;

constexpr size_t O_Y = 0, O_DNCONV_P = 17825792, O_DN_P = 17862656, O_RET_P = 18386944, O_FFN_P = 18911232,
                 O_DNCONV_S = 19001344, O_DN_S = 19591168, O_RET_S = 27979776, O_FFN_S = 36368384;
constexpr size_t W_NB = 0, W_BIG = 36700160, W_ACT = 141557760, W_SMALL = 240123904;
constexpr size_t W_GB = W_SMALL, W_TRIG = W_SMALL + (1u << 20);

__device__ __forceinline__ float bf2f(bf16 v) { return __uint_as_float(((unsigned)v) << 16); }
__device__ __forceinline__ bf16 f2bf(float f) { unsigned u = __float_as_uint(f); return (bf16)((u + 0x7fffu + ((u >> 16) & 1u)) >> 16); }
__device__ __forceinline__ float silu_f(float x) { return x / (1.f + __expf(-x)); }
__device__ __forceinline__ float sigmoid_f(float x) { return 1.f / (1.f + __expf(-x)); }
__device__ __forceinline__ float wave_sum(float v) {
#pragma unroll
    for (int o = 1; o < 64; o <<= 1) v += __shfl_xor(v, o);
    return v;
}
__device__ __forceinline__ int proj_orig_col(int n) {
    if (n < 1536) return n;
    if (n < 3072) return 2056 + (n - 1536);
    if (n < 3584) return 1536 + (n - 3072);
    return 3592 + (n - 3584);
}
__device__ __forceinline__ int up_orig_col(int n) { const int t = n >> 8, half = (n >> 7) & 1, j = n & 127; return half * DFF + 128 * t + j; }

template <int MODE>
__global__ void __launch_bounds__(256) k_rows_norm(const float* xp, const float* xs, const float* w, bf16* out,
                                                   const float* w_in, const float* A_log, const float* dt_bias, float* gb) {
    const int lane = threadIdx.x & 63, row = blockIdx.x * 4 + (threadIdx.x >> 6);
    if (row >= T) return;
    const float* x = (MODE == 0) ? (row < TP ? xp + (size_t)row * D : xs + (size_t)(row - TP) * D) : xp + (size_t)row * D;
    float v[16]; float s = 0.f;
#pragma unroll
    for (int j = 0; j < 4; ++j) { const float4 t = *(const float4*)(x + 4 * lane + 256 * j); v[4 * j] = t.x; v[4 * j + 1] = t.y; v[4 * j + 2] = t.z; v[4 * j + 3] = t.w; s += t.x * t.x + t.y * t.y + t.z * t.z + t.w * t.w; }
    s = wave_sum(s);
    const float rstd = rsqrtf(s * (1.f / D) + EPS);
#pragma unroll
    for (int j = 0; j < 4; ++j) {
        const float4 ww = *(const float4*)(w + 4 * lane + 256 * j);
        v[4 * j] *= rstd * ww.x; v[4 * j + 1] *= rstd * ww.y; v[4 * j + 2] *= rstd * ww.z; v[4 * j + 3] *= rstd * ww.w;
        ushort4 o; o.x = f2bf(v[4 * j]); o.y = f2bf(v[4 * j + 1]); o.z = f2bf(v[4 * j + 2]); o.w = f2bf(v[4 * j + 3]);
        *(ushort4*)(out + (size_t)row * D + 4 * lane + 256 * j) = o;
    }
    if (MODE == 0) {
        float acc[8];
#pragma unroll
        for (int c = 0; c < 8; ++c) acc[c] = 0.f;
#pragma unroll
        for (int j = 0; j < 4; ++j)
#pragma unroll
            for (int e = 0; e < 4; ++e) { const int k = 4 * lane + 256 * j + e; const float* wr = w_in + (size_t)k * 4104 + 2048;
#pragma unroll
                for (int c = 0; c < 8; ++c) acc[c] += v[4 * j + e] * wr[c]; }
#pragma unroll
        for (int c = 0; c < 8; ++c) acc[c] = wave_sum(acc[c]);
        if (lane < 4) gb[(size_t)row * 8 + lane] = sigmoid_f(acc[lane]);
        else if (lane < 8) { const int h = lane - 4; const float xx = acc[lane] + dt_bias[h]; const float sp = (xx > 20.f) ? xx : log1pf(__expf(xx)); gb[(size_t)row * 8 + lane] = -__expf(A_log[h]) * sp; }
    }
}

__global__ void k_trig(float2* trig) {
    const int idx = blockIdx.x * blockDim.x + threadIdx.x;
    if (idx >= 2056 * 64) return;
    const int pi = idx >> 6, i = idx & 63;
    const int pos = pi < 2048 ? pi : 16384 + (pi - 2048);
    const float invf = (float)exp2(-(double)i * (2.0 / 128.0) * 13.287712379549449);
    const double a = (double)pos * (double)invf;
    const double rev = a * 0.15915494309189535;
    const double fr = rev - rint(rev);
    trig[idx] = make_float2(__builtin_amdgcn_cosf((float)fr), __builtin_amdgcn_sinf((float)fr));
}

__global__ void k_cvt_p(const float* pp, const float* ps, bf16* pb) {
    const size_t i = (size_t)blockIdx.x * blockDim.x + threadIdx.x;
    if (i >= (size_t)T * PLE) return;
    const size_t np = (size_t)TP * PLE;
    pb[i] = f2bf(i < np ? pp[i] : ps[i - np]);
}

template <int EPI, int CMAP>
__global__ void __launch_bounds__(256) k_gemm(const bf16* A, const float* W, bf16* Cb, float* hf, const float* xp, const float* xs, const bf16* pe,
                                              int lda, int ldw, int K, int N, int row0, int nrows, int ldc, int crow0) {
    __shared__ float As[16][68];
    __shared__ float Bs[16][68];
    const int tid = threadIdx.x, tx = tid & 15, ty = tid >> 4;
    const int bm = blockIdx.y * 64 + row0, bn = blockIdx.x * 64;
    float acc[4][4];
#pragma unroll
    for (int i = 0; i < 4; ++i)
#pragma unroll
        for (int j = 0; j < 4; ++j) acc[i][j] = 0.f;
    const int ar = tid >> 2, ak = (tid & 3) * 4;
    const int bk = tid >> 4, bc = (tid & 15) * 4;
    for (int k0 = 0; k0 < K; k0 += 16) {
        {
            const ushort4 a4 = *(const ushort4*)(A + (size_t)(bm + ar) * lda + k0 + ak);
            As[ak][ar] = bf2f(a4.x); As[ak + 1][ar] = bf2f(a4.y); As[ak + 2][ar] = bf2f(a4.z); As[ak + 3][ar] = bf2f(a4.w);
#pragma unroll
            for (int e = 0; e < 4; ++e) { const int n = bn + bc + e; const int oc = CMAP == 1 ? proj_orig_col(n) : (CMAP == 2 ? up_orig_col(n) : n);
                Bs[bk][bc + e] = W[(size_t)(k0 + bk) * ldw + oc]; }
        }
        __syncthreads();
#pragma unroll
        for (int kk = 0; kk < 16; ++kk) {
            const float4 av = *(const float4*)&As[kk][ty * 4]; const float4 bv = *(const float4*)&Bs[kk][tx * 4];
            const float a_[4] = {av.x, av.y, av.z, av.w}, b_[4] = {bv.x, bv.y, bv.z, bv.w};
#pragma unroll
            for (int i = 0; i < 4; ++i)
#pragma unroll
                for (int j = 0; j < 4; ++j) acc[i][j] += a_[i] * b_[j];
        }
        __syncthreads();
    }
#pragma unroll
    for (int i = 0; i < 4; ++i) {
        const int row = bm + ty * 4 + i;
#pragma unroll
        for (int j = 0; j < 4; ++j) {
            const int col = bn + tx * 4 + j;
            if (EPI == 0) Cb[(size_t)(row - crow0) * ldc + col] = f2bf(acc[i][j]);
            else if (EPI == 1) { const float base = xs ? (row < TP ? xp[(size_t)row * D + col] : xs[(size_t)(row - TP) * D + col]) : hf[(size_t)row * D + col];
                hf[(size_t)row * D + col] = base + acc[i][j]; }
            else { const float h = hf[(size_t)row * D + col]; hf[(size_t)row * D + col] = h + sigmoid_f(acc[i][j]) * bf2f(pe[(size_t)row * D + col]); }
        }
    }
}

__device__ __forceinline__ float block_sum128(float v, float* red) {
    v = wave_sum(v);
    __syncthreads();
    if ((threadIdx.x & 63) == 0) red[threadIdx.x >> 6] = v;
    __syncthreads();
    return red[0] + red[1];
}
__global__ void __launch_bounds__(128) k_dn(bf16* proj, const float* gb, const float* conv_w, const float* dn_norm_w,
                                            const float* st_conv, const float* st_dn, float* out) {
    __shared__ float qs[128], ks[128], red[2];
    const int seq = blockIdx.x >> 2, h = blockIdx.x & 3, j = threadIdx.x;
    const bool prompt = seq < NB; const int b = prompt ? seq : seq - NB;
    const int L = prompt ? SEQ : DSEQ; const size_t row0 = prompt ? (size_t)b * SEQ : (size_t)TP + (size_t)b * DSEQ;
    float S[128];
    if (prompt) {
#pragma unroll
        for (int d = 0; d < 128; ++d) S[d] = 0.f;
    } else {
#pragma unroll
        for (int d = 0; d < 128; ++d) S[d] = st_dn[((size_t)(b * 4 + h) * 128 + d) * 128 + j];
    }
    const int cq = h * 128 + j, ck = 512 + h * 128 + j, cv = 1024 + h * 128 + j;
    float wq[4], wk[4], wv[4], xq[3], xk[3], xv[3];
#pragma unroll
    for (int i = 0; i < 4; ++i) { wq[i] = conv_w[i * 1536 + cq]; wk[i] = conv_w[i * 1536 + ck]; wv[i] = conv_w[i * 1536 + cv]; }
#pragma unroll
    for (int i = 0; i < 3; ++i) {
        xq[i] = prompt ? 0.f : st_conv[((size_t)b * 3 + i) * 1536 + cq];
        xk[i] = prompt ? 0.f : st_conv[((size_t)b * 3 + i) * 1536 + ck];
        xv[i] = prompt ? 0.f : st_conv[((size_t)b * 3 + i) * 1536 + cv];
    }
    const float nw = dn_norm_w[j];
    for (int t = 0; t < L; ++t) {
        const size_t row = row0 + t; bf16* pr = proj + row * NPROJ;
        const float pq = bf2f(pr[cq]), pk = bf2f(pr[ck]), pv = bf2f(pr[cv]);
        const float q0 = silu_f(wq[0] * xq[0] + wq[1] * xq[1] + wq[2] * xq[2] + wq[3] * pq);
        const float k0 = silu_f(wk[0] * xk[0] + wk[1] * xk[1] + wk[2] * xk[2] + wk[3] * pk);
        const float v0 = silu_f(wv[0] * xv[0] + wv[1] * xv[1] + wv[2] * xv[2] + wv[3] * pv);
        xq[0] = xq[1]; xq[1] = xq[2]; xq[2] = pq; xk[0] = xk[1]; xk[1] = xk[2]; xk[2] = pk; xv[0] = xv[1]; xv[1] = xv[2]; xv[2] = pv;
        const float sq = block_sum128(q0 * q0, red), sk = block_sum128(k0 * k0, red);
        qs[j] = q0 * rsqrtf(sq + EPS) * 0.08838834764831845f; ks[j] = k0 * rsqrtf(sk + EPS);
        __syncthreads();
        const float beta = gb[row * 8 + h], a = __expf(gb[row * 8 + 4 + h]);
        float kS = 0.f;
#pragma unroll
        for (int d = 0; d < 128; ++d) kS += ks[d] * S[d];
        const float delta = beta * (v0 - a * kS);
        float o = 0.f;
#pragma unroll
        for (int d = 0; d < 128; ++d) { S[d] = a * S[d] + ks[d] * delta; o += S[d] * qs[d]; }
        const float so = block_sum128(o * o, red);
        const float z = bf2f(pr[3072 + h * 128 + j]);
        pr[3072 + h * 128 + j] = f2bf(o * rsqrtf(so * (1.f / 128.f) + EPS) * nw * silu_f(z));
    }
    float* so_ = out + (prompt ? O_DN_P : O_DN_S) + (size_t)(b * 4 + h) * 16384;
#pragma unroll
    for (int d = 0; d < 128; ++d) so_[d * 128 + j] = S[d];
    float* co = out + (prompt ? O_DNCONV_P : O_DNCONV_S) + (size_t)b * 3 * 1536;
#pragma unroll
    for (int i = 0; i < 3; ++i) { co[i * 1536 + cq] = xq[i]; co[i * 1536 + ck] = xk[i]; co[i * 1536 + cv] = xv[i]; }
}

__global__ void __launch_bounds__(128) k_ret(bf16* proj, const float2* trig, const float* ret_norm_w, const float* st_ret, float* out) {
    __shared__ float qs[128], ks[128], red[2];
    const int seq = blockIdx.x >> 2, h = blockIdx.x & 3, j = threadIdx.x;
    const bool prompt = seq < NB; const int b = prompt ? seq : seq - NB;
    const int L = prompt ? SEQ : DSEQ; const size_t row0 = prompt ? (size_t)b * SEQ : (size_t)TP + (size_t)b * DSEQ;
    float R[128];
    if (prompt) {
#pragma unroll
        for (int d = 0; d < 128; ++d) R[d] = 0.f;
    } else {
#pragma unroll
        for (int d = 0; d < 128; ++d) R[d] = st_ret[((size_t)(b * 4 + h) * 128 + d) * 128 + j];
    }
    const float gamma = 1.f - exp2f(-5.f - (float)h);
    const float nw = ret_norm_w[h * 128 + j];
    const int cq = 1536 + h * 128 + j, ck = 2048 + h * 128 + j, cv = 2560 + h * 128 + j, cg = 3584 + h * 128 + j;
    for (int t = 0; t < L; ++t) {
        const size_t row = row0 + t; bf16* pr = proj + row * NPROJ;
        const float q = bf2f(pr[cq]), k = bf2f(pr[ck]), v = bf2f(pr[cv]);
        __syncthreads();
        qs[j] = q; ks[j] = k;
        __syncthreads();
        const float2 cs = trig[(size_t)((prompt ? 0 : 2048) + t) * 64 + (j >> 1)];
        const float qp = qs[j ^ 1], kp = ks[j ^ 1];
        const float qr = (j & 1) ? (qp * cs.y + q * cs.x) : (q * cs.x - qp * cs.y);
        const float kr = ((j & 1) ? (kp * cs.y + k * cs.x) : (k * cs.x - kp * cs.y)) * 0.08838834764831845f;
        __syncthreads();
        qs[j] = qr; ks[j] = kr;
        __syncthreads();
        float o = 0.f;
#pragma unroll
        for (int d = 0; d < 128; ++d) { R[d] = gamma * R[d] + ks[d] * v; o += qs[d] * R[d]; }
        const float mu = block_sum128(o, red) * (1.f / 128.f);
        const float dlt = o - mu;
        const float var = block_sum128(dlt * dlt, red) * (1.f / 128.f);
        const float g = bf2f(pr[cg]);
        pr[cg] = f2bf(dlt * rsqrtf(var + EPS) * nw * silu_f(g));
    }
    float* so_ = out + (prompt ? O_RET_P : O_RET_S) + (size_t)(b * 4 + h) * 16384;
#pragma unroll
    for (int d = 0; d < 128; ++d) so_[d * 128 + j] = R[d];
}

__global__ void k_act(const bf16* u, const float* cw, const float* cb, const float* st_ffn, bf16* act, float* out, int row0, int nrows) {
    const size_t idx = (size_t)blockIdx.x * blockDim.x + threadIdx.x;
    if (idx >= (size_t)nrows * DFF) return;
    const int lr = (int)(idx / DFF), ch = (int)(idx % DFF), row = row0 + lr;
    const bool prompt = row < TP; const int b = prompt ? row / SEQ : (row - TP) / DSEQ; const int pos = prompt ? row % SEQ : (row - TP) % DSEQ; const int L = prompt ? SEQ : DSEQ;
    const int ng = (ch >> 7) * 256 + (ch & 127), nv = ng + 128;
    float xg[3], xv[3];
#pragma unroll
    for (int i = 0; i < 3; ++i) {
        const int p = pos - 2 + i;
        if (p >= 0) { xg[i] = bf2f(u[(size_t)(lr - 2 + i) * NUP + ng]); xv[i] = bf2f(u[(size_t)(lr - 2 + i) * NUP + nv]); }
        else if (prompt) { xg[i] = 0.f; xv[i] = 0.f; }
        else { xg[i] = st_ffn[((size_t)b * 2 + (p + 2)) * NUP + ch]; xv[i] = st_ffn[((size_t)b * 2 + (p + 2)) * NUP + DFF + ch]; }
    }
    const float ug = cw[ch] * xg[0] + cw[NUP + ch] * xg[1] + cw[2 * NUP + ch] * xg[2] + cb[ch];
    const float uv = cw[DFF + ch] * xv[0] + cw[NUP + DFF + ch] * xv[1] + cw[2 * NUP + DFF + ch] * xv[2] + cb[DFF + ch];
    act[(size_t)row * DFF + ch] = f2bf(silu_f(ug) * uv);
    if (pos >= L - 2) { float* o = out + (prompt ? O_FFN_P : O_FFN_S) + ((size_t)b * 2 + (pos - (L - 2))) * NUP; o[ch] = xg[2]; o[DFF + ch] = xv[2]; }
}

__global__ void __launch_bounds__(256) k_final(float* h, const float* w) {
    const int lane = threadIdx.x & 63, row = blockIdx.x * 4 + (threadIdx.x >> 6);
    if (row >= T) return;
    float* x = h + (size_t)row * D; float4 v[4]; float s = 0.f;
#pragma unroll
    for (int j = 0; j < 4; ++j) { v[j] = *(const float4*)(x + 4 * lane + 256 * j); s += v[j].x * v[j].x + v[j].y * v[j].y + v[j].z * v[j].z + v[j].w * v[j].w; }
    s = wave_sum(s); const float rstd = rsqrtf(s * (1.f / D) + EPS);
#pragma unroll
    for (int j = 0; j < 4; ++j) { const float4 ww = *(const float4*)(w + 4 * lane + 256 * j);
        *(float4*)(x + 4 * lane + 256 * j) = make_float4(v[j].x * rstd * ww.x, v[j].y * rstd * ww.y, v[j].z * rstd * ww.z, v[j].w * rstd * ww.w); }
}

extern "C" void kernel_launch(void* const* d_in, const int* in_sizes, int n_in, void* d_out, int out_size, void* d_ws, size_t ws_size, hipStream_t stream) {
    const float* x_p = (const float*)d_in[0]; const float* x_s = (const float*)d_in[1]; const float* p_p = (const float*)d_in[2]; const float* p_s = (const float*)d_in[3];
    const float* st_conv = (const float*)d_in[4]; const float* st_dn = (const float*)d_in[5]; const float* st_ret = (const float*)d_in[6]; const float* st_ffn = (const float*)d_in[7];
    const float* attn_norm_w = (const float*)d_in[8]; const float* w_in = (const float*)d_in[9]; const float* dn_conv_w = (const float*)d_in[10];
    const float* A_log = (const float*)d_in[11]; const float* dt_bias = (const float*)d_in[12]; const float* dn_norm_w = (const float*)d_in[13]; const float* ret_norm_w = (const float*)d_in[14];
    const float* w_out = (const float*)d_in[15]; const float* ffn_norm_w = (const float*)d_in[16]; const float* w_up = (const float*)d_in[17]; const float* ffn_conv_w = (const float*)d_in[18];
    const float* ffn_conv_b = (const float*)d_in[19]; const float* w_down = (const float*)d_in[20]; const float* ple_norm_w = (const float*)d_in[21]; const float* w_gate = (const float*)d_in[22];
    const float* w_ple = (const float*)d_in[23]; const float* final_w = (const float*)d_in[24];
    float* out = (float*)d_out; char* ws = (char*)d_ws;
    bf16* nb = (bf16*)(ws + W_NB); bf16* big = (bf16*)(ws + W_BIG); bf16* act = (bf16*)(ws + W_ACT); float* gb = (float*)(ws + W_GB); float2* trig = (float2*)(ws + W_TRIG);
    float* hf = out + O_Y;

    k_trig<<<(2056 * 64 + 255) / 256, 256, 0, stream>>>(trig);
    k_rows_norm<0><<<T / 4, 256, 0, stream>>>(x_p, x_s, attn_norm_w, nb, w_in, A_log, dt_bias, gb);
    k_gemm<0, 1><<<dim3(NPROJ / 64, T / 64), 256, 0, stream>>>(nb, w_in, big, nullptr, nullptr, nullptr, nullptr, D, 4104, D, NPROJ, 0, T, NPROJ, 0);
    k_dn<<<(NB + NSB) * 4, 128, 0, stream>>>(big, gb, dn_conv_w, dn_norm_w, st_conv, st_dn, out);
    k_ret<<<(NB + NSB) * 4, 128, 0, stream>>>(big, trig, ret_norm_w, st_ret, out);
    k_gemm<1, 0><<<dim3(D / 64, T / 64), 256, 0, stream>>>(big + 3072, w_out, nullptr, hf, x_p, x_s, nullptr, NPROJ, D, D, D, 0, T, 0, 0);
    k_rows_norm<1><<<T / 4, 256, 0, stream>>>(hf, nullptr, ffn_norm_w, nb, nullptr, nullptr, nullptr, nullptr);
    for (int half = 0; half < 2; ++half) {
        const int r0 = half ? 8192 : 0, nr = half ? T - 8192 : 8192;
        k_gemm<0, 2><<<dim3(NUP / 64, nr / 64), 256, 0, stream>>>(nb, w_up, big, nullptr, nullptr, nullptr, nullptr, D, NUP, D, NUP, r0, nr, NUP, r0);
        k_act<<<(unsigned)(((size_t)nr * DFF + 255) / 256), 256, 0, stream>>>(big, ffn_conv_w, ffn_conv_b, st_ffn, act, out, r0, nr);
    }
    k_gemm<1, 0><<<dim3(D / 64, T / 64), 256, 0, stream>>>(act, w_down, nullptr, hf, nullptr, nullptr, nullptr, DFF, D, DFF, D, 0, T, 0, 0);
    k_rows_norm<1><<<T / 4, 256, 0, stream>>>(hf, nullptr, ple_norm_w, nb, nullptr, nullptr, nullptr, nullptr);
    bf16* pb = big; bf16* pe = big + (size_t)T * PLE;
    k_cvt_p<<<(unsigned)(((size_t)T * PLE + 255) / 256), 256, 0, stream>>>(p_p, p_s, pb);
    k_gemm<0, 0><<<dim3(D / 64, T / 64), 256, 0, stream>>>(pb, w_ple, pe, nullptr, nullptr, nullptr, nullptr, PLE, D, PLE, D, 0, T, D, 0);
    k_gemm<2, 0><<<dim3(D / 64, T / 64), 256, 0, stream>>>(nb, w_gate, nullptr, hf, nullptr, nullptr, pe, D, D, D, D, 0, T, 0, 0);
    k_final<<<T / 4, 256, 0, stream>>>(hf, final_w);
}
```

```cpp
#include <hip/hip_runtime.h>
#include <cstdio>
#include <cstdint>

typedef unsigned short bf16;
constexpr int TP = 16384, TS = 1024, T = TP + TS;
constexpr int D = 1024, NPROJ = 4096, DFF = 2816, NUP = 5632, PLE = 256;
constexpr int SEQ = 2048, DSEQ = 8, NB = 8, NSB = 128;
constexpr float EPS = 1e-6f;

constexpr size_t O_Y = 0, O_DNCONV_P = 17825792, O_DN_P = 17862656, O_RET_P = 18386944, O_FFN_P = 18911232,
                 O_DNCONV_S = 19001344, O_DN_S = 19591168, O_RET_S = 27979776, O_FFN_S = 36368384;

__device__ __forceinline__ float bf2f(bf16 v) { return __uint_as_float(((unsigned)v) << 16); }
__device__ __forceinline__ bf16 f2bf(float f) { unsigned u = __float_as_uint(f); return (bf16)((u + 0x7fffu + ((u >> 16) & 1u)) >> 16); }
__device__ __forceinline__ float silu_f(float x) { return x / (1.f + __expf(-x)); }
__device__ __forceinline__ float sigmoid_f(float x) { return 1.f / (1.f + __expf(-x)); }
__device__ __forceinline__ float wave_sum(float v) {
#pragma unroll
    for (int o = 1; o < 64; o <<= 1) v += __shfl_xor(v, o);
    return v;
}
__host__ __device__ __forceinline__ int proj_orig_col(int n) {
    if (n < 1536) return n;
    if (n < 3072) return 2056 + (n - 1536);
    if (n < 3584) return 1536 + (n - 3072);
    return 3592 + (n - 3584);
}
__host__ __device__ __forceinline__ int up_orig_col(int n) { const int t = n >> 8, half = (n >> 7) & 1, j = n & 127; return half * DFF + 128 * t + j; }

namespace pg8 {
#define PG8_LAS __attribute__((address_space(3)))
typedef unsigned short bf16_t;
typedef short bf16x8 __attribute__((ext_vector_type(8)));
typedef float f32x4 __attribute__((ext_vector_type(4)));
typedef unsigned u32x4 __attribute__((ext_vector_type(4)));
constexpr int BM = 256, BK = 64, HALF = 128, HTB = HALF * BK * 2  , STAGE_BYTES = 8 * HTB, NXCD = 8, WGM = 8;

__host__ __device__ __forceinline__ int lds_byte(int r, int c) { const int st = (r >> 4) * 2 + (c >> 5), rr = r & 15, cc = c & 31, ob = rr * 64 + cc * 2; return st * 1024 + (ob ^ (((ob >> 9) & 1) << 5)); }
__host__ __device__ __forceinline__ void stage_rc(int b, int& R, int& C) { const int st = b / 1024, sb = b % 1024, swz = sb ^ (((sb >> 9) & 1) << 5); R = (st >> 1) * 16 + swz / 64; C = (st & 1) * 32 + (swz % 64) / 2; }
__host__ __device__ __forceinline__ int perm32(int rho) { const int n = rho >> 4, i = rho & 15; return 8 * (i >> 2) + 4 * n + (i & 3); }

struct Unit { int pm, pn; };
struct Gemm { const bf16_t* A; const bf16_t* Bt; int M, N, K, lda, ldb; };

struct StaticOrder {
    int nM, nN, nwg, G, c;
    __host__ __device__ void init(int M, int N, int G_, int c_) { nM = M / BM; nN = N / BM; nwg = nM * nN; G = G_; c = c_; }
    __host__ __device__ bool next(int i, Unit& u) const {
        const long L = (long)i * G + c; if (L >= nwg) return false;
        int wgid = (int)L; { const int q = nwg / NXCD, r = nwg % NXCD, xcd = wgid % NXCD, off = wgid / NXCD; wgid = (xcd < r ? xcd * (q + 1) : r * (q + 1) + (xcd - r) * q) + off; }
        const int nig = WGM * nN, gid = wgid / nig, fm = gid * WGM, gsz = (nM - fm) < WGM ? (nM - fm) : WGM;
        u.pm = fm + ((wgid % nig) % gsz); u.pn = (wgid % nig) / gsz; return true;
    }
    __device__ __forceinline__ void a_ready(const Unit&) const {}
    __device__ __forceinline__ void done(const Unit&) const {}
};

__device__ __forceinline__ unsigned cvt_pk_bf16(float lo, float hi) { unsigned r; asm volatile("v_cvt_pk_bf16_f32 %0, %1, %2" : "=v"(r) : "v"(lo), "v"(hi)); return r; }

struct EpiStore {
    static constexpr bool PERM = true, AFTER_DRAIN = false;
    bf16_t* O; int ldc;
    __device__ __forceinline__ void operator()(const f32x4 (&acc)[2][2][4][2], const Unit& u, int wr, int wc, int fr, int fq, int ui) const {
        const int row0 = u.pm * BM + wr * 64 + fr, col0 = u.pn * BM + wc * 32 + 8 * fq;
#pragma unroll
        for (int ai = 0; ai < 2; ++ai)
#pragma unroll
            for (int m = 0; m < 4; ++m) { bf16_t* rowp = O + (size_t)(row0 + ai * HALF + m * 16) * ldc + col0;
#pragma unroll
                for (int bj = 0; bj < 2; ++bj) { const f32x4 v0 = acc[ai][bj][m][0], v1 = acc[ai][bj][m][1];
                    u32x4 w; w.x = cvt_pk_bf16(v0[0], v0[1]); w.y = cvt_pk_bf16(v0[2], v0[3]); w.z = cvt_pk_bf16(v1[0], v1[1]); w.w = cvt_pk_bf16(v1[2], v1[3]);
                    *(u32x4*)(rowp + bj * HALF) = w; } }
    }
};
struct EpiResid {
    static constexpr bool PERM = true, AFTER_DRAIN = false;
    float* hf; const float* xp; const float* xs;
    __device__ __forceinline__ void operator()(const f32x4 (&acc)[2][2][4][2], const Unit& u, int wr, int wc, int fr, int fq, int ui) const {
        const int row0 = u.pm * BM + wr * 64 + fr, col0 = u.pn * BM + wc * 32 + 8 * fq;
#pragma unroll
        for (int ai = 0; ai < 2; ++ai)
#pragma unroll
            for (int m = 0; m < 4; ++m) { const int row = row0 + ai * HALF + m * 16;
                const float* bp = xs ? (row < 16384 ? xp + (size_t)row * 1024 : xs + (size_t)(row - 16384) * 1024) : hf + (size_t)row * 1024;
                float* op = hf + (size_t)row * 1024;
#pragma unroll
                for (int bj = 0; bj < 2; ++bj) { const int c = col0 + bj * HALF;
                    const f32x4 b0 = *(const f32x4*)(bp + c), b1 = *(const f32x4*)(bp + c + 4);
                    *(f32x4*)(op + c) = b0 + acc[ai][bj][m][0]; *(f32x4*)(op + c + 4) = b1 + acc[ai][bj][m][1]; } }
    }
};
struct EpiPle {
    static constexpr bool PERM = true, AFTER_DRAIN = false;
    float* hf; const bf16_t* pe;
    __device__ __forceinline__ void operator()(const f32x4 (&acc)[2][2][4][2], const Unit& u, int wr, int wc, int fr, int fq, int ui) const {
        const int row0 = u.pm * BM + wr * 64 + fr, col0 = u.pn * BM + wc * 32 + 8 * fq;
#pragma unroll
        for (int ai = 0; ai < 2; ++ai)
#pragma unroll
            for (int m = 0; m < 4; ++m) { const int row = row0 + ai * HALF + m * 16; float* op = hf + (size_t)row * 1024;
#pragma unroll
                for (int bj = 0; bj < 2; ++bj) { const int c = col0 + bj * HALF;
                    const u32x4 pw = *(const u32x4*)(pe + (size_t)row * 1024 + c);
                    const f32x4 h0 = *(const f32x4*)(op + c), h1 = *(const f32x4*)(op + c + 4);
                    const f32x4 a0 = acc[ai][bj][m][0], a1 = acc[ai][bj][m][1];
                    f32x4 p0, p1;
                    p0[0] = __uint_as_float(pw.x << 16); p0[1] = __uint_as_float(pw.x & 0xffff0000u); p0[2] = __uint_as_float(pw.y << 16); p0[3] = __uint_as_float(pw.y & 0xffff0000u);
                    p1[0] = __uint_as_float(pw.z << 16); p1[1] = __uint_as_float(pw.z & 0xffff0000u); p1[2] = __uint_as_float(pw.w << 16); p1[3] = __uint_as_float(pw.w & 0xffff0000u);
                    f32x4 o0, o1;
#pragma unroll
                    for (int e = 0; e < 4; ++e) { o0[e] = h0[e] + p0[e] / (1.f + __expf(-a0[e])); o1[e] = h1[e] + p1[e] / (1.f + __expf(-a1[e])); }
                    *(f32x4*)(op + c) = o0; *(f32x4*)(op + c + 4) = o1; } }
    }
};


struct EpiResidN {
    static constexpr bool PERM = true, AFTER_DRAIN = false;
    float* hf; const float* xp; const float* xs; bf16_t* hb; float* ssq;
    __device__ __forceinline__ void operator()(const f32x4 (&acc)[2][2][4][2], const Unit& u, int wr, int wc, int fr, int fq, int ui) const {
        const int row0 = u.pm * BM + wr * 64 + fr, col0 = u.pn * BM + wc * 32 + 8 * fq;
#pragma unroll
        for (int ai = 0; ai < 2; ++ai)
#pragma unroll
            for (int m = 0; m < 4; ++m) { const int row = row0 + ai * HALF + m * 16;
                const float* bp = xs ? (row < 16384 ? xp + (size_t)row * 1024 : xs + (size_t)(row - 16384) * 1024) : hf + (size_t)row * 1024;
                float* op = hf + (size_t)row * 1024; bf16_t* ob = hb + (size_t)row * 1024; float s = 0.f;
#pragma unroll
                for (int bj = 0; bj < 2; ++bj) { const int c = col0 + bj * HALF;
                    const f32x4 v0 = *(const f32x4*)(bp + c) + acc[ai][bj][m][0], v1 = *(const f32x4*)(bp + c + 4) + acc[ai][bj][m][1];
                    *(f32x4*)(op + c) = v0; *(f32x4*)(op + c + 4) = v1;
                    s += (v0[0] * v0[0] + v0[1] * v0[1]) + (v0[2] * v0[2] + v0[3] * v0[3]) + (v1[0] * v1[0] + v1[1] * v1[1]) + (v1[2] * v1[2] + v1[3] * v1[3]);
                    u32x4 w; w.x = cvt_pk_bf16(v0[0], v0[1]); w.y = cvt_pk_bf16(v0[2], v0[3]); w.z = cvt_pk_bf16(v1[0], v1[1]); w.w = cvt_pk_bf16(v1[2], v1[3]);
                    *(u32x4*)(ob + c) = w; }
                s += __shfl_xor(s, 16); s += __shfl_xor(s, 32);
                if (fq == 0) ssq[(size_t)row * 16 + u.pn * 4 + wc] = s; }
    }
};
struct EpiScaleStore {
    static constexpr bool PERM = true, AFTER_DRAIN = false;
    bf16_t* O; int ldc; const PG8_LAS float* tbl;
    __device__ __forceinline__ void operator()(const f32x4 (&acc)[2][2][4][2], const Unit& u, int wr, int wc, int fr, int fq, int ui) const {
        const int row0 = u.pm * BM + wr * 64 + fr, col0 = u.pn * BM + wc * 32 + 8 * fq;
#pragma unroll
        for (int ai = 0; ai < 2; ++ai)
#pragma unroll
            for (int m = 0; m < 4; ++m) { bf16_t* rowp = O + (size_t)(row0 + ai * HALF + m * 16) * ldc + col0;
                const float rs = tbl[ui * 256 + ai * HALF + wr * 64 + m * 16 + fr];
#pragma unroll
                for (int bj = 0; bj < 2; ++bj) { const f32x4 v0 = acc[ai][bj][m][0] * rs, v1 = acc[ai][bj][m][1] * rs;
                    u32x4 w; w.x = cvt_pk_bf16(v0[0], v0[1]); w.y = cvt_pk_bf16(v0[2], v0[3]); w.z = cvt_pk_bf16(v1[0], v1[1]); w.w = cvt_pk_bf16(v1[2], v1[3]);
                    *(u32x4*)(rowp + bj * HALF) = w; } }
    }
};
struct EpiPleN {
    static constexpr bool PERM = true, AFTER_DRAIN = false;
    float* hf; const bf16_t* pe; const PG8_LAS float* tbl; float* ssq;
    __device__ __forceinline__ void operator()(const f32x4 (&acc)[2][2][4][2], const Unit& u, int wr, int wc, int fr, int fq, int ui) const {
        const int row0 = u.pm * BM + wr * 64 + fr, col0 = u.pn * BM + wc * 32 + 8 * fq;
#pragma unroll
        for (int ai = 0; ai < 2; ++ai)
#pragma unroll
            for (int m = 0; m < 4; ++m) { const int row = row0 + ai * HALF + m * 16; float* op = hf + (size_t)row * 1024; float s = 0.f;
                const float rs = tbl[ui * 256 + ai * HALF + wr * 64 + m * 16 + fr];
#pragma unroll
                for (int bj = 0; bj < 2; ++bj) { const int c = col0 + bj * HALF;
                    const u32x4 pw = *(const u32x4*)(pe + (size_t)row * 1024 + c);
                    const f32x4 h0 = *(const f32x4*)(op + c), h1 = *(const f32x4*)(op + c + 4);
                    const f32x4 a0 = acc[ai][bj][m][0] * rs, a1 = acc[ai][bj][m][1] * rs;
                    f32x4 p0, p1;
                    p0[0] = __uint_as_float(pw.x << 16); p0[1] = __uint_as_float(pw.x & 0xffff0000u); p0[2] = __uint_as_float(pw.y << 16); p0[3] = __uint_as_float(pw.y & 0xffff0000u);
                    p1[0] = __uint_as_float(pw.z << 16); p1[1] = __uint_as_float(pw.z & 0xffff0000u); p1[2] = __uint_as_float(pw.w << 16); p1[3] = __uint_as_float(pw.w & 0xffff0000u);
                    f32x4 o0, o1;
#pragma unroll
                    for (int e = 0; e < 4; ++e) { o0[e] = h0[e] + p0[e] / (1.f + __expf(-a0[e])); o1[e] = h1[e] + p1[e] / (1.f + __expf(-a1[e])); }
                    *(f32x4*)(op + c) = o0; *(f32x4*)(op + c + 4) = o1;
                    s += (o0[0] * o0[0] + o0[1] * o0[1]) + (o0[2] * o0[2] + o0[3] * o0[3]) + (o1[0] * o1[0] + o1[1] * o1[1]) + (o1[2] * o1[2] + o1[3] * o1[3]); }
                s += __shfl_xor(s, 16); s += __shfl_xor(s, 32);
                if (fq == 0) ssq[(size_t)row * 16 + u.pn * 4 + wc] = s; }
    }
};

template <class Epi, class Sched, bool ALIGN_EPI = false, bool SP2 = false>
__device__ __forceinline__ void gemm_phase(PG8_LAS unsigned char* lds, const Gemm g, const Sched& S, const Epi& E) {
    const int tid = threadIdx.x, wid = __builtin_amdgcn_readfirstlane(tid >> 6), lane = tid & 63, wr = wid >> 2, wc = wid & 3, fr = lane & 15, fq = lane >> 4;
    const int K = g.K, nt = K / BK;
    unsigned voffA[2], voffB[2];
#pragma unroll
    for (int i = 0; i < 2; ++i) { int R, C; stage_rc(tid * 16 + i * 8192, R, C); const int Rb = Epi::PERM ? ((R & ~31) + perm32(R & 31)) : R;
        voffA[i] = (unsigned)(R * g.lda + C) * 2u; voffB[i] = (unsigned)(Rb * g.ldb + C) * 2u; }
    const size_t kstep = (size_t)(BK * 2);
    const size_t hstepA = (size_t)HALF * g.lda * 2, hstepB = (size_t)HALF * g.ldb * 2;
    const size_t tstepA = 2 * hstepA, tstepB = 2 * hstepB;
    const unsigned ldsw = (unsigned)wid * 1024u;
    const int aoff = lds_byte(wr * 64 + fr, fq * 8), boff = lds_byte(wc * 32 + fr, fq * 8);
#define PG8_SA(b, h) (((b) * 2 + (h)) * HTB)
#define PG8_SB(b, h) ((4 + (b) * 2 + (h)) * HTB)
#define PG8_STAGE(bufoff, gbase, voff) do { _Pragma("unroll") for (int _i = 0; _i < 2; ++_i) \
        __builtin_amdgcn_global_load_lds((const unsigned*)((const char*)(gbase) + (voff)[_i]), (PG8_LAS unsigned*)(lds + (bufoff) + ldsw + _i * 8192), 16, 0, 0); } while (0)
#define PG8_LDA(dst, b, h) do { _Pragma("unroll") for (int m = 0; m < 4; ++m) _Pragma("unroll") for (int k = 0; k < 2; ++k) dst[m][k] = *(const PG8_LAS bf16x8*)(lds + PG8_SA(b, h) + aoff + m * 2048 + k * 1024); } while (0)
#define PG8_LDB(dst, b, h) do { _Pragma("unroll") for (int n = 0; n < 2; ++n) _Pragma("unroll") for (int k = 0; k < 2; ++k) dst[n][k] = *(const PG8_LAS bf16x8*)(lds + PG8_SB(b, h) + boff + n * 2048 + k * 1024); } while (0)
#define PG8_MMA(ai, bj, At, Bt) do { __builtin_amdgcn_s_setprio(1); _Pragma("unroll") for (int m = 0; m < 4; ++m) _Pragma("unroll") for (int n = 0; n < 2; ++n) _Pragma("unroll") for (int k = 0; k < 2; ++k) \
        acc[ai][bj][m][n] = __builtin_amdgcn_mfma_f32_16x16x32_bf16(Bt[n][k], At[m][k], acc[ai][bj][m][n], 0, 0, 0); __builtin_amdgcn_s_setprio(0); } while (0)
#define PG8_WAIT_V(n) asm volatile("s_waitcnt vmcnt(" #n ")" ::: "memory")
#define PG8_WAIT_L(n) asm volatile("s_waitcnt lgkmcnt(" #n ")" ::: "memory")
#define PG8_BAR __builtin_amdgcn_s_barrier()
#define PG8_SCHED __builtin_amdgcn_sched_barrier(0)
    Unit cur, nxt; int ui = 0;
    if (!S.next(0, cur)) return;
    f32x4 acc[2][2][4][2];
#pragma unroll
    for (int a = 0; a < 2; ++a)
#pragma unroll
        for (int b = 0; b < 2; ++b)
#pragma unroll
            for (int m = 0; m < 4; ++m)
#pragma unroll
                for (int n = 0; n < 2; ++n) acc[a][b][m][n] = (f32x4){0.f, 0.f, 0.f, 0.f};
    bf16x8 At[4][2], B0[2][2], B1[2][2];
    const char* cA = (const char*)g.A + (size_t)cur.pm * tstepA; const char* cB = (const char*)g.Bt + (size_t)cur.pn * tstepB;
    S.a_ready(cur);
    if constexpr (SP2) {
        PG8_STAGE(PG8_SB(0, 0), cB, voffB); PG8_STAGE(PG8_SB(0, 1), cB + hstepB, voffB); PG8_STAGE(PG8_SA(0, 0), cA, voffA); PG8_STAGE(PG8_SA(0, 1), cA + hstepA, voffA);
        if (wr == 1) PG8_BAR;
        PG8_WAIT_V(2); PG8_BAR;
        PG8_STAGE(PG8_SB(1, 0), cB + kstep, voffB); PG8_STAGE(PG8_SA(1, 0), cA + kstep, voffA); PG8_STAGE(PG8_SB(1, 1), cB + hstepB + kstep, voffB);
        PG8_WAIT_V(6); PG8_BAR;
    } else {
        PG8_STAGE(PG8_SB(0, 0), cB, voffB); PG8_STAGE(PG8_SA(0, 0), cA, voffA); PG8_STAGE(PG8_SB(0, 1), cB + hstepB, voffB); PG8_STAGE(PG8_SA(0, 1), cA + hstepA, voffA);
        if (wr == 1) PG8_BAR;
        PG8_WAIT_V(4); PG8_BAR;
        PG8_STAGE(PG8_SB(1, 0), cB + kstep, voffB); PG8_STAGE(PG8_SA(1, 0), cA + kstep, voffA); PG8_STAGE(PG8_SB(1, 1), cB + hstepB + kstep, voffB);
        PG8_WAIT_V(6); PG8_BAR;
    }
    for (;;) {
        const bool has_next = S.next(ui + 1, nxt);
        const char* nA = has_next ? (const char*)g.A + (size_t)nxt.pm * tstepA : cA; const char* nB = has_next ? (const char*)g.Bt + (size_t)nxt.pn * tstepB : cB;
        for (int t = 0; t < nt; t += 2) {
            const bool last = (t == nt - 2);
            const char* a1 = cA + (size_t)(t + 1) * kstep;
            const char* a2 = last ? nA : cA + (size_t)(t + 2) * kstep; const char* b2 = last ? nB : cB + (size_t)(t + 2) * kstep;
            const char* a3 = a2 + kstep; const char* b3 = b2 + kstep;
            if (last && has_next) S.a_ready(nxt);
            if constexpr (SP2) {
            PG8_LDB(B0, 0, 0); PG8_LDB(B1, 0, 1); PG8_SCHED; PG8_LDA(At, 0, 0); PG8_STAGE(PG8_SA(1, 1), a1 + hstepA, voffA);
            PG8_WAIT_V(8); PG8_WAIT_L(0); PG8_BAR; PG8_MMA(0, 0, At, B0); PG8_MMA(0, 1, At, B1); PG8_BAR; PG8_SCHED;
            PG8_LDA(At, 0, 1); PG8_STAGE(PG8_SB(0, 0), b2, voffB); PG8_STAGE(PG8_SB(0, 1), b2 + hstepB, voffB); PG8_STAGE(PG8_SA(0, 0), a2, voffA);
            PG8_WAIT_V(8); PG8_WAIT_L(0); PG8_BAR; PG8_MMA(1, 0, At, B0); PG8_MMA(1, 1, At, B1); PG8_BAR; PG8_SCHED;
            PG8_LDB(B0, 1, 0); PG8_LDB(B1, 1, 1); PG8_SCHED; PG8_LDA(At, 1, 0); PG8_STAGE(PG8_SA(0, 1), a2 + hstepA, voffA);
            PG8_WAIT_V(8); PG8_WAIT_L(0); PG8_BAR; PG8_MMA(0, 0, At, B0); PG8_MMA(0, 1, At, B1); PG8_BAR; PG8_SCHED;
            PG8_LDA(At, 1, 1); PG8_STAGE(PG8_SB(1, 0), b3, voffB); PG8_STAGE(PG8_SB(1, 1), b3 + hstepB, voffB); PG8_STAGE(PG8_SA(1, 0), a3, voffA);
            PG8_WAIT_V(8); PG8_WAIT_L(0); PG8_BAR; PG8_MMA(1, 0, At, B0); PG8_MMA(1, 1, At, B1); PG8_BAR; PG8_SCHED;
            } else {
            PG8_LDB(B0, 0, 0); PG8_SCHED; PG8_LDA(At, 0, 0); PG8_STAGE(PG8_SA(1, 1), a1 + hstepA, voffA);
            PG8_WAIT_L(8); PG8_BAR; PG8_WAIT_L(0); PG8_MMA(0, 0, At, B0); PG8_BAR; PG8_SCHED;
            PG8_LDB(B1, 0, 1); PG8_STAGE(PG8_SB(0, 0), b2, voffB);
            PG8_BAR; PG8_WAIT_L(0); PG8_MMA(0, 1, At, B1); PG8_BAR;
            PG8_LDA(At, 0, 1); PG8_STAGE(PG8_SA(0, 0), a2, voffA);
            PG8_BAR; PG8_WAIT_L(0); PG8_MMA(1, 0, At, B0); PG8_BAR; PG8_SCHED;
            PG8_STAGE(PG8_SB(0, 1), b2 + hstepB, voffB);
            PG8_WAIT_V(6); PG8_BAR; PG8_MMA(1, 1, At, B1); PG8_BAR;
            PG8_LDB(B0, 1, 0); PG8_SCHED; PG8_LDA(At, 1, 0); PG8_STAGE(PG8_SA(0, 1), a2 + hstepA, voffA);
            PG8_WAIT_L(8); PG8_BAR; PG8_WAIT_L(0); PG8_MMA(0, 0, At, B0); PG8_BAR; PG8_SCHED;
            PG8_LDB(B1, 1, 1); PG8_STAGE(PG8_SB(1, 0), b3, voffB);
            PG8_BAR; PG8_WAIT_L(0); PG8_MMA(0, 1, At, B1); PG8_BAR;
            PG8_LDA(At, 1, 1); PG8_STAGE(PG8_SA(1, 0), a3, voffA);
            PG8_BAR; PG8_WAIT_L(0); PG8_MMA(1, 0, At, B0); PG8_BAR; PG8_SCHED;
            PG8_STAGE(PG8_SB(1, 1), b3 + hstepB, voffB);
            PG8_WAIT_V(6); PG8_BAR; PG8_MMA(1, 1, At, B1); PG8_BAR;
            }
        }
        if constexpr (ALIGN_EPI) { if (wr == 0) PG8_BAR; }
        if constexpr (!Epi::AFTER_DRAIN) { E(acc, cur, wr, wc, fr, fq, ui); S.done(cur); }
        if (!has_next) break;
#pragma unroll
        for (int a = 0; a < 2; ++a)
#pragma unroll
            for (int b = 0; b < 2; ++b)
#pragma unroll
                for (int m = 0; m < 4; ++m)
#pragma unroll
                    for (int n = 0; n < 2; ++n) acc[a][b][m][n] = (f32x4){0.f, 0.f, 0.f, 0.f};
        cur = nxt; cA = nA; cB = nB; ++ui;
        if constexpr (ALIGN_EPI) { if (wr == 1) PG8_BAR; }
    }
    PG8_WAIT_V(0);
    if constexpr (!ALIGN_EPI) { if (wr == 0) PG8_BAR; }
    PG8_BAR;
    if constexpr (Epi::AFTER_DRAIN) { E.fused(acc, cur, wr, wc, fr, fq, lds, wid, lane); S.done(cur); }
#undef PG8_SA
#undef PG8_SB
#undef PG8_STAGE
#undef PG8_LDA
#undef PG8_LDB
#undef PG8_MMA
#undef PG8_WAIT_V
#undef PG8_WAIT_L
#undef PG8_BAR
#undef PG8_SCHED
}
}
constexpr int NWAVES = 8;
constexpr size_t MiB = 1u << 20;
constexpr size_t WS_CTL = 0, CTL_ZERO_BYTES = 1 * MiB;
constexpr size_t WS_TRIG = 1 * MiB, WS_GB = 2 * MiB + 256 * 1024;
constexpr size_t WS_WUP = 3 * MiB, WS_WDOWN = 14 * MiB, WS_WGATE = 19 * MiB + 512 * 1024, WS_WPLE = 21 * MiB + 512 * 1024;
constexpr size_t WS_NBUF = 22 * MiB;
constexpr size_t WS_BIG = 56 * MiB;
constexpr size_t WS_ACT = 155 * MiB;
constexpr size_t WS_WIN = 192 * MiB, WS_WOUT = 200 * MiB;
constexpr size_t WS_PE = WS_BIG, WS_PB = 90 * MiB;
constexpr size_t WS_FRHI = 202 * MiB, WS_GLAST = 2 * MiB + 896 * 1024;
constexpr size_t WS_SSQA = 250 * MiB, WS_SSQB = 252 * MiB;
constexpr size_t WS_END = 256 * MiB;
static_assert(WS_ACT + (size_t)T * DFF * 2 <= WS_END && WS_BIG + (size_t)T * NPROJ * 2 <= WS_WIN && WS_BIG + (size_t)9216 * NUP * 2 <= WS_ACT, "d_ws map");
constexpr int CW_BAR = 4096;
constexpr int RING_OFF = 0, RING_BYTES = 131072;
constexpr int LDS_BYTES = 163840;
constexpr int LDSCTL_OFF = LDS_BYTES - 1024, MISC_OFF = LDSCTL_OFF + 320;
#define GAS __attribute__((address_space(1)))
#define LAS __attribute__((address_space(3)))
typedef unsigned v4u __attribute__((ext_vector_type(4)));
typedef float f32x4 __attribute__((ext_vector_type(4)));
typedef short bf16x8 __attribute__((ext_vector_type(8)));
typedef GAS unsigned gu32;
typedef GAS unsigned long long gu64;
#define RLX_AGENT __ATOMIC_RELAXED, __HIP_MEMORY_SCOPE_AGENT
#define LDS_WAIT() asm volatile("s_waitcnt lgkmcnt(0)" ::: "memory")
#define VM_WAIT() asm volatile("s_waitcnt vmcnt(0)" ::: "memory")
__device__ __forceinline__ unsigned long long rt() { return __builtin_amdgcn_s_memrealtime(); }
__device__ __forceinline__ unsigned pk2(float lo, float hi) { return (unsigned)f2bf(lo) | ((unsigned)f2bf(hi) << 16); }

#define XB_TMO      128
#define XB_XCNT(j)  (256  + 64 * (j))
#define XB_XSUB(j)  (1280 + 64 * (j))
#define XB_XGEN(j)  (2304 + 64 * (j))
#define XB_TOP      3328
#define XB_TOPGEN   3392
#define XCD_BAR_WORDS 3456
#define XB_SPIN_CAP (1u << 18)

__device__ __forceinline__ unsigned xb_ld(unsigned* p)              { return __hip_atomic_load(p, __ATOMIC_RELAXED, __HIP_MEMORY_SCOPE_AGENT); }
__device__ __forceinline__ unsigned xb_add(unsigned* p, unsigned v) { return __hip_atomic_fetch_add(p, v, __ATOMIC_RELAXED, __HIP_MEMORY_SCOPE_AGENT); }
__device__ __forceinline__ unsigned xb_xcc_id() { return (unsigned)__builtin_amdgcn_s_getreg((3 << 11) | 20) & 0xFu; }
#define XB_SPIN(cond, bar) do { unsigned _sp = 0; while (cond) { __builtin_amdgcn_s_sleep(1); \
    if ((++_sp & 255u) == 0u) { if (xb_ld(&(bar)[XB_TMO])) break; if (_sp > XB_SPIN_CAP) { atomicAdd(&(bar)[XB_TMO], 1u); break; } } } } while (0)

struct XcdBarrier {
    unsigned* bar; unsigned x;
    volatile LAS unsigned* st;
};

__device__ __forceinline__ XcdBarrier xcd_barrier_post(unsigned* bar, volatile LAS unsigned* st) {
    XcdBarrier b; b.bar = bar; b.x = xb_xcc_id(); b.st = st;
    if (threadIdx.x == 0) (void)xb_add(&bar[XB_XCNT(b.x)], 1u);
    return b;
}
__device__ __forceinline__ void xcd_barrier_complete(unsigned* bar, unsigned x, unsigned& nloc, unsigned& nx) {
    const unsigned G = gridDim.x * gridDim.y * gridDim.z;
    unsigned sum, cnt, mine, sp = 0u;
    for (;;) {
        sum = 0u; cnt = 0u; mine = 0u;
#pragma unroll
        for (unsigned j = 0; j < 16; ++j) { const unsigned c = xb_ld(&bar[XB_XCNT(j)]); sum += c; cnt += (c > 0u) ? 1u : 0u; mine = (j == x) ? c : mine; }
        if (sum == G) break;
        __builtin_amdgcn_s_sleep(1);
        if ((++sp & 255u) == 0u) { if (xb_ld(&bar[XB_TMO])) break; if (sp > XB_SPIN_CAP) { atomicAdd(&bar[XB_TMO], 1u); break; } }
    }
    nloc = mine > 0u ? mine : 1u; nx = cnt > 0u ? cnt : 1u;
}

__device__ __forceinline__ void xcd_barrier(const XcdBarrier& b) {
    asm volatile("s_waitcnt vmcnt(0)" ::: "memory");
    __syncthreads();
    if (threadIdx.x == 0) {
        unsigned* bar = b.bar;
        __builtin_amdgcn_s_waitcnt(0);
        unsigned nloc = b.st[0], nx = b.st[1];
        if (nloc == 0u) { xcd_barrier_complete(bar, b.x, nloc, nx); b.st[0] = nloc; b.st[1] = nx; }
        const unsigned old = xb_add(&bar[XB_XSUB(b.x)], 1u);
        const unsigned gen = old / nloc;
        if (old + 1u == (gen + 1u) * nloc) {
            __builtin_amdgcn_fence(__ATOMIC_RELEASE, "agent");
            asm volatile("s_waitcnt vmcnt(0)" ::: "memory");
            const unsigned og = xb_add(&bar[XB_TOP], 1u);
            const unsigned tg = og / nx;
            if (og + 1u == (tg + 1u) * nx) xb_add(&bar[XB_TOPGEN], 1u);
            else XB_SPIN(xb_ld(&bar[XB_TOPGEN]) == tg, bar);
            __builtin_amdgcn_fence(__ATOMIC_ACQUIRE, "agent");
            xb_add(&bar[XB_XGEN(b.x)], 1u);
            asm volatile("s_waitcnt vmcnt(0)" ::: "memory");
        } else {
            XB_SPIN(xb_ld(&bar[XB_XGEN(b.x)]) == gen, bar);
            __builtin_amdgcn_fence(__ATOMIC_ACQUIRE, "agent");
            asm volatile("s_waitcnt vmcnt(0)" ::: "memory");
        }
    }
    __syncthreads();
}

struct Args { const float* in[25]; float* dout; unsigned char* dws; int ph_lo, ph_hi, li, pad; };
enum InIdx { I_XP = 0, I_XS, I_PP, I_PS, I_ST_CONV, I_ST_DN, I_ST_RET, I_ST_FFN, I_ATTN_NW, I_WIN, I_DN_CONVW, I_ALOG, I_DTB, I_DN_NW, I_RET_NW,
             I_WOUT, I_FFN_NW, I_WUP, I_FFN_CW, I_FFN_CB, I_WDOWN, I_PLE_NW, I_WGATE, I_WPLE, I_FINAL_NW };
struct Frame {
    LAS unsigned char* lds; volatile LAS unsigned* MISC; gu32* ctl;
    int tid, lane, wave, G, gw, NGW;
};

__device__ __forceinline__ void transpose_item(const float* W, int ldw, int oc0, int K, bf16* WT, int n0, int k0, LAS float* scr, int lane, const float* kscale) {
#pragma unroll 8
    for (int i = 0; i < 32; ++i) { const int kk = 2 * i + (lane >> 5); float v = W[(size_t)(k0 + kk) * ldw + oc0 + (lane & 31)]; if (kscale) v *= kscale[k0 + kk]; scr[kk * 33 + (lane & 31)] = v; }
    LDS_WAIT(); asm volatile("" ::: "memory");
    const int c = lane & 7;
#pragma unroll
    for (int j = 0; j < 4; ++j) { const int n = (lane >> 3) + 8 * j; const LAS float* s = scr + (8 * c) * 33 + n;
        v4u o; o.x = pk2(s[0 * 33], s[1 * 33]); o.y = pk2(s[2 * 33], s[3 * 33]); o.z = pk2(s[4 * 33], s[5 * 33]); o.w = pk2(s[6 * 33], s[7 * 33]);
        *(GAS v4u*)(WT + (size_t)(n0 + n) * K + k0 + 8 * c) = o; }
    LDS_WAIT(); asm volatile("" ::: "memory");
}
template <int MODE>
__device__ __forceinline__ void rows_norm_phase(const Frame& F, const float* xp, const float* xs, const float* w, bf16* outb,
                                                const float* w_in, const float* A_log, const float* dt_bias, float* gb) {
    const int lane = F.lane;
    for (int row = F.gw; row < T; row += F.NGW) {
        const float* x = (MODE == 0) ? (row < TP ? xp + (size_t)row * D : xs + (size_t)(row - TP) * D) : xp + (size_t)row * D;
        float v[16]; float s = 0.f;
#pragma unroll
        for (int j = 0; j < 4; ++j) { const f32x4 t = *(const f32x4*)(x + 4 * lane + 256 * j); v[4 * j] = t[0]; v[4 * j + 1] = t[1]; v[4 * j + 2] = t[2]; v[4 * j + 3] = t[3]; s += t[0] * t[0] + t[1] * t[1] + t[2] * t[2] + t[3] * t[3]; }
        s = wave_sum(s);
        const float rstd = rsqrtf(s * (1.f / D) + EPS);
#pragma unroll
        for (int j = 0; j < 4; ++j) {
            const f32x4 ww = *(const f32x4*)(w + 4 * lane + 256 * j);
            v[4 * j] *= rstd * ww[0]; v[4 * j + 1] *= rstd * ww[1]; v[4 * j + 2] *= rstd * ww[2]; v[4 * j + 3] *= rstd * ww[3];
            uint2 o; o.x = pk2(v[4 * j], v[4 * j + 1]); o.y = pk2(v[4 * j + 2], v[4 * j + 3]);
            *(uint2*)(outb + (size_t)row * D + 4 * lane + 256 * j) = o;
        }
        if (MODE == 0) {
            float acc[8];
#pragma unroll
            for (int c = 0; c < 8; ++c) acc[c] = 0.f;
#pragma unroll
            for (int j = 0; j < 4; ++j)
#pragma unroll
                for (int e = 0; e < 4; ++e) { const int k = 4 * lane + 256 * j + e; const float* wr = w_in + (size_t)k * 4104 + 2048;
                    const f32x4 w0 = *(const f32x4*)wr, w1 = *(const f32x4*)(wr + 4);
#pragma unroll
                    for (int c = 0; c < 4; ++c) { acc[c] += v[4 * j + e] * w0[c]; acc[4 + c] += v[4 * j + e] * w1[c]; } }
#pragma unroll
            for (int c = 0; c < 8; ++c) acc[c] = wave_sum(acc[c]);
            float r = 0.f;
#pragma unroll
            for (int c = 0; c < 8; ++c) r = (lane == c) ? acc[c] : r;
            if (lane < 4) gb[(size_t)row * 8 + lane] = sigmoid_f(r);
            else if (lane < 8) { const int h = lane - 4; const float xx = r + dt_bias[h]; const float sp = (xx > 20.f) ? xx : log1pf(__expf(xx)); gb[(size_t)row * 8 + lane] = -__expf(A_log[h]) * sp; }
        }
    }
}
__device__ __forceinline__ void trig_phase(const Frame& F, float2* trig) {
    for (int idx = blockIdx.x * 512 + F.tid; idx < 2056 * 64; idx += F.G * 512) {
        const int pi = idx >> 6, i = idx & 63;
        const int pos = pi < 2048 ? pi : 16384 + (pi - 2048);
        const float invf = (float)exp2(-(double)i * (2.0 / 128.0) * 13.287712379549449);
        const double a = (double)pos * (double)invf;
        const double rev = a * 0.15915494309189535;
        const double fr = rev - rint(rev);
        trig[idx] = make_float2(__builtin_amdgcn_cosf((float)fr), __builtin_amdgcn_sinf((float)fr));
    }
}
__device__ __forceinline__ void final_norm_phase(const Frame& F, float* h, const float* w) {
    const int lane = F.lane;
    for (int row = F.gw; row < T; row += F.NGW) {
        float* x = h + (size_t)row * D; f32x4 v[4]; float s = 0.f;
#pragma unroll
        for (int j = 0; j < 4; ++j) { v[j] = *(const f32x4*)(x + 4 * lane + 256 * j); s += v[j][0] * v[j][0] + v[j][1] * v[j][1] + v[j][2] * v[j][2] + v[j][3] * v[j][3]; }
        s = wave_sum(s); const float rstd = rsqrtf(s * (1.f / D) + EPS);
#pragma unroll
        for (int j = 0; j < 4; ++j) { const f32x4 ww = *(const f32x4*)(w + 4 * lane + 256 * j); *(f32x4*)(x + 4 * lane + 256 * j) = v[j] * ww * rstd; }
    }
}
__device__ __forceinline__ void bf8_to_f32(const v4u w, float* o) {
    o[0] = __uint_as_float(w.x << 16); o[1] = __uint_as_float(w.x & 0xffff0000u); o[2] = __uint_as_float(w.y << 16); o[3] = __uint_as_float(w.y & 0xffff0000u);
    o[4] = __uint_as_float(w.z << 16); o[5] = __uint_as_float(w.z & 0xffff0000u); o[6] = __uint_as_float(w.w << 16); o[7] = __uint_as_float(w.w & 0xffff0000u);
}
__device__ __forceinline__ void act_phase(const Frame& F, const bf16* u, int row0, int nrows, const float* cw, const float* cb, const float* st_ffn, bf16* act, float* out) {
    const int total = nrows * 352;
    for (int i = blockIdx.x * 512 + F.tid; i < total; i += F.G * 512) {
        const int lr = i / 352, g8 = i - lr * 352, ch = 8 * g8, row = row0 + lr;
        const bool prompt = row < TP; const int b = prompt ? row / SEQ : (row - TP) / DSEQ; const int pos = prompt ? row % SEQ : (row - TP) % DSEQ; const int L = prompt ? SEQ : DSEQ;
        const int ng = (ch >> 7) * 256 + (ch & 127), nv = ng + 128;
        float xg[3][8], xv[3][8];
#pragma unroll
        for (int r = 0; r < 3; ++r) {
            const int p = pos - 2 + r;
            if (p >= 0) { bf8_to_f32(*(const v4u*)(u + (size_t)(lr - 2 + r) * NUP + ng), xg[r]); bf8_to_f32(*(const v4u*)(u + (size_t)(lr - 2 + r) * NUP + nv), xv[r]); }
            else if (prompt) {
#pragma unroll
                for (int e = 0; e < 8; ++e) { xg[r][e] = 0.f; xv[r][e] = 0.f; }
            } else { const float* sp = st_ffn + ((size_t)b * 2 + (p + 2)) * NUP + ch;
#pragma unroll
                for (int e = 0; e < 8; ++e) { xg[r][e] = sp[e]; xv[r][e] = sp[DFF + e]; } }
        }
        float o[8];
#pragma unroll
        for (int e = 0; e < 8; ++e) {
            const int c = ch + e;
            const float ug = cw[c] * xg[0][e] + cw[NUP + c] * xg[1][e] + cw[2 * NUP + c] * xg[2][e] + cb[c];
            const float uv = cw[DFF + c] * xv[0][e] + cw[NUP + DFF + c] * xv[1][e] + cw[2 * NUP + DFF + c] * xv[2][e] + cb[DFF + c];
            o[e] = silu_f(ug) * uv;
        }
        v4u w; w.x = pk2(o[0], o[1]); w.y = pk2(o[2], o[3]); w.z = pk2(o[4], o[5]); w.w = pk2(o[6], o[7]);
        *(v4u*)(act + (size_t)row * DFF + ch) = w;
        if (pos >= L - 2) { float* op = out + (prompt ? O_FFN_P : O_FFN_S) + ((size_t)b * 2 + (pos - (L - 2))) * NUP + ch;
#pragma unroll
            for (int e = 0; e < 8; ++e) { op[e] = xg[2][e]; op[DFF + e] = xv[2][e]; } }
    }
}

__device__ __forceinline__ float grp_sum128(float v, LAS float* red, int w2, int lane) {
    v = wave_sum(v); __syncthreads(); if (lane == 0) red[w2] = v; __syncthreads(); return red[0] + red[1];
}
__device__ __forceinline__ void dn_item(LAS float* gl, int j, int w2, int lane, bool prompt, int b, int h, bf16* proj, const float* gb, const float* conv_w, const float* dn_norm_w,
                                        const float* st_conv, const float* st_dn, float* out) {
    LAS float* qs = gl; LAS float* ks = gl + 128; LAS float* red = gl + 256;
    const int L = prompt ? SEQ : DSEQ; const size_t row0 = prompt ? (size_t)b * SEQ : (size_t)TP + (size_t)b * DSEQ;
    float S[128];
#pragma unroll
    for (int d = 0; d < 128; ++d) S[d] = prompt ? 0.f : st_dn[((size_t)(b * 4 + h) * 128 + d) * 128 + j];
    const int cq = h * 128 + j, ck = 512 + h * 128 + j, cv = 1024 + h * 128 + j;
    float wq[4], wk[4], wv[4], xq[3], xk[3], xv[3];
#pragma unroll
    for (int i = 0; i < 4; ++i) { wq[i] = conv_w[i * 1536 + cq]; wk[i] = conv_w[i * 1536 + ck]; wv[i] = conv_w[i * 1536 + cv]; }
#pragma unroll
    for (int i = 0; i < 3; ++i) {
        xq[i] = prompt ? 0.f : st_conv[((size_t)b * 3 + i) * 1536 + cq];
        xk[i] = prompt ? 0.f : st_conv[((size_t)b * 3 + i) * 1536 + ck];
        xv[i] = prompt ? 0.f : st_conv[((size_t)b * 3 + i) * 1536 + cv];
    }
    const float nw = dn_norm_w[j];
    for (int t = 0; t < L; ++t) {
        const size_t row = row0 + t; bf16* pr = proj + row * NPROJ;
        const float pq = bf2f(pr[cq]), pk = bf2f(pr[ck]), pv = bf2f(pr[cv]);
        const float q0 = silu_f(wq[0] * xq[0] + wq[1] * xq[1] + wq[2] * xq[2] + wq[3] * pq);
        const float k0 = silu_f(wk[0] * xk[0] + wk[1] * xk[1] + wk[2] * xk[2] + wk[3] * pk);
        const float v0 = silu_f(wv[0] * xv[0] + wv[1] * xv[1] + wv[2] * xv[2] + wv[3] * pv);
        xq[0] = xq[1]; xq[1] = xq[2]; xq[2] = pq; xk[0] = xk[1]; xk[1] = xk[2]; xk[2] = pk; xv[0] = xv[1]; xv[1] = xv[2]; xv[2] = pv;
        const float sq = grp_sum128(q0 * q0, red, w2, lane), sk = grp_sum128(k0 * k0, red, w2, lane);
        qs[j] = q0 * rsqrtf(sq + EPS) * 0.08838834764831845f; ks[j] = k0 * rsqrtf(sk + EPS);
        __syncthreads();
        const float beta = gb[row * 8 + h], a = __expf(gb[row * 8 + 4 + h]);
        float kS = 0.f;
#pragma unroll
        for (int d = 0; d < 128; ++d) kS += ks[d] * S[d];
        const float delta = beta * (v0 - a * kS);
        float o = 0.f;
#pragma unroll
        for (int d = 0; d < 128; ++d) { S[d] = a * S[d] + ks[d] * delta; o += S[d] * qs[d]; }
        const float so = grp_sum128(o * o, red, w2, lane);
        const float z = bf2f(pr[3072 + h * 128 + j]);
        pr[3072 + h * 128 + j] = f2bf(o * rsqrtf(so * (1.f / 128.f) + EPS) * nw * silu_f(z));
    }
    float* so_ = out + (prompt ? O_DN_P : O_DN_S) + (size_t)(b * 4 + h) * 16384;
#pragma unroll
    for (int d = 0; d < 128; ++d) so_[d * 128 + j] = S[d];
    float* co = out + (prompt ? O_DNCONV_P : O_DNCONV_S) + (size_t)b * 3 * 1536;
#pragma unroll
    for (int i = 0; i < 3; ++i) { co[i * 1536 + cq] = xq[i]; co[i * 1536 + ck] = xk[i]; co[i * 1536 + cv] = xv[i]; }
}
__device__ __forceinline__ void ret_item(LAS float* gl, int j, int w2, int lane, bool prompt, int b, int h, bf16* proj, const float2* trig, const float* ret_norm_w, const float* st_ret, float* out) {
    LAS float* qs = gl; LAS float* ks = gl + 128; LAS float* red = gl + 256;
    const int L = prompt ? SEQ : DSEQ; const size_t row0 = prompt ? (size_t)b * SEQ : (size_t)TP + (size_t)b * DSEQ;
    float R[128];
#pragma unroll
    for (int d = 0; d < 128; ++d) R[d] = prompt ? 0.f : st_ret[((size_t)(b * 4 + h) * 128 + d) * 128 + j];
    const float gamma = 1.f - exp2f(-5.f - (float)h);
    const float nw = ret_norm_w[h * 128 + j];
    const int cq = 1536 + h * 128 + j, ck = 2048 + h * 128 + j, cv = 2560 + h * 128 + j, cg = 3584 + h * 128 + j;
    for (int t = 0; t < L; ++t) {
        const size_t row = row0 + t; bf16* pr = proj + row * NPROJ;
        const float q = bf2f(pr[cq]), k = bf2f(pr[ck]), v = bf2f(pr[cv]);
        __syncthreads();
        qs[j] = q; ks[j] = k;
        __syncthreads();
        const float2 cs = trig[(size_t)((prompt ? 0 : 2048) + t) * 64 + (j >> 1)];
        const float qp = qs[j ^ 1], kp = ks[j ^ 1];
        const float qr = (j & 1) ? (qp * cs.y + q * cs.x) : (q * cs.x - qp * cs.y);
        const float kr = ((j & 1) ? (kp * cs.y + k * cs.x) : (k * cs.x - kp * cs.y)) * 0.08838834764831845f;
        __syncthreads();
        qs[j] = qr; ks[j] = kr;
        __syncthreads();
        float o = 0.f;
#pragma unroll
        for (int d = 0; d < 128; ++d) { R[d] = gamma * R[d] + ks[d] * v; o += qs[d] * R[d]; }
        const float mu = grp_sum128(o, red, w2, lane) * (1.f / 128.f);
        const float dlt = o - mu;
        const float var = grp_sum128(dlt * dlt, red, w2, lane) * (1.f / 128.f);
        const float g = bf2f(pr[cg]);
        pr[cg] = f2bf(dlt * rsqrtf(var + EPS) * nw * silu_f(g));
    }
    float* so_ = out + (prompt ? O_RET_P : O_RET_S) + (size_t)(b * 4 + h) * 16384;
#pragma unroll
    for (int d = 0; d < 128; ++d) so_[d * 128 + j] = R[d];
}

__device__ __forceinline__ float grp_sum256(float v, LAS float* red, int w4, int lane) {
    v = wave_sum(v); __syncthreads(); if (lane == 0) red[w4] = v; __syncthreads(); return (red[0] + red[1]) + (red[2] + red[3]);
}
__device__ __forceinline__ void dn_item2(LAS float* gl, int t256, int w4, int lane, bool prompt, int b, int h, bf16* proj, const float* gb, const float* conv_w, const float* dn_norm_w,
                                         const float* st_conv, const float* st_dn, float* out) {
    LAS float* qs = gl; LAS float* ks = gl + 128; LAS float* red = gl + 256;
    const int j = t256 >> 1, half = t256 & 1, d0 = 64 * half; const float once = half ? 0.f : 1.f;
    const int L = prompt ? SEQ : DSEQ; const size_t row0 = prompt ? (size_t)b * SEQ : (size_t)TP + (size_t)b * DSEQ;
    float S[64];
#pragma unroll
    for (int d = 0; d < 64; ++d) S[d] = prompt ? 0.f : st_dn[((size_t)(b * 4 + h) * 128 + d0 + d) * 128 + j];
    const int cq = h * 128 + j, ck = 512 + h * 128 + j, cv = 1024 + h * 128 + j;
    float wq[4], wk[4], wv[4], xq[3], xk[3], xv[3];
#pragma unroll
    for (int i = 0; i < 4; ++i) { wq[i] = conv_w[i * 1536 + cq]; wk[i] = conv_w[i * 1536 + ck]; wv[i] = conv_w[i * 1536 + cv]; }
#pragma unroll
    for (int i = 0; i < 3; ++i) {
        xq[i] = prompt ? 0.f : st_conv[((size_t)b * 3 + i) * 1536 + cq];
        xk[i] = prompt ? 0.f : st_conv[((size_t)b * 3 + i) * 1536 + ck];
        xv[i] = prompt ? 0.f : st_conv[((size_t)b * 3 + i) * 1536 + cv];
    }
    const float nw = dn_norm_w[j];
    for (int t = 0; t < L; ++t) {
        const size_t row = row0 + t; bf16* pr = proj + row * NPROJ;
        const float pq = bf2f(pr[cq]), pk = bf2f(pr[ck]), pv = bf2f(pr[cv]);
        const float q0 = silu_f(wq[0] * xq[0] + wq[1] * xq[1] + wq[2] * xq[2] + wq[3] * pq);
        const float k0 = silu_f(wk[0] * xk[0] + wk[1] * xk[1] + wk[2] * xk[2] + wk[3] * pk);
        const float v0 = silu_f(wv[0] * xv[0] + wv[1] * xv[1] + wv[2] * xv[2] + wv[3] * pv);
        xq[0] = xq[1]; xq[1] = xq[2]; xq[2] = pq; xk[0] = xk[1]; xk[1] = xk[2]; xk[2] = pk; xv[0] = xv[1]; xv[1] = xv[2]; xv[2] = pv;
        const float sq = grp_sum256(q0 * q0 * once, red, w4, lane), sk = grp_sum256(k0 * k0 * once, red, w4, lane);
        if (!half) { qs[j] = q0 * rsqrtf(sq + EPS) * 0.08838834764831845f; ks[j] = k0 * rsqrtf(sk + EPS); }
        __syncthreads();
        const float beta = gb[row * 8 + h], a = __expf(gb[row * 8 + 4 + h]);
        float kS = 0.f;
#pragma unroll
        for (int d = 0; d < 64; ++d) kS += ks[d0 + d] * S[d];
        kS += __shfl_xor(kS, 1);
        const float delta = beta * (v0 - a * kS);
        float o = 0.f;
#pragma unroll
        for (int d = 0; d < 64; ++d) { S[d] = a * S[d] + ks[d0 + d] * delta; o += S[d] * qs[d0 + d]; }
        o += __shfl_xor(o, 1);
        const float so = grp_sum256(o * o * once, red, w4, lane);
        if (!half) { const float z = bf2f(pr[3072 + h * 128 + j]); pr[3072 + h * 128 + j] = f2bf(o * rsqrtf(so * (1.f / 128.f) + EPS) * nw * silu_f(z)); }
    }
    float* so_ = out + (prompt ? O_DN_P : O_DN_S) + (size_t)(b * 4 + h) * 16384;
#pragma unroll
    for (int d = 0; d < 64; ++d) so_[(d0 + d) * 128 + j] = S[d];
    if (!half) { float* co = out + (prompt ? O_DNCONV_P : O_DNCONV_S) + (size_t)b * 3 * 1536;
#pragma unroll
        for (int i = 0; i < 3; ++i) { co[i * 1536 + cq] = xq[i]; co[i * 1536 + ck] = xk[i]; co[i * 1536 + cv] = xv[i]; } }
}
__device__ __forceinline__ void ret_item2(LAS float* gl, int t256, int w4, int lane, bool prompt, int b, int h, bf16* proj, const float2* trig, const float* ret_norm_w, const float* st_ret, float* out) {
    LAS float* qs = gl; LAS float* ks = gl + 128; LAS float* red = gl + 256;
    const int j = t256 >> 1, half = t256 & 1, d0 = 64 * half; const float once = half ? 0.f : 1.f;
    const int L = prompt ? SEQ : DSEQ; const size_t row0 = prompt ? (size_t)b * SEQ : (size_t)TP + (size_t)b * DSEQ;
    float R[64];
#pragma unroll
    for (int d = 0; d < 64; ++d) R[d] = prompt ? 0.f : st_ret[((size_t)(b * 4 + h) * 128 + d0 + d) * 128 + j];
    const float gamma = 1.f - exp2f(-5.f - (float)h);
    const float nw = ret_norm_w[h * 128 + j];
    const int cq = 1536 + h * 128 + j, ck = 2048 + h * 128 + j, cv = 2560 + h * 128 + j, cg = 3584 + h * 128 + j;
    for (int t = 0; t < L; ++t) {
        const size_t row = row0 + t; bf16* pr = proj + row * NPROJ;
        const float q = bf2f(pr[cq]), k = bf2f(pr[ck]), v = bf2f(pr[cv]);
        __syncthreads();
        if (!half) { qs[j] = q; ks[j] = k; }
        __syncthreads();
        const float2 cs = trig[(size_t)((prompt ? 0 : 2048) + t) * 64 + (j >> 1)];
        const float qp = qs[j ^ 1], kp = ks[j ^ 1];
        const float qr = (j & 1) ? (qp * cs.y + q * cs.x) : (q * cs.x - qp * cs.y);
        const float kr = ((j & 1) ? (kp * cs.y + k * cs.x) : (k * cs.x - kp * cs.y)) * 0.08838834764831845f;
        __syncthreads();
        if (!half) { qs[j] = qr; ks[j] = kr; }
        __syncthreads();
        float o = 0.f;
#pragma unroll
        for (int d = 0; d < 64; ++d) { R[d] = gamma * R[d] + ks[d0 + d] * v; o += qs[d0 + d] * R[d]; }
        o += __shfl_xor(o, 1);
        const float mu = grp_sum256(o * once, red, w4, lane) * (1.f / 128.f);
        const float dlt = o - mu;
        const float var = grp_sum256(dlt * dlt * once, red, w4, lane) * (1.f / 128.f);
        if (!half) { const float g = bf2f(pr[cg]); pr[cg] = f2bf(dlt * rsqrtf(var + EPS) * nw * silu_f(g)); }
    }
    float* so_ = out + (prompt ? O_RET_P : O_RET_S) + (size_t)(b * 4 + h) * 16384;
#pragma unroll
    for (int d = 0; d < 64; ++d) so_[(d0 + d) * 128 + j] = R[d];
}


template <class Sched>
__device__ __forceinline__ void build_rstd_tables(const Frame& F, const Sched& S, const float* ssq, int rowbase, LAS float* tbl) {
    pg8::Unit u;
    for (int i = 0; S.next(i, u); ++i) {
        const int r = F.tid >> 1, hsel = F.tid & 1;
        const float* p = ssq + ((size_t)(rowbase + u.pm * 256 + r)) * 16 + hsel * 8;
        const f32x4 a = *(const f32x4*)p, b = *(const f32x4*)(p + 4);
        float s = ((a[0] + a[1]) + (a[2] + a[3])) + ((b[0] + b[1]) + (b[2] + b[3]));
        s += __shfl_xor(s, 1);
        if (!hsel) tbl[i * 256 + r] = rsqrtf(s * (1.f / 1024.f) + EPS);
    }
    __syncthreads();
}
__device__ __forceinline__ void final_norm_phase2(const Frame& F, float* h, const float* ssq, const float* w) {
    const int lane = F.lane;
    for (int row = F.gw; row < T; row += F.NGW) {
        float* x = h + (size_t)row * D;
        float s = lane < 16 ? ssq[(size_t)row * 16 + lane] : 0.f;
        s = wave_sum(s); const float rstd = rsqrtf(s * (1.f / D) + EPS);
#pragma unroll
        for (int j = 0; j < 4; ++j) { const f32x4 v = *(const f32x4*)(x + 4 * lane + 256 * j); const f32x4 ww = *(const f32x4*)(w + 4 * lane + 256 * j); *(f32x4*)(x + 4 * lane + 256 * j) = v * ww * rstd; }
    }
}

typedef __bf16 bfx8 __attribute__((ext_vector_type(8)));
typedef float f32x16 __attribute__((ext_vector_type(16)));
typedef float f32x8 __attribute__((ext_vector_type(8)));
#define MFMA32(a, b, c) __builtin_amdgcn_mfma_f32_32x32x16_bf16((a), (b), (c), 0, 0, 0)
__device__ __forceinline__ int crow(int reg, int h) { return (reg & 3) + 8 * (reg >> 2) + 4 * h; }
__device__ __forceinline__ bfx8 pack8(float a0, float a1, float a2, float a3, float a4, float a5, float a6, float a7) {
    const f32x8 v = {a0, a1, a2, a3, a4, a5, a6, a7}; return __builtin_convertvector(v, bfx8);
}
#define PACK_STEP(x, s) pack8((x)[8 * (s)], (x)[8 * (s) + 1], (x)[8 * (s) + 2], (x)[8 * (s) + 3], (x)[8 * (s) + 4], (x)[8 * (s) + 5], (x)[8 * (s) + 6], (x)[8 * (s) + 7])
__device__ __forceinline__ void st_frag(unsigned char* fragblk, int f, int l, bfx8 v) { *(bfx8*)(fragblk + (size_t)f * 1024 + l * 16) = v; }
constexpr int IMG_STRIDE = 132;
constexpr int IMG_BYTES = 64 * IMG_STRIDE * 4;
constexpr int MAT_STRIDE = 68;
constexpr int MAT_BYTES = 64 * MAT_STRIDE * 4;
constexpr int RET_FRAG_P = 56 * 1024, RET_FRAG_S = 17 * 1024;
constexpr int SLOT_BYTES = 56 * 1024, OBUF_OFF = 2 * SLOT_BYTES, OBUF_STRIDE = 272, OBUF_BYTES = 64 * OBUF_STRIDE;

template <int C>
__device__ __forceinline__ void ret_prep_item(const Frame& F, bool prompt, int b, int h, int chunk, const bf16* proj, const float2* trig, unsigned char* frag) {
    constexpr int MT = C == 64 ? 2 : 1, KS = C == 64 ? 4 : 1;
    LAS float* Qi = (LAS float*)(F.lds); LAS float* Ki = (LAS float*)(F.lds + IMG_BYTES); LAS float* Vi = (LAS float*)(F.lds + 2 * IMG_BYTES);
    LAS float* QKM = (LAS float*)(F.lds + 3 * IMG_BYTES);
    const int tid = F.tid, lane = F.lane, wave = F.wave, hh = lane >> 5, l31 = lane & 31;
    const size_t row0 = prompt ? (size_t)b * SEQ + (size_t)chunk * 64 : (size_t)TP + (size_t)b * DSEQ;
    const int pos0 = prompt ? chunk * 64 : 2048;
    const float lg2 = log2f(1.f - exp2f(-5.f - (float)h));
    for (int w = tid; w < C * 32; w += 512) {
        const int t = w >> 5, c4 = (w & 31) * 4;
        const bf16* pr = proj + (row0 + t) * NPROJ + 1536 + h * 128 + c4;
        const uint2 q2 = *(const uint2*)pr, k2 = *(const uint2*)(pr + 512), v2 = *(const uint2*)(pr + 1024);
        const f32x4 tr = *(const f32x4*)(&trig[(size_t)(pos0 + t) * 64 + (c4 >> 1)]);
        const float q0 = __uint_as_float(q2.x << 16), q1 = __uint_as_float(q2.x & 0xffff0000u), q2_ = __uint_as_float(q2.y << 16), q3 = __uint_as_float(q2.y & 0xffff0000u);
        const float k0 = __uint_as_float(k2.x << 16), k1 = __uint_as_float(k2.x & 0xffff0000u), k2_ = __uint_as_float(k2.y << 16), k3 = __uint_as_float(k2.y & 0xffff0000u);
        const float sc = 0.08838834764831845f;
        f32x4 qo, ko, vo;
        qo[0] = q0 * tr[0] - q1 * tr[1]; qo[1] = q0 * tr[1] + q1 * tr[0]; qo[2] = q2_ * tr[2] - q3 * tr[3]; qo[3] = q2_ * tr[3] + q3 * tr[2];
        ko[0] = (k0 * tr[0] - k1 * tr[1]) * sc; ko[1] = (k0 * tr[1] + k1 * tr[0]) * sc; ko[2] = (k2_ * tr[2] - k3 * tr[3]) * sc; ko[3] = (k2_ * tr[3] + k3 * tr[2]) * sc;
        vo[0] = __uint_as_float(v2.x << 16); vo[1] = __uint_as_float(v2.x & 0xffff0000u); vo[2] = __uint_as_float(v2.y << 16); vo[3] = __uint_as_float(v2.y & 0xffff0000u);
        *(LAS f32x4*)(Qi + t * IMG_STRIDE + c4) = qo; *(LAS f32x4*)(Ki + t * IMG_STRIDE + c4) = ko; *(LAS f32x4*)(Vi + t * IMG_STRIDE + c4) = vo;
    }
    __syncthreads();
    if (wave < (C == 64 ? 3 : 1)) {
        const int mt = wave == 0 ? 0 : 1, nt = wave == 2 ? 1 : 0;
        const int ar = 32 * mt + l31, br = 32 * nt + l31;
        f32x16 acc;
#pragma unroll
        for (int r = 0; r < 16; ++r) acc[r] = 0.f;
#pragma unroll
        for (int ks = 0; ks < 8; ++ks) {
            const int k = 16 * ks + 8 * hh;
            f32x4 a0 = {0.f, 0.f, 0.f, 0.f}, a1 = a0, b0 = a0, b1 = a0;
            if (ar < C) { a0 = *(const LAS f32x4*)(Qi + ar * IMG_STRIDE + k); a1 = *(const LAS f32x4*)(Qi + ar * IMG_STRIDE + k + 4); }
            if (br < C) { b0 = *(const LAS f32x4*)(Ki + br * IMG_STRIDE + k); b1 = *(const LAS f32x4*)(Ki + br * IMG_STRIDE + k + 4); }
            acc = MFMA32(pack8(a0[0], a0[1], a0[2], a0[3], a1[0], a1[1], a1[2], a1[3]), pack8(b0[0], b0[1], b0[2], b0[3], b1[0], b1[1], b1[2], b1[3]), acc);
        }
#pragma unroll
        for (int r = 0; r < 16; ++r) { const int i = 32 * mt + crow(r, hh), j = 32 * nt + l31;
            QKM[i * MAT_STRIDE + j] = (i >= j && i < C) ? acc[r] * exp2f((float)(i - j) * lg2) : 0.f; }
    }
    if (C == 64 && wave == 3) {
#pragma unroll
        for (int r = 0; r < 16; ++r) QKM[crow(r, hh) * MAT_STRIDE + 32 + l31] = 0.f;
    }
    __syncthreads();
    constexpr int NF = MT * 8 + MT * KS + 4 * KS + 4 * KS;
    for (int p = tid; p < NF * 64; p += 512) {
        const int f = p >> 6, l = p & 63, lh = l >> 5, ll = l & 31;
        bfx8 o;
        if (f < MT * 8) {
            const int mt = f >> 3, ks = f & 7, t = 32 * mt + ll, k0 = 32 * (ks >> 1) + 16 * (ks & 1) + 4 * lh;
            f32x4 a0 = {0.f, 0.f, 0.f, 0.f}, a1 = a0;
            if (t < C) { const float sc = exp2f((float)(t + 1) * lg2); a0 = *(const LAS f32x4*)(Qi + t * IMG_STRIDE + k0) * sc; a1 = *(const LAS f32x4*)(Qi + t * IMG_STRIDE + k0 + 8) * sc; }
            o = pack8(a0[0], a0[1], a0[2], a0[3], a1[0], a1[1], a1[2], a1[3]);
        } else if (f < MT * 8 + MT * KS) {
            const int g = f - MT * 8, mt = g / KS, ks = g % KS, i = 32 * mt + ll, k0 = 16 * ks + 8 * lh;
            const f32x4 a0 = *(const LAS f32x4*)(QKM + i * MAT_STRIDE + k0), a1 = *(const LAS f32x4*)(QKM + i * MAT_STRIDE + k0 + 4);
            o = pack8(a0[0], a0[1], a0[2], a0[3], a1[0], a1[1], a1[2], a1[3]);
        } else if (f < MT * 8 + MT * KS + 4 * KS) {
            const int g = f - MT * 8 - MT * KS, mt4 = g / KS, ks = g % KS, d = 32 * mt4 + ll, t0 = 16 * ks + 8 * lh;
            float e[8];
#pragma unroll
            for (int j = 0; j < 8; ++j) { const int t = t0 + j; e[j] = t < C ? Ki[t * IMG_STRIDE + d] * exp2f((float)(C - 1 - t) * lg2) : 0.f; }
            o = pack8(e[0], e[1], e[2], e[3], e[4], e[5], e[6], e[7]);
        } else {
            const int g = f - MT * 8 - MT * KS - 4 * KS, s = g / KS, ks = g % KS, dv = 32 * s + ll, t0 = 16 * ks + 8 * lh;
            float e[8];
#pragma unroll
            for (int j = 0; j < 8; ++j) { const int t = t0 + j; e[j] = t < C ? Vi[t * IMG_STRIDE + dv] : 0.f; }
            o = pack8(e[0], e[1], e[2], e[3], e[4], e[5], e[6], e[7]);
        }
        st_frag(frag, f, l, o);
    }
    __syncthreads();
}

__device__ __forceinline__ void ret_stream(const Frame& F, int b, int h, const unsigned char* frag0, bf16* proj, const float* ret_norm_w, float* out) {
    const int lane = F.lane, wave = F.wave, hh = lane >> 5, l31 = lane & 31;
    constexpr int NC = 32;
    const float cd = exp2f(64.f * log2f(1.f - exp2f(-5.f - (float)h)));
    if (wave < 4) {
        const int s = wave;
        f32x16 R[4];
#pragma unroll
        for (int t = 0; t < 4; ++t)
#pragma unroll
            for (int r = 0; r < 16; ++r) R[t][r] = 0.f;
        for (int c = 0; c < NC; ++c) {
            __syncthreads();
            const LAS unsigned char* slot = F.lds + (c & 1) * SLOT_BYTES + lane * 16;
            LAS unsigned char* ob = F.lds + OBUF_OFF + (c & 1) * OBUF_BYTES;
            f32x16 accO[2];
#pragma unroll
            for (int mt = 0; mt < 2; ++mt)
#pragma unroll
                for (int r = 0; r < 16; ++r) accO[mt][r] = 0.f;
#pragma unroll
            for (int ks = 0; ks < 8; ++ks) {
                const bfx8 rb = (ks & 1) ? PACK_STEP(R[ks >> 1], 1) : PACK_STEP(R[ks >> 1], 0);
#pragma unroll
                for (int mt = 0; mt < 2; ++mt) accO[mt] = MFMA32(*(const LAS bfx8*)(slot + (mt * 8 + ks) * 1024), rb, accO[mt]);
            }
            bfx8 vt[4];
#pragma unroll
            for (int ks = 0; ks < 4; ++ks) vt[ks] = *(const LAS bfx8*)(slot + (40 + s * 4 + ks) * 1024);
#pragma unroll
            for (int ks = 0; ks < 4; ++ks)
#pragma unroll
                for (int mt = 0; mt < 2; ++mt) accO[mt] = MFMA32(*(const LAS bfx8*)(slot + (16 + mt * 4 + ks) * 1024), vt[ks], accO[mt]);
#pragma unroll
            for (int t = 0; t < 4; ++t) {
                R[t] = R[t] * cd;
#pragma unroll
                for (int ks = 0; ks < 4; ++ks) R[t] = MFMA32(*(const LAS bfx8*)(slot + (24 + t * 4 + ks) * 1024), vt[ks], R[t]);
            }
#pragma unroll
            for (int mt = 0; mt < 2; ++mt)
#pragma unroll
                for (int r = 0; r < 16; ++r) *(LAS bf16*)(ob + (32 * mt + crow(r, hh)) * OBUF_STRIDE + (32 * s + l31) * 2) = f2bf(accO[mt][r]);
        }
        __syncthreads();
        float* so = out + O_RET_P + (size_t)(b * 4 + h) * 16384;
#pragma unroll
        for (int t = 0; t < 4; ++t)
#pragma unroll
            for (int r = 0; r < 16; ++r) so[(unsigned)((32 * t + crow(r, hh)) * 128 + 32 * s + l31)] = R[t][r];
    } else {
        const int hw = wave - 4;
#pragma unroll
        for (int i = 0; i < 14; ++i) { const int f = hw + 4 * i;
            __builtin_amdgcn_global_load_lds((const unsigned*)(frag0 + (size_t)f * 1024 + lane * 16), (LAS unsigned*)(F.lds + f * 1024), 16, 0, 0); }
        VM_WAIT();
        for (int c = 0; c <= NC; ++c) {
            __syncthreads();
            if (c + 1 < NC) {
                const unsigned char* src = frag0 + (size_t)(c + 1) * RET_FRAG_P; LAS unsigned char* dst = F.lds + ((c + 1) & 1) * SLOT_BYTES;
#pragma unroll
                for (int i = 0; i < 14; ++i) { const int f = hw + 4 * i;
                    __builtin_amdgcn_global_load_lds((const unsigned*)(src + (size_t)f * 1024 + lane * 16), (LAS unsigned*)(dst + f * 1024), 16, 0, 0); }
            }
            if (c >= 1) {
                const int cc = c - 1, tok = 16 * hw + (lane & 15), part = lane >> 4;
                const LAS unsigned char* ob = F.lds + OBUF_OFF + (cc & 1) * OBUF_BYTES + tok * OBUF_STRIDE + part * 64;
                float o[32];
#pragma unroll
                for (int q = 0; q < 4; ++q) bf8_to_f32(*(const LAS v4u*)(ob + q * 16), o + 8 * q);
                float sm = 0.f;
#pragma unroll
                for (int e = 0; e < 32; ++e) sm += o[e];
                sm += __shfl_xor(sm, 16); sm += __shfl_xor(sm, 32);
                const float mu = sm * (1.f / 128.f); float vs = 0.f;
#pragma unroll
                for (int e = 0; e < 32; ++e) { o[e] -= mu; vs += o[e] * o[e]; }
                vs += __shfl_xor(vs, 16); vs += __shfl_xor(vs, 32);
                const float rstd = rsqrtf(vs * (1.f / 128.f) + EPS);
                bf16* gp = proj + ((size_t)b * SEQ + (size_t)cc * 64 + tok) * NPROJ + 3584 + h * 128 + part * 32;
                const float* nw = ret_norm_w + h * 128 + part * 32;
#pragma unroll
                for (int q = 0; q < 4; ++q) {
                    float g[8]; bf8_to_f32(*(const v4u*)(gp + 8 * q), g);
                    float y[8];
#pragma unroll
                    for (int e = 0; e < 8; ++e) y[e] = o[8 * q + e] * rstd * nw[8 * q + e] * silu_f(g[e]);
                    v4u w; w.x = pk2(y[0], y[1]); w.y = pk2(y[2], y[3]); w.z = pk2(y[4], y[5]); w.w = pk2(y[6], y[7]);
                    *(v4u*)(gp + 8 * q) = w;
                }
            }
            VM_WAIT();
        }
    }
}

__device__ __forceinline__ void ret_sample_item(const Frame& F, bool active, int b, int h, const unsigned char* frag, bf16* proj, const float* ret_norm_w, const float* st_ret, float* out) {
    int lane = F.lane; asm volatile("" : "+v"(lane));
    const int wave = F.wave, s = wave & 3, team = wave >> 2, hh = lane >> 5, l31 = lane & 31;
    LAS float* xch = (LAS float*)(F.lds) + team * 64;
    f32x16 R[4]; f32x16 accO;
    if (active) {
        const float* sp = st_ret + (size_t)(b * 4 + h) * 16384;
#pragma unroll
        for (int t = 0; t < 4; ++t)
#pragma unroll
            for (int r = 0; r < 16; ++r) R[t][r] = sp[(unsigned)((32 * t + crow(r, hh)) * 128 + 32 * s + l31)];
        const unsigned char* fb = frag + lane * 16;
#pragma unroll
        for (int r = 0; r < 16; ++r) accO[r] = 0.f;
#pragma unroll
        for (int ks = 0; ks < 8; ++ks) {
            const bfx8 rb = (ks & 1) ? PACK_STEP(R[ks >> 1], 1) : PACK_STEP(R[ks >> 1], 0);
            accO = MFMA32(*(const bfx8*)(fb + ks * 1024), rb, accO);
        }
        const bfx8 vt = *(const bfx8*)(fb + (13 + s) * 1024);
        accO = MFMA32(*(const bfx8*)(fb + 8 * 1024), vt, accO);
        const float cd = exp2f(8.f * log2f(1.f - exp2f(-5.f - (float)h)));
#pragma unroll
        for (int t = 0; t < 4; ++t) { R[t] = R[t] * cd; R[t] = MFMA32(*(const bfx8*)(fb + (9 + t) * 1024), vt, R[t]); }
#pragma unroll
        for (int r = 0; r < 4; ++r) {
            float sm = accO[r], sq = accO[r] * accO[r];
#pragma unroll
            for (int o = 1; o < 32; o <<= 1) { sm += __shfl_xor(sm, o); sq += __shfl_xor(sq, o); }
            if (l31 == 0) { xch[((4 * hh + r) * 4 + s) * 2] = sm; xch[((4 * hh + r) * 4 + s) * 2 + 1] = sq; }
        }
    }
    __syncthreads();
    if (active) {
#pragma unroll
        for (int r = 0; r < 4; ++r) {
            const int tok = 4 * hh + r; float sm = 0.f, sq = 0.f;
#pragma unroll
            for (int q = 0; q < 4; ++q) { sm += xch[(tok * 4 + q) * 2]; sq += xch[(tok * 4 + q) * 2 + 1]; }
            const float mu = sm * (1.f / 128.f), var = fmaxf(sq * (1.f / 128.f) - mu * mu, 0.f);
            bf16* gp = proj + ((size_t)TP + (size_t)b * DSEQ + tok) * NPROJ + 3584 + h * 128 + 32 * s + l31;
            const float g = bf2f(*gp);
            *gp = f2bf((accO[r] - mu) * rsqrtf(var + EPS) * ret_norm_w[h * 128 + 32 * s + l31] * silu_f(g));
        }
        float* so = out + O_RET_S + (size_t)(b * 4 + h) * 16384;
#pragma unroll
        for (int t = 0; t < 4; ++t)
#pragma unroll
            for (int r = 0; r < 16; ++r) so[(unsigned)((32 * t + crow(r, hh)) * 128 + 32 * s + l31)] = R[t][r];
    }
    __syncthreads();
}

constexpr int DN_FRAG_P = 72 * 1024, DN_FRAG_S = 29 * 1024;
constexpr int VEC_OFF = 3 * IMG_BYTES + 2 * MAT_BYTES;
template <int C>
__device__ __forceinline__ void dn_prep_item(const Frame& F, bool prompt, int b, int h, int chunk, const bf16* proj, const float* gb, const float* conv_w, const float* st_conv,
                                             unsigned char* frag, float* glast, float* out) {
    constexpr int MT = C == 64 ? 2 : 1, KS = C == 64 ? 4 : 1, TQ = C == 64 ? 16 : 8, NQ = C / TQ;
    LAS float* Qi = (LAS float*)(F.lds); LAS float* Ki = (LAS float*)(F.lds + IMG_BYTES); LAS float* Vi = (LAS float*)(F.lds + 2 * IMG_BYTES);
    LAS float* AM = (LAS float*)(F.lds + 3 * IMG_BYTES); LAS float* QKM = (LAS float*)(F.lds + 3 * IMG_BYTES + MAT_BYTES);
    LAS float* gcv = (LAS float*)(F.lds + VEC_OFF); LAS float* betav = gcv + 64; LAS float* egv = gcv + 128;
    const int tid = F.tid, lane = F.lane, wave = F.wave, hh = lane >> 5, l31 = lane & 31;
    const size_t row0 = prompt ? (size_t)b * SEQ + (size_t)chunk * 64 : (size_t)TP + (size_t)b * DSEQ;
    if (tid < 96 * NQ) {
        const int cgi = tid % 96, tq = tid / 96, which = cgi >> 5, c4 = (cgi & 31) * 4, col = which * 512 + h * 128 + c4, t0 = tq * TQ;
        f32x4 w[4];
#pragma unroll
        for (int j = 0; j < 4; ++j) w[j] = *(const f32x4*)(conv_w + j * 1536 + col);
        f32x4 x0, x1, x2;
        if (t0 == 0 && chunk == 0) {
            if (prompt) { x0 = (f32x4){0.f, 0.f, 0.f, 0.f}; x1 = x0; x2 = x0; }
            else { const float* sp = st_conv + (size_t)b * 3 * 1536 + col; x0 = *(const f32x4*)sp; x1 = *(const f32x4*)(sp + 1536); x2 = *(const f32x4*)(sp + 2 * 1536); }
        } else {
            const bf16* pp = proj + (row0 + t0 - 3) * NPROJ + col;
            const uint2 a = *(const uint2*)pp, bq = *(const uint2*)(pp + NPROJ), cq = *(const uint2*)(pp + 2 * NPROJ);
            x0 = (f32x4){__uint_as_float(a.x << 16), __uint_as_float(a.x & 0xffff0000u), __uint_as_float(a.y << 16), __uint_as_float(a.y & 0xffff0000u)};
            x1 = (f32x4){__uint_as_float(bq.x << 16), __uint_as_float(bq.x & 0xffff0000u), __uint_as_float(bq.y << 16), __uint_as_float(bq.y & 0xffff0000u)};
            x2 = (f32x4){__uint_as_float(cq.x << 16), __uint_as_float(cq.x & 0xffff0000u), __uint_as_float(cq.y << 16), __uint_as_float(cq.y & 0xffff0000u)};
        }
        LAS float* img = (which == 0 ? Qi : (which == 1 ? Ki : Vi));
        for (int t = t0; t < t0 + TQ; ++t) {
            const uint2 a = *(const uint2*)(proj + (row0 + t) * NPROJ + col);
            const f32x4 x3 = {__uint_as_float(a.x << 16), __uint_as_float(a.x & 0xffff0000u), __uint_as_float(a.y << 16), __uint_as_float(a.y & 0xffff0000u)};
            const f32x4 y = w[0] * x0 + w[1] * x1 + w[2] * x2 + w[3] * x3;
            f32x4 o;
#pragma unroll
            for (int e = 0; e < 4; ++e) o[e] = silu_f(y[e]);
            *(LAS f32x4*)(img + t * IMG_STRIDE + c4) = o;
            x0 = x1; x1 = x2; x2 = x3;
        }
        if ((prompt && chunk == 31 && tq == NQ - 1) || !prompt) {
            float* co = out + (prompt ? O_DNCONV_P : O_DNCONV_S) + (size_t)b * 3 * 1536 + col;
            *(f32x4*)co = x0; *(f32x4*)(co + 1536) = x1; *(f32x4*)(co + 2 * 1536) = x2;
        }
    }
    __syncthreads();
    if (tid < C * 8) {
        const int tok = tid >> 3, part = tid & 7;
        LAS float* qp = Qi + tok * IMG_STRIDE + part * 16; LAS float* kp = Ki + tok * IMG_STRIDE + part * 16;
        f32x4 q[4], k[4]; float sq = 0.f, sk = 0.f;
#pragma unroll
        for (int i = 0; i < 4; ++i) { q[i] = *(LAS f32x4*)(qp + 4 * i); k[i] = *(LAS f32x4*)(kp + 4 * i);
            sq += q[i][0] * q[i][0] + q[i][1] * q[i][1] + q[i][2] * q[i][2] + q[i][3] * q[i][3]; sk += k[i][0] * k[i][0] + k[i][1] * k[i][1] + k[i][2] * k[i][2] + k[i][3] * k[i][3]; }
        sq += __shfl_xor(sq, 1); sq += __shfl_xor(sq, 2); sq += __shfl_xor(sq, 4);
        sk += __shfl_xor(sk, 1); sk += __shfl_xor(sk, 2); sk += __shfl_xor(sk, 4);
        const float rq = rsqrtf(sq + EPS) * 0.08838834764831845f, rk = rsqrtf(sk + EPS);
#pragma unroll
        for (int i = 0; i < 4; ++i) { *(LAS f32x4*)(qp + 4 * i) = q[i] * rq; *(LAS f32x4*)(kp + 4 * i) = k[i] * rk; }
    }
    if (wave == 7) {
        float g = lane < C ? gb[(row0 + lane) * 8 + 4 + h] : 0.f;
#pragma unroll
        for (int o = 1; o < 64; o <<= 1) { const float t = __shfl_up(g, o); if (lane >= o) g += t; }
        if (lane < C) { gcv[lane] = g; egv[lane] = __expf(g); betav[lane] = gb[(row0 + lane) * 8 + h]; }
        else { gcv[lane] = 0.f; egv[lane] = 0.f; betav[lane] = 0.f; }
    }
    __syncthreads();
    {
        constexpr int NTL = C == 64 ? 3 : 1;
        if (wave < 2 * NTL) {
            const int kind = wave / NTL, ti = wave % NTL, mt = ti == 0 ? 0 : 1, nt = ti == 2 ? 1 : 0;
            const int ar = 32 * mt + l31, br = 32 * nt + l31;
            const LAS float* Ai = kind == 0 ? Ki : Qi;
            f32x16 acc;
#pragma unroll
            for (int r = 0; r < 16; ++r) acc[r] = 0.f;
#pragma unroll
            for (int ks = 0; ks < 8; ++ks) {
                const int k = 16 * ks + 8 * hh;
                f32x4 a0 = {0.f, 0.f, 0.f, 0.f}, a1 = a0, b0 = a0, b1 = a0;
                if (ar < C) { a0 = *(const LAS f32x4*)(Ai + ar * IMG_STRIDE + k); a1 = *(const LAS f32x4*)(Ai + ar * IMG_STRIDE + k + 4); }
                if (br < C) { b0 = *(const LAS f32x4*)(Ki + br * IMG_STRIDE + k); b1 = *(const LAS f32x4*)(Ki + br * IMG_STRIDE + k + 4); }
                acc = MFMA32(pack8(a0[0], a0[1], a0[2], a0[3], a1[0], a1[1], a1[2], a1[3]), pack8(b0[0], b0[1], b0[2], b0[3], b1[0], b1[1], b1[2], b1[3]), acc);
            }
            LAS float* M = kind == 0 ? AM : QKM;
            const int j = 32 * nt + l31; const float gj = gcv[j];
#pragma unroll
            for (int r = 0; r < 16; ++r) { const int i = 32 * mt + crow(r, hh);
                const bool keep = (kind == 0 ? i > j : i >= j) && i < C;
                float v = 0.f;
                if (keep) v = acc[r] * __expf(gcv[i] - gj) * (kind == 0 ? betav[i] : 1.f);
                M[i * MAT_STRIDE + j] = v; }
        } else if (C == 64) {
            LAS float* M = wave == 6 ? AM : QKM;
#pragma unroll
            for (int r = 0; r < 16; ++r) M[crow(r, hh) * MAT_STRIDE + 32 + l31] = 0.f;
        }
    }
    {
        constexpr int F_KT = 2 * MT * 8 + MT * KS;
        const float gl = gcv[C - 1];
        for (int p = tid; p < 4 * KS * 64; p += 512) {
            const int g = p >> 6, l = p & 63, lh = l >> 5, ll = l & 31, mt4 = g / KS, ks = g % KS, d = 32 * mt4 + ll, k0 = 32 * (ks >> 1) + 16 * (ks & 1) + 4 * lh;
            float e[8];
#pragma unroll
            for (int j = 0; j < 8; ++j) { const int t = k0 + (j & 3) + 8 * (j >> 2); e[j] = t < C ? Ki[t * IMG_STRIDE + d] * __expf(gl - gcv[t]) : 0.f; }
            st_frag(frag, F_KT + g, l, pack8(e[0], e[1], e[2], e[3], e[4], e[5], e[6], e[7]));
        }
    }
    __syncthreads();
    if (wave < 4) {
        const bool isw = wave >= 2; const int c = tid & 127;
        LAS float* img = (isw ? Ki : Vi) + c;
        for (int t = 0; t < C; ++t) img[t * IMG_STRIDE] *= betav[t] * (isw ? egv[t] : 1.f);
        constexpr int BS = C == 64 ? 16 : 8, NBK = C / BS;
        for (int blk = 0; blk < NBK; ++blk) {
            const int r0 = blk * BS;
            float x[BS];
#pragma unroll
            for (int i = 0; i < BS; ++i) x[i] = img[(r0 + i) * IMG_STRIDE];
#pragma unroll
            for (int i = 1; i < BS; ++i) {
                float a0 = 0.f, a1 = 0.f, a2 = 0.f, a3 = 0.f;
#pragma unroll
                for (int q = 0; q < (i + 3) / 4; ++q) {
                    const f32x4 a = *(const LAS f32x4*)(AM + (r0 + i) * MAT_STRIDE + r0 + 4 * q);
                    a0 += a[0] * x[4 * q];
                    if (4 * q + 1 < i) a1 += a[1] * x[4 * q + 1];
                    if (4 * q + 2 < i) a2 += a[2] * x[4 * q + 2];
                    if (4 * q + 3 < i) a3 += a[3] * x[4 * q + 3];
                }
                x[i] -= (a0 + a1) + (a2 + a3);
            }
#pragma unroll
            for (int i = 0; i < BS; ++i) img[(r0 + i) * IMG_STRIDE] = x[i];
            for (int r = r0 + BS; r < C; ++r) {
                float a0 = 0.f, a1 = 0.f, a2 = 0.f, a3 = 0.f;
#pragma unroll
                for (int q = 0; q < BS / 4; ++q) {
                    const f32x4 a = *(const LAS f32x4*)(AM + r * MAT_STRIDE + r0 + 4 * q);
                    a0 += a[0] * x[4 * q]; a1 += a[1] * x[4 * q + 1]; a2 += a[2] * x[4 * q + 2]; a3 += a[3] * x[4 * q + 3];
                }
                img[r * IMG_STRIDE] -= (a0 + a1) + (a2 + a3);
            }
        }
    } else {
        constexpr int F_QD = MT * 8, F_QK = 2 * MT * 8, NFH = MT * 8 + MT * KS;
        for (int p = tid - 256; p < NFH * 64; p += 256) {
            const int fi = p >> 6, l = p & 63, lh = l >> 5, ll = l & 31;
            bfx8 o; int f;
            if (fi < MT * 8) {
                const int mt = fi >> 3, ks = fi & 7, t = 32 * mt + ll, k0 = 32 * (ks >> 1) + 16 * (ks & 1) + 4 * lh;
                f32x4 a0 = {0.f, 0.f, 0.f, 0.f}, a1 = a0;
                if (t < C) { const float sc = egv[t]; a0 = *(const LAS f32x4*)(Qi + t * IMG_STRIDE + k0) * sc; a1 = *(const LAS f32x4*)(Qi + t * IMG_STRIDE + k0 + 8) * sc; }
                o = pack8(a0[0], a0[1], a0[2], a0[3], a1[0], a1[1], a1[2], a1[3]); f = F_QD + fi;
            } else {
                const int g = fi - MT * 8, mt = g / KS, ks = g % KS, i = 32 * mt + ll, k0 = 32 * (ks >> 1) + 16 * (ks & 1) + 4 * lh;
                const f32x4 a0 = *(const LAS f32x4*)(QKM + i * MAT_STRIDE + k0), a1 = *(const LAS f32x4*)(QKM + i * MAT_STRIDE + k0 + 8);
                o = pack8(a0[0], a0[1], a0[2], a0[3], a1[0], a1[1], a1[2], a1[3]); f = F_QK + g;
            }
            st_frag(frag, f, l, o);
        }
    }
    __syncthreads();
    {
        constexpr int F_U = 2 * MT * 8 + MT * KS + 4 * KS, NF6 = MT * 8 + 4 * MT * 2;
        for (int p = tid; p < NF6 * 64; p += 512) {
            const int fi = p >> 6, l = p & 63, lh = l >> 5, ll = l & 31;
            bfx8 o; int f;
            if (fi < MT * 8) {
                const int mt = fi >> 3, ks = fi & 7, t = 32 * mt + ll, k0 = 32 * (ks >> 1) + 16 * (ks & 1) + 4 * lh;
                f32x4 a0 = {0.f, 0.f, 0.f, 0.f}, a1 = a0;
                if (t < C) { a0 = -*(const LAS f32x4*)(Ki + t * IMG_STRIDE + k0); a1 = -*(const LAS f32x4*)(Ki + t * IMG_STRIDE + k0 + 8); }
                o = pack8(a0[0], a0[1], a0[2], a0[3], a1[0], a1[1], a1[2], a1[3]); f = fi;
            } else {
                const int g = fi - MT * 8, half = g & 1, sm = g >> 1, mt = sm % MT, s = sm / MT, dv = 32 * s + ll;
                float e[8];
#pragma unroll
                for (int j = 0; j < 8; ++j) { const int t = 32 * mt + crow(8 * half + j, lh); e[j] = t < C ? Vi[t * IMG_STRIDE + dv] : 0.f; }
                o = pack8(e[0], e[1], e[2], e[3], e[4], e[5], e[6], e[7]); f = F_U + g;
            }
            st_frag(frag, f, l, o);
        }
        if (tid == 0) *glast = egv[C - 1];
    }
    __syncthreads();
}

__device__ __forceinline__ void dn_stream(const Frame& F, int b, int h, const unsigned char* frag_lo, const unsigned char* frag_hi, int split,
                                          const float* glast, bf16* proj, const float* dn_norm_w, float* out) {
    const int lane = F.lane, wave = F.wave, hh = lane >> 5, l31 = lane & 31;
    constexpr int NC = 32;
    const int it0 = (b * 4 + h) * 32;
#define DN_ITEM_PTR(c) (((it0 + (c)) < split) ? frag_lo + (size_t)(it0 + (c)) * DN_FRAG_P : frag_hi + (size_t)(it0 + (c) - split) * DN_FRAG_P)
    if (wave < 4) {
        const int s = wave;
        f32x16 S[4];
#pragma unroll
        for (int t = 0; t < 4; ++t)
#pragma unroll
            for (int r = 0; r < 16; ++r) S[t][r] = 0.f;
        for (int c = 0; c < NC; ++c) {
            const unsigned char* ub = DN_ITEM_PTR(c) + (size_t)(56 + s * 4) * 1024 + lane * 16;
            const v4u u00 = *(const v4u*)(ub), u01 = *(const v4u*)(ub + 1024), u10 = *(const v4u*)(ub + 2048), u11 = *(const v4u*)(ub + 3072);
            const float dec = glast[it0 + c];
            __syncthreads();
            const LAS unsigned char* slot = F.lds + (c & 1) * SLOT_BYTES + lane * 16;
            LAS unsigned char* ob = F.lds + OBUF_OFF + (c & 1) * OBUF_BYTES;
            f32x16 accV[2], accO[2];
            { float t8[8];
              bf8_to_f32(u00, t8);
#pragma unroll
              for (int e = 0; e < 8; ++e) accV[0][e] = t8[e];
              bf8_to_f32(u01, t8);
#pragma unroll
              for (int e = 0; e < 8; ++e) accV[0][8 + e] = t8[e];
              bf8_to_f32(u10, t8);
#pragma unroll
              for (int e = 0; e < 8; ++e) accV[1][e] = t8[e];
              bf8_to_f32(u11, t8);
#pragma unroll
              for (int e = 0; e < 8; ++e) accV[1][8 + e] = t8[e]; }
#pragma unroll
            for (int mt = 0; mt < 2; ++mt)
#pragma unroll
                for (int r = 0; r < 16; ++r) accO[mt][r] = 0.f;
#pragma unroll
            for (int ks = 0; ks < 8; ++ks) {
                const bfx8 sb = (ks & 1) ? PACK_STEP(S[ks >> 1], 1) : PACK_STEP(S[ks >> 1], 0);
#pragma unroll
                for (int mt = 0; mt < 2; ++mt) {
                    accV[mt] = MFMA32(*(const LAS bfx8*)(slot + (mt * 8 + ks) * 1024), sb, accV[mt]);
                    accO[mt] = MFMA32(*(const LAS bfx8*)(slot + (16 + mt * 8 + ks) * 1024), sb, accO[mt]);
                }
                if (ks & 1) asm volatile("" ::: "memory");
            }
            bfx8 vb[4];
            vb[0] = PACK_STEP(accV[0], 0); vb[1] = PACK_STEP(accV[0], 1); vb[2] = PACK_STEP(accV[1], 0); vb[3] = PACK_STEP(accV[1], 1);
#pragma unroll
            for (int ks = 0; ks < 4; ++ks)
#pragma unroll
                for (int mt = 0; mt < 2; ++mt) accO[mt] = MFMA32(*(const LAS bfx8*)(slot + (32 + mt * 4 + ks) * 1024), vb[ks], accO[mt]);
#pragma unroll
            for (int t = 0; t < 4; ++t) {
                S[t] = S[t] * dec;
#pragma unroll
                for (int ks = 0; ks < 4; ++ks) S[t] = MFMA32(*(const LAS bfx8*)(slot + (40 + t * 4 + ks) * 1024), vb[ks], S[t]);
            }
#pragma unroll
            for (int mt = 0; mt < 2; ++mt)
#pragma unroll
                for (int r = 0; r < 16; ++r) *(LAS bf16*)(ob + (32 * mt + crow(r, hh)) * OBUF_STRIDE + (32 * s + l31) * 2) = f2bf(accO[mt][r]);
        }
        __syncthreads();
        float* so = out + O_DN_P + (size_t)(b * 4 + h) * 16384;
#pragma unroll
        for (int t = 0; t < 4; ++t)
#pragma unroll
            for (int r = 0; r < 16; ++r) so[(unsigned)((32 * t + crow(r, hh)) * 128 + 32 * s + l31)] = S[t][r];
    } else {
        const int hw = wave - 4;
        { const unsigned char* src = DN_ITEM_PTR(0);
#pragma unroll
          for (int i = 0; i < 14; ++i) { const int f = hw + 4 * i;
              __builtin_amdgcn_global_load_lds((const unsigned*)(src + (size_t)f * 1024 + lane * 16), (LAS unsigned*)(F.lds + f * 1024), 16, 0, 0); } }
        VM_WAIT();
        for (int c = 0; c <= NC; ++c) {
            __syncthreads();
            if (c + 1 < NC) {
                const unsigned char* src = DN_ITEM_PTR(c + 1); LAS unsigned char* dst = F.lds + ((c + 1) & 1) * SLOT_BYTES;
#pragma unroll
                for (int i = 0; i < 14; ++i) { const int f = hw + 4 * i;
                    __builtin_amdgcn_global_load_lds((const unsigned*)(src + (size_t)f * 1024 + lane * 16), (LAS unsigned*)(dst + f * 1024), 16, 0, 0); }
            }
            if (c >= 1) {
                const int cc = c - 1, tok = 16 * hw + (lane & 15), part = lane >> 4;
                const LAS unsigned char* ob = F.lds + OBUF_OFF + (cc & 1) * OBUF_BYTES + tok * OBUF_STRIDE + part * 64;
                float o[32];
#pragma unroll
                for (int q = 0; q < 4; ++q) bf8_to_f32(*(const LAS v4u*)(ob + q * 16), o + 8 * q);
                float vs = 0.f;
#pragma unroll
                for (int e = 0; e < 32; ++e) vs += o[e] * o[e];
                vs += __shfl_xor(vs, 16); vs += __shfl_xor(vs, 32);
                const float rstd = rsqrtf(vs * (1.f / 128.f) + EPS);
                bf16* gp = proj + ((size_t)b * SEQ + (size_t)cc * 64 + tok) * NPROJ + 3072 + h * 128 + part * 32;
                const float* nw = dn_norm_w + part * 32;
#pragma unroll
                for (int q = 0; q < 4; ++q) {
                    float g[8]; bf8_to_f32(*(const v4u*)(gp + 8 * q), g);
                    float y[8];
#pragma unroll
                    for (int e = 0; e < 8; ++e) y[e] = o[8 * q + e] * rstd * nw[8 * q + e] * silu_f(g[e]);
                    v4u w; w.x = pk2(y[0], y[1]); w.y = pk2(y[2], y[3]); w.z = pk2(y[4], y[5]); w.w = pk2(y[6], y[7]);
                    *(v4u*)(gp + 8 * q) = w;
                }
            }
            VM_WAIT();
        }
    }
#undef DN_ITEM_PTR
}

__device__ __forceinline__ void dn_sample_item(const Frame& F, bool active, int b, int h, const unsigned char* frag, float dec, bf16* proj, const float* dn_norm_w, const float* st_dn, float* out) {
    int lane = F.lane; asm volatile("" : "+v"(lane));
    const int wave = F.wave, s = wave & 3, team = wave >> 2, hh = lane >> 5, l31 = lane & 31;
    LAS float* xch = (LAS float*)(F.lds) + team * 64;
    f32x16 S[4]; f32x16 accO;
    if (active) {
        const float* sp = st_dn + (size_t)(b * 4 + h) * 16384;
#pragma unroll
        for (int t = 0; t < 4; ++t)
#pragma unroll
            for (int r = 0; r < 16; ++r) S[t][r] = sp[(unsigned)((32 * t + crow(r, hh)) * 128 + 32 * s + l31)];
        const unsigned char* fb = frag + lane * 16;
        f32x16 accV;
        { const v4u u0 = *(const v4u*)(fb + (21 + s * 2) * 1024), u1 = *(const v4u*)(fb + (22 + s * 2) * 1024); float t8[8];
          bf8_to_f32(u0, t8);
#pragma unroll
          for (int e = 0; e < 8; ++e) accV[e] = t8[e];
          bf8_to_f32(u1, t8);
#pragma unroll
          for (int e = 0; e < 8; ++e) accV[8 + e] = t8[e]; }
#pragma unroll
        for (int r = 0; r < 16; ++r) accO[r] = 0.f;
#pragma unroll
        for (int ks = 0; ks < 8; ++ks) {
            const bfx8 sb = (ks & 1) ? PACK_STEP(S[ks >> 1], 1) : PACK_STEP(S[ks >> 1], 0);
            accV = MFMA32(*(const bfx8*)(fb + ks * 1024), sb, accV);
            accO = MFMA32(*(const bfx8*)(fb + (8 + ks) * 1024), sb, accO);
        }
        const bfx8 vb = PACK_STEP(accV, 0);
        accO = MFMA32(*(const bfx8*)(fb + 16 * 1024), vb, accO);
#pragma unroll
        for (int t = 0; t < 4; ++t) { S[t] = S[t] * dec; S[t] = MFMA32(*(const bfx8*)(fb + (17 + t) * 1024), vb, S[t]); }
#pragma unroll
        for (int r = 0; r < 4; ++r) {
            float sq = accO[r] * accO[r];
#pragma unroll
            for (int o = 1; o < 32; o <<= 1) sq += __shfl_xor(sq, o);
            if (l31 == 0) xch[(4 * hh + r) * 4 + s] = sq;
        }
    }
    __syncthreads();
    if (active) {
#pragma unroll
        for (int r = 0; r < 4; ++r) {
            const int tok = 4 * hh + r;
            const float sq = (xch[tok * 4] + xch[tok * 4 + 1]) + (xch[tok * 4 + 2] + xch[tok * 4 + 3]);
            bf16* gp = proj + ((size_t)TP + (size_t)b * DSEQ + tok) * NPROJ + 3072 + h * 128 + 32 * s + l31;
            const float z = bf2f(*gp);
            *gp = f2bf(accO[r] * rsqrtf(sq * (1.f / 128.f) + EPS) * dn_norm_w[32 * s + l31] * silu_f(z));
        }
        float* so = out + O_DN_S + (size_t)(b * 4 + h) * 16384;
#pragma unroll
        for (int t = 0; t < 4; ++t)
#pragma unroll
            for (int r = 0; r < 16; ++r) so[(unsigned)((32 * t + crow(r, hh)) * 128 + 32 * s + l31)] = S[t][r];
    }
    __syncthreads();
}
constexpr int N_PHASES = 13;
#ifndef DN_CHUNKED
#define DN_CHUNKED 0
#endif
__global__ void __launch_bounds__(NWAVES * 64, 2) mk_fwd(Args args) {
    extern __shared__ __attribute__((aligned(16))) unsigned char lds[];
    Frame F;
    F.lds = (LAS unsigned char*)lds;
    F.MISC = (volatile LAS unsigned*)(F.lds + MISC_OFF);
    F.tid = threadIdx.x; F.lane = F.tid & 63; F.wave = __builtin_amdgcn_readfirstlane(F.tid >> 6);
    F.G = gridDim.x;
    { const int bx = blockIdx.x; const int vcu = (F.G % 8 == 0) ? (bx % 8) * (F.G / 8) + bx / 8 : bx; F.gw = vcu * NWAVES + F.wave; F.NGW = F.G * NWAVES; }
    F.ctl = (gu32*)(args.dws + WS_CTL);
    for (int u = F.tid; u < (LDS_BYTES - LDSCTL_OFF) / 4; u += NWAVES * 64) ((LAS unsigned*)(F.lds + LDSCTL_OFF))[u] = 0u;
    __syncthreads();
    XcdBarrier bar = xcd_barrier_post((unsigned*)(F.ctl + CW_BAR) + args.li * XCD_BAR_WORDS, F.MISC + 8);
    const int lo = args.ph_lo, hi = args.ph_hi;
#define IN(k) (lo <= (k) && (k) < hi)
#define SEAM(k) do { if (IN(k) && IN((k) + 1)) xcd_barrier(bar); } while (0)
#define out (args.dout)
#define hf (args.dout + O_Y)
#define ws (args.dws)
#define nbuf ((bf16*)(args.dws + WS_NBUF))
#define big ((bf16*)(args.dws + WS_BIG))
#define act ((bf16*)(args.dws + WS_ACT))
#define Wt_in ((bf16*)(args.dws + WS_WIN))
#define Wt_out ((bf16*)(args.dws + WS_WOUT))
#define Wt_up ((bf16*)(args.dws + WS_WUP))
#define Wt_down ((bf16*)(args.dws + WS_WDOWN))
#define Wt_gate ((bf16*)(args.dws + WS_WGATE))
#define Wt_ple ((bf16*)(args.dws + WS_WPLE))
#define gb ((float*)(args.dws + WS_GB))
#define trig ((float2*)(args.dws + WS_TRIG))
#define pe ((bf16*)(args.dws + WS_PE))
#define pb ((bf16*)(args.dws + WS_PB))
#define fr_ret_p ((unsigned char*)(args.dout + O_Y))
#define fr_ret_s (fr_ret_p + (size_t)1024 * RET_FRAG_P)
    constexpr int DN_SPLIT = 480;
#define fr_dn_lo (args.dws + WS_NBUF)
#define fr_dn_hi (args.dws + WS_FRHI)
#define fr_dn_s (fr_dn_hi + (size_t)(1024 - DN_SPLIT) * DN_FRAG_P)
#define glast_p ((float*)(args.dws + WS_GLAST))
#define glast_s (glast_p + 1024)
#define ssqa ((float*)(args.dws + WS_SSQA))
#define ssqb ((float*)(args.dws + WS_SSQB))
#define RTBL ((LAS float*)(F.lds + RING_BYTES))
    using pg8::Gemm; using pg8::StaticOrder; using pg8::EpiStore; using pg8::EpiResid; using pg8::EpiPle; using pg8::EpiResidN; using pg8::EpiScaleStore; using pg8::EpiPleN;
    const int bx = blockIdx.x;

    if (IN(0)) {
        trig_phase(F, trig);
        LAS float* scr = (LAS float*)(F.lds + RING_OFF + F.wave * 16384);
        constexpr int I_IN = 16 * 128, I_OUT = 16 * 32, I_UP = 16 * 176, I_DOWN = 44 * 32, I_GATE = 16 * 32, I_PLEI = 4 * 32;
        constexpr int NITEMS = I_IN + I_OUT + I_UP + I_DOWN + I_GATE + I_PLEI;
        for (int it = F.gw; it < NITEMS; it += F.NGW) {
            int r = it;
            if (r < I_IN) { const int kb = r / 128, nb = r % 128; transpose_item(args.in[I_WIN], 4104, proj_orig_col(32 * nb), D, Wt_in, 32 * nb, 64 * kb, scr, F.lane, nullptr); continue; } r -= I_IN;
            if (r < I_OUT) { const int kb = r / 32, nb = r % 32; transpose_item(args.in[I_WOUT], D, 32 * nb, D, Wt_out, 32 * nb, 64 * kb, scr, F.lane, nullptr); continue; } r -= I_OUT;
            if (r < I_UP) { const int kb = r / 176, nb = r % 176; transpose_item(args.in[I_WUP], NUP, up_orig_col(32 * nb), D, Wt_up, 32 * nb, 64 * kb, scr, F.lane, args.in[I_FFN_NW]); continue; } r -= I_UP;
            if (r < I_DOWN) { const int kb = r / 32, nb = r % 32; transpose_item(args.in[I_WDOWN], D, 32 * nb, DFF, Wt_down, 32 * nb, 64 * kb, scr, F.lane, nullptr); continue; } r -= I_DOWN;
            if (r < I_GATE) { const int kb = r / 32, nb = r % 32; transpose_item(args.in[I_WGATE], D, 32 * nb, D, Wt_gate, 32 * nb, 64 * kb, scr, F.lane, args.in[I_PLE_NW]); continue; } r -= I_GATE;
            { const int kb = r / 32, nb = r % 32; transpose_item(args.in[I_WPLE], D, 32 * nb, PLE, Wt_ple, 32 * nb, 64 * kb, scr, F.lane, nullptr); }
        }
        rows_norm_phase<0>(F, args.in[I_XP], args.in[I_XS], args.in[I_ATTN_NW], nbuf, args.in[I_WIN], args.in[I_ALOG], args.in[I_DTB], gb);
    }
    SEAM(0);
    if (IN(1)) {
        Gemm g{nbuf, Wt_in, T, NPROJ, D, D, D}; StaticOrder S; S.init(T, NPROJ, F.G, bx);
        EpiStore E{big, NPROJ};
        pg8::gemm_phase<EpiStore, StaticOrder, true, true>(F.lds + RING_OFF, g, S, E);
    }
    SEAM(1);
    if (IN(2)) {
        for (int it = bx; it < 1024; it += F.G) { const int bh = it >> 5, c = it & 31;
            dn_prep_item<64>(F, true, bh >> 2, bh & 3, c, big, gb, args.in[I_DN_CONVW], args.in[I_ST_CONV],
                             it < DN_SPLIT ? fr_dn_lo + (size_t)it * DN_FRAG_P : fr_dn_hi + (size_t)(it - DN_SPLIT) * DN_FRAG_P, glast_p + it, out); }
        for (int it = bx; it < 1024; it += F.G) { const int bh = it >> 5, c = it & 31; ret_prep_item<64>(F, true, bh >> 2, bh & 3, c, big, trig, fr_ret_p + (size_t)it * RET_FRAG_P); }
        for (int it = bx; it < 512; it += F.G) dn_prep_item<8>(F, false, it >> 2, it & 3, 0, big, gb, args.in[I_DN_CONVW], args.in[I_ST_CONV], fr_dn_s + (size_t)it * DN_FRAG_S, glast_s + it, out);
        for (int it = bx; it < 512; it += F.G) ret_prep_item<8>(F, false, it >> 2, it & 3, 0, big, trig, fr_ret_s + (size_t)it * RET_FRAG_S);
    }
    SEAM(2);
    if (IN(3)) {
        if (bx < 32) dn_stream(F, bx >> 2, bx & 3, fr_dn_lo, fr_dn_hi, DN_SPLIT, glast_p, big, args.in[I_DN_NW], out);
        else if (bx < 64) ret_stream(F, (bx - 32) >> 2, bx & 3, fr_ret_p + (size_t)(bx - 32) * 32 * RET_FRAG_P, big, args.in[I_RET_NW], out);
        else {
            const int tm = (bx - 64) * 2 + (F.wave >> 2);
#pragma unroll 1
            for (int k = 0; k < 3; ++k) {
                const int idx = tm + 384 * k;
                if (idx < 512) dn_sample_item(F, true, idx >> 2, idx & 3, fr_dn_s + (size_t)idx * DN_FRAG_S, glast_s[idx], big, args.in[I_DN_NW], args.in[I_ST_DN], out);
                else { const int it = idx - 512; const bool active = it < 512;
                    ret_sample_item(F, active, it >> 2, it & 3, fr_ret_s + (size_t)(active ? it : 0) * RET_FRAG_S, big, args.in[I_RET_NW], args.in[I_ST_RET], out); }
            }
        }
    }
    SEAM(3);
    if (IN(4)) {
        Gemm g{big + 3072, Wt_out, T, D, D, NPROJ, D}; StaticOrder S; S.init(T, D, F.G, bx);
        EpiResidN E{hf, args.in[I_XP], args.in[I_XS], nbuf, ssqa};
        pg8::gemm_phase<EpiResidN, StaticOrder, true, true>(F.lds + RING_OFF, g, S, E);
    }
    SEAM(4);
    if (IN(5)) {
        Gemm g{nbuf, Wt_up, 8192, NUP, D, D, D}; StaticOrder S; S.init(8192, NUP, F.G, bx);
        build_rstd_tables(F, S, ssqa, 0, RTBL);
        EpiScaleStore E{big, NUP, RTBL};
        pg8::gemm_phase<EpiScaleStore, StaticOrder, true, true>(F.lds + RING_OFF, g, S, E);
    }
    SEAM(5);
    if (IN(6)) act_phase(F, big, 0, 8192, args.in[I_FFN_CW], args.in[I_FFN_CB], args.in[I_ST_FFN], act, out);
    SEAM(6);
    if (IN(7)) {
        Gemm g{nbuf + (size_t)8192 * D, Wt_up, T - 8192, NUP, D, D, D}; StaticOrder S; S.init(T - 8192, NUP, F.G, bx);
        build_rstd_tables(F, S, ssqa, 8192, RTBL);
        EpiScaleStore E{big, NUP, RTBL};
        pg8::gemm_phase<EpiScaleStore, StaticOrder, true, true>(F.lds + RING_OFF, g, S, E);
    }
    SEAM(7);
    if (IN(8)) act_phase(F, big, 8192, T - 8192, args.in[I_FFN_CW], args.in[I_FFN_CB], args.in[I_ST_FFN], act, out);
    SEAM(8);
    if (IN(9)) {
        Gemm g{act, Wt_down, T, D, DFF, DFF, DFF}; StaticOrder S; S.init(T, D, F.G, bx);
        EpiResidN E{hf, nullptr, nullptr, nbuf, ssqb};
        pg8::gemm_phase<EpiResidN, StaticOrder, true, true>(F.lds + RING_OFF, g, S, E);
        const float* pp = args.in[I_PP]; const float* ps = args.in[I_PS];
        const size_t n4 = (size_t)T * PLE / 4, np4 = (size_t)TP * PLE / 4;
        for (size_t i = (size_t)bx * 512 + F.tid; i < n4; i += (size_t)F.G * 512) {
            const f32x4 v = i < np4 ? ((const f32x4*)pp)[i] : ((const f32x4*)ps)[i - np4];
            uint2 o; o.x = pk2(v[0], v[1]); o.y = pk2(v[2], v[3]); ((uint2*)pb)[i] = o;
        }
    }
    SEAM(9);
    if (IN(10)) {
        Gemm g{pb, Wt_ple, T, D, PLE, PLE, PLE}; StaticOrder S; S.init(T, D, F.G, bx);
        EpiStore E{pe, D};
        pg8::gemm_phase<EpiStore, StaticOrder, true, true>(F.lds + RING_OFF, g, S, E);
    }
    SEAM(10);
    if (IN(11)) {
        Gemm g{nbuf, Wt_gate, T, D, D, D, D}; StaticOrder S; S.init(T, D, F.G, bx);
        build_rstd_tables(F, S, ssqb, 0, RTBL);
        EpiPleN E{hf, pe, RTBL, ssqa};
        pg8::gemm_phase<EpiPleN, StaticOrder, true, true>(F.lds + RING_OFF, g, S, E);
    }
    SEAM(11);
    if (IN(12)) final_norm_phase2(F, hf, ssqa, args.in[I_FINAL_NW]);
#undef IN
#undef SEAM
#undef out
#undef hf
#undef ws
#undef nbuf
#undef big
#undef act
#undef Wt_in
#undef Wt_out
#undef Wt_up
#undef Wt_down
#undef Wt_gate
#undef Wt_ple
#undef gb
#undef trig
#undef pe
#undef pb
#undef fr_ret_p
#undef fr_ret_s
#undef fr_dn_lo
#undef fr_dn_hi
#undef fr_dn_s
#undef glast_p
#undef glast_s
#undef ssqa
#undef ssqb
#undef RTBL
}

extern "C" void kernel_launch(void* const* d_in, const int* in_sizes, int n_in, void* d_out, int out_size, void* d_ws, size_t ws_size, hipStream_t stream) {
    static int grid = 0;
    if (grid == 0) {
        int dev = 0, cus = 0;
        if (n_in != 25 || ws_size < WS_END) { fprintf(stderr, "kernel_launch: unexpected n_in %d / ws_size %zu\n", n_in, ws_size); grid = -1; return; }
        if (hipGetDevice(&dev) != hipSuccess || hipDeviceGetAttribute(&cus, hipDeviceAttributeMultiprocessorCount, dev) != hipSuccess) { grid = -1; return; }
        if (hipFuncSetAttribute((const void*)mk_fwd, hipFuncAttributeMaxDynamicSharedMemorySize, LDS_BYTES) != hipSuccess) { fprintf(stderr, "kernel_launch: hipFuncSetAttribute failed\n"); grid = -1; return; }
        (void)hipGetLastError();
        grid = cus;
    }
    if (grid < 0) return;
    (void)hipMemsetAsync((char*)d_ws + WS_CTL, 0, CTL_ZERO_BYTES, stream);
    Args a{};
    for (int i = 0; i < 25; ++i) a.in[i] = (const float*)d_in[i];
    a.dout = (float*)d_out; a.dws = (unsigned char*)d_ws;
    a.ph_lo = 0; a.ph_hi = N_PHASES; a.li = 0;
    hipLaunchKernelGGL(mk_fwd, dim3(grid), dim3(NWAVES * 64), LDS_BYTES, stream, a);
}
```

```cpp
#include <hip/hip_runtime.h>
#include <cstdio>
#include <cstdint>

typedef unsigned short bf16;
constexpr int TP = 16384, TS = 1024, T = TP + TS;
constexpr int D = 1024, NPROJ = 4096, DFF = 2816, NUP = 5632, PLE = 256;
constexpr int SEQ = 2048, DSEQ = 8, NB = 8, NSB = 128;
constexpr float EPS = 1e-6f;

constexpr size_t O_Y = 0, O_DNCONV_P = 17825792, O_DN_P = 17862656, O_RET_P = 18386944, O_FFN_P = 18911232,
                 O_DNCONV_S = 19001344, O_DN_S = 19591168, O_RET_S = 27979776, O_FFN_S = 36368384;

__device__ __forceinline__ float bf2f(bf16 v) { return __uint_as_float(((unsigned)v) << 16); }
__device__ __forceinline__ bf16 f2bf(float f) { unsigned u = __float_as_uint(f); return (bf16)((u + 0x7fffu + ((u >> 16) & 1u)) >> 16); }
__device__ __forceinline__ float silu_f(float x) { return x / (1.f + __expf(-x)); }
__device__ __forceinline__ float sigmoid_f(float x) { return 1.f / (1.f + __expf(-x)); }
__device__ __forceinline__ float wave_sum(float v) {
#pragma unroll
    for (int o = 1; o < 64; o <<= 1) v += __shfl_xor(v, o);
    return v;
}
__host__ __device__ __forceinline__ int proj_orig_col(int n) {
    if (n < 1536) return n;
    if (n < 3072) return 2056 + (n - 1536);
    if (n < 3584) return 1536 + (n - 3072);
    return 3592 + (n - 3584);
}
__host__ __device__ __forceinline__ int up_orig_col(int n) { const int t = n >> 8, half = (n >> 7) & 1, j = n & 127; return half * DFF + 128 * t + j; }

namespace pg8 {
#define PG8_LAS __attribute__((address_space(3)))
typedef unsigned short bf16_t;
typedef short bf16x8 __attribute__((ext_vector_type(8)));
typedef float f32x4 __attribute__((ext_vector_type(4)));
typedef unsigned u32x4 __attribute__((ext_vector_type(4)));
constexpr int BM = 256, BK = 64, HALF = 128, HTB = HALF * BK * 2  , STAGE_BYTES = 8 * HTB, NXCD = 8, WGM = 8;

__host__ __device__ __forceinline__ int lds_byte(int r, int c) { const int st = (r >> 4) * 2 + (c >> 5), rr = r & 15, cc = c & 31, ob = rr * 64 + cc * 2; return st * 1024 + (ob ^ (((ob >> 9) & 1) << 5)); }
__host__ __device__ __forceinline__ void stage_rc(int b, int& R, int& C) { const int st = b / 1024, sb = b % 1024, swz = sb ^ (((sb >> 9) & 1) << 5); R = (st >> 1) * 16 + swz / 64; C = (st & 1) * 32 + (swz % 64) / 2; }
__host__ __device__ __forceinline__ int perm32(int rho) { const int n = rho >> 4, i = rho & 15; return 8 * (i >> 2) + 4 * n + (i & 3); }

struct Unit { int pm, pn; };
struct Gemm { const bf16_t* A; const bf16_t* Bt; int M, N, K, lda, ldb; };

struct StaticOrder {
    int nM, nN, nwg, G, c;
    __host__ __device__ void init(int M, int N, int G_, int c_) { nM = M / BM; nN = N / BM; nwg = nM * nN; G = G_; c = c_; }
    __host__ __device__ bool next(int i, Unit& u) const {
        const long L = (long)i * G + c; if (L >= nwg) return false;
        int wgid = (int)L; { const int q = nwg / NXCD, r = nwg % NXCD, xcd = wgid % NXCD, off = wgid / NXCD; wgid = (xcd < r ? xcd * (q + 1) : r * (q + 1) + (xcd - r) * q) + off; }
        const int nig = WGM * nN, gid = wgid / nig, fm = gid * WGM, gsz = (nM - fm) < WGM ? (nM - fm) : WGM;
        u.pm = fm + ((wgid % nig) % gsz); u.pn = (wgid % nig) / gsz; return true;
    }
    __device__ __forceinline__ void a_ready(const Unit&) const {}
    __device__ __forceinline__ void done(const Unit&) const {}
};

__device__ __forceinline__ unsigned cvt_pk_bf16(float lo, float hi) { unsigned r; asm volatile("v_cvt_pk_bf16_f32 %0, %1, %2" : "=v"(r) : "v"(lo), "v"(hi)); return r; }

struct EpiStore {
    static constexpr bool PERM = true, AFTER_DRAIN = false;
    bf16_t* O; int ldc;
    __device__ __forceinline__ void operator()(const f32x4 (&acc)[2][2][4][2], const Unit& u, int wr, int wc, int fr, int fq, int ui) const {
        const int row0 = u.pm * BM + wr * 64 + fr, col0 = u.pn * BM + wc * 32 + 8 * fq;
#pragma unroll
        for (int ai = 0; ai < 2; ++ai)
#pragma unroll
            for (int m = 0; m < 4; ++m) { bf16_t* rowp = O + (size_t)(row0 + ai * HALF + m * 16) * ldc + col0;
#pragma unroll
                for (int bj = 0; bj < 2; ++bj) { const f32x4 v0 = acc[ai][bj][m][0], v1 = acc[ai][bj][m][1];
                    u32x4 w; w.x = cvt_pk_bf16(v0[0], v0[1]); w.y = cvt_pk_bf16(v0[2], v0[3]); w.z = cvt_pk_bf16(v1[0], v1[1]); w.w = cvt_pk_bf16(v1[2], v1[3]);
                    *(u32x4*)(rowp + bj * HALF) = w; } }
    }
};
struct EpiResid {
    static constexpr bool PERM = true, AFTER_DRAIN = false;
    float* hf; const float* xp; const float* xs;
    __device__ __forceinline__ void operator()(const f32x4 (&acc)[2][2][4][2], const Unit& u, int wr, int wc, int fr, int fq, int ui) const {
        const int row0 = u.pm * BM + wr * 64 + fr, col0 = u.pn * BM + wc * 32 + 8 * fq;
#pragma unroll
        for (int ai = 0; ai < 2; ++ai)
#pragma unroll
            for (int m = 0; m < 4; ++m) { const int row = row0 + ai * HALF + m * 16;
                const float* bp = xs ? (row < 16384 ? xp + (size_t)row * 1024 : xs + (size_t)(row - 16384) * 1024) : hf + (size_t)row * 1024;
                float* op = hf + (size_t)row * 1024;
#pragma unroll
                for (int bj = 0; bj < 2; ++bj) { const int c = col0 + bj * HALF;
                    const f32x4 b0 = *(const f32x4*)(bp + c), b1 = *(const f32x4*)(bp + c + 4);
                    *(f32x4*)(op + c) = b0 + acc[ai][bj][m][0]; *(f32x4*)(op + c + 4) = b1 + acc[ai][bj][m][1]; } }
    }
};
struct EpiPle {
    static constexpr bool PERM = true, AFTER_DRAIN = false;
    float* hf; const bf16_t* pe;
    __device__ __forceinline__ void operator()(const f32x4 (&acc)[2][2][4][2], const Unit& u, int wr, int wc, int fr, int fq, int ui) const {
        const int row0 = u.pm * BM + wr * 64 + fr, col0 = u.pn * BM + wc * 32 + 8 * fq;
#pragma unroll
        for (int ai = 0; ai < 2; ++ai)
#pragma unroll
            for (int m = 0; m < 4; ++m) { const int row = row0 + ai * HALF + m * 16; float* op = hf + (size_t)row * 1024;
#pragma unroll
                for (int bj = 0; bj < 2; ++bj) { const int c = col0 + bj * HALF;
                    const u32x4 pw = *(const u32x4*)(pe + (size_t)row * 1024 + c);
                    const f32x4 h0 = *(const f32x4*)(op + c), h1 = *(const f32x4*)(op + c + 4);
                    const f32x4 a0 = acc[ai][bj][m][0], a1 = acc[ai][bj][m][1];
                    f32x4 p0, p1;
                    p0[0] = __uint_as_float(pw.x << 16); p0[1] = __uint_as_float(pw.x & 0xffff0000u); p0[2] = __uint_as_float(pw.y << 16); p0[3] = __uint_as_float(pw.y & 0xffff0000u);
                    p1[0] = __uint_as_float(pw.z << 16); p1[1] = __uint_as_float(pw.z & 0xffff0000u); p1[2] = __uint_as_float(pw.w << 16); p1[3] = __uint_as_float(pw.w & 0xffff0000u);
                    f32x4 o0, o1;
#pragma unroll
                    for (int e = 0; e < 4; ++e) { o0[e] = h0[e] + p0[e] / (1.f + __expf(-a0[e])); o1[e] = h1[e] + p1[e] / (1.f + __expf(-a1[e])); }
                    *(f32x4*)(op + c) = o0; *(f32x4*)(op + c + 4) = o1; } }
    }
};


struct EpiResidN {
    static constexpr bool PERM = true, AFTER_DRAIN = false;
    float* hf; const float* xp; const float* xs; bf16_t* hb; float* ssq;
    __device__ __forceinline__ void operator()(const f32x4 (&acc)[2][2][4][2], const Unit& u, int wr, int wc, int fr, int fq, int ui) const {
        const int row0 = u.pm * BM + wr * 64 + fr, col0 = u.pn * BM + wc * 32 + 8 * fq;
#pragma unroll
        for (int ai = 0; ai < 2; ++ai)
#pragma unroll
            for (int m = 0; m < 4; ++m) { const int row = row0 + ai * HALF + m * 16;
                const float* bp = xs ? (row < 16384 ? xp + (size_t)row * 1024 : xs + (size_t)(row - 16384) * 1024) : hf + (size_t)row * 1024;
                float* op = hf + (size_t)row * 1024; bf16_t* ob = hb + (size_t)row * 1024; float s = 0.f;
#pragma unroll
                for (int bj = 0; bj < 2; ++bj) { const int c = col0 + bj * HALF;
                    const f32x4 v0 = *(const f32x4*)(bp + c) + acc[ai][bj][m][0], v1 = *(const f32x4*)(bp + c + 4) + acc[ai][bj][m][1];
                    *(f32x4*)(op + c) = v0; *(f32x4*)(op + c + 4) = v1;
                    s += (v0[0] * v0[0] + v0[1] * v0[1]) + (v0[2] * v0[2] + v0[3] * v0[3]) + (v1[0] * v1[0] + v1[1] * v1[1]) + (v1[2] * v1[2] + v1[3] * v1[3]);
                    u32x4 w; w.x = cvt_pk_bf16(v0[0], v0[1]); w.y = cvt_pk_bf16(v0[2], v0[3]); w.z = cvt_pk_bf16(v1[0], v1[1]); w.w = cvt_pk_bf16(v1[2], v1[3]);
                    *(u32x4*)(ob + c) = w; }
                s += __shfl_xor(s, 16); s += __shfl_xor(s, 32);
                if (fq == 0) ssq[(size_t)row * 16 + u.pn * 4 + wc] = s; }
    }
};
struct EpiScaleStore {
    static constexpr bool PERM = true, AFTER_DRAIN = false;
    bf16_t* O; int ldc; const PG8_LAS float* tbl;
    __device__ __forceinline__ void operator()(const f32x4 (&acc)[2][2][4][2], const Unit& u, int wr, int wc, int fr, int fq, int ui) const {
        const int row0 = u.pm * BM + wr * 64 + fr, col0 = u.pn * BM + wc * 32 + 8 * fq;
#pragma unroll
        for (int ai = 0; ai < 2; ++ai)
#pragma unroll
            for (int m = 0; m < 4; ++m) { bf16_t* rowp = O + (size_t)(row0 + ai * HALF + m * 16) * ldc + col0;
                const float rs = tbl[ui * 256 + ai * HALF + wr * 64 + m * 16 + fr];
#pragma unroll
                for (int bj = 0; bj < 2; ++bj) { const f32x4 v0 = acc[ai][bj][m][0] * rs, v1 = acc[ai][bj][m][1] * rs;
                    u32x4 w; w.x = cvt_pk_bf16(v0[0], v0[1]); w.y = cvt_pk_bf16(v0[2], v0[3]); w.z = cvt_pk_bf16(v1[0], v1[1]); w.w = cvt_pk_bf16(v1[2], v1[3]);
                    *(u32x4*)(rowp + bj * HALF) = w; } }
    }
};
struct EpiPleN {
    static constexpr bool PERM = true, AFTER_DRAIN = false;
    float* hf; const bf16_t* pe; const PG8_LAS float* tbl; float* ssq;
    __device__ __forceinline__ void operator()(const f32x4 (&acc)[2][2][4][2], const Unit& u, int wr, int wc, int fr, int fq, int ui) const {
        const int row0 = u.pm * BM + wr * 64 + fr, col0 = u.pn * BM + wc * 32 + 8 * fq;
#pragma unroll
        for (int ai = 0; ai < 2; ++ai)
#pragma unroll
            for (int m = 0; m < 4; ++m) { const int row = row0 + ai * HALF + m * 16; float* op = hf + (size_t)row * 1024; float s = 0.f;
                const float rs = tbl[ui * 256 + ai * HALF + wr * 64 + m * 16 + fr];
#pragma unroll
                for (int bj = 0; bj < 2; ++bj) { const int c = col0 + bj * HALF;
                    const u32x4 pw = *(const u32x4*)(pe + (size_t)row * 1024 + c);
                    const f32x4 h0 = *(const f32x4*)(op + c), h1 = *(const f32x4*)(op + c + 4);
                    const f32x4 a0 = acc[ai][bj][m][0] * rs, a1 = acc[ai][bj][m][1] * rs;
                    f32x4 p0, p1;
                    p0[0] = __uint_as_float(pw.x << 16); p0[1] = __uint_as_float(pw.x & 0xffff0000u); p0[2] = __uint_as_float(pw.y << 16); p0[3] = __uint_as_float(pw.y & 0xffff0000u);
                    p1[0] = __uint_as_float(pw.z << 16); p1[1] = __uint_as_float(pw.z & 0xffff0000u); p1[2] = __uint_as_float(pw.w << 16); p1[3] = __uint_as_float(pw.w & 0xffff0000u);
                    f32x4 o0, o1;
#pragma unroll
                    for (int e = 0; e < 4; ++e) { o0[e] = h0[e] + p0[e] / (1.f + __expf(-a0[e])); o1[e] = h1[e] + p1[e] / (1.f + __expf(-a1[e])); }
                    *(f32x4*)(op + c) = o0; *(f32x4*)(op + c + 4) = o1;
                    s += (o0[0] * o0[0] + o0[1] * o0[1]) + (o0[2] * o0[2] + o0[3] * o0[3]) + (o1[0] * o1[0] + o1[1] * o1[1]) + (o1[2] * o1[2] + o1[3] * o1[3]); }
                s += __shfl_xor(s, 16); s += __shfl_xor(s, 32);
                if (fq == 0) ssq[(size_t)row * 16 + u.pn * 4 + wc] = s; }
    }
};


template <int N> __device__ __forceinline__ float dpp_row_prev(float cur, float prevreg) {
    const int w = __builtin_amdgcn_update_dpp(0, __float_as_int(prevreg), 0x100 + (16 - N), 0xf, 0xf, false);
    return __int_as_float(__builtin_amdgcn_update_dpp(w, __float_as_int(cur), 0x110 + N, 0xf, 0xf, false));
}
struct EpiFfnAct {
    static constexpr bool PERM = true, AFTER_DRAIN = false;
    bf16_t* act; bf16_t* us; float* ub; const float* cw; const float* cb; const PG8_LAS float* tbl;
    __device__ __forceinline__ void operator()(const f32x4 (&acc)[2][2][4][2], const Unit& u, int wr, int wc, int fr, int fq, int ui) const {
        if (u.pm >= 64) {
            const int row0 = (u.pm - 64) * BM + wr * 64 + fr, col0 = u.pn * BM + wc * 32 + 8 * fq;
#pragma unroll
            for (int ai = 0; ai < 2; ++ai)
#pragma unroll
                for (int m = 0; m < 4; ++m) { bf16_t* rowp = us + (size_t)(row0 + ai * HALF + m * 16) * 5632 + col0;
                    const float rs = tbl[ui * 256 + ai * HALF + wr * 64 + m * 16 + fr];
#pragma unroll
                    for (int bj = 0; bj < 2; ++bj) { const f32x4 v0 = acc[ai][bj][m][0] * rs, v1 = acc[ai][bj][m][1] * rs;
                        u32x4 w; w.x = cvt_pk_bf16(v0[0], v0[1]); w.y = cvt_pk_bf16(v0[2], v0[3]); w.z = cvt_pk_bf16(v1[0], v1[1]); w.w = cvt_pk_bf16(v1[2], v1[3]);
                        *(u32x4*)(rowp + bj * HALF) = w; } }
            return;
        }
        const int ch0 = 128 * u.pn + 32 * wc + 8 * fq, colg = 256 * u.pn + 32 * wc + 8 * fq;
        typedef float f32x2 __attribute__((ext_vector_type(2)));
#pragma unroll
        for (int np = 0; np < 4; ++np) {
            const int n = np >> 1, e0 = 2 * (np & 1), ch = ch0 + 4 * n + e0;
            const f32x2 wg0 = *(const f32x2*)(cw + ch), wg1 = *(const f32x2*)(cw + 5632 + ch), wg2 = *(const f32x2*)(cw + 2 * 5632 + ch), bg = *(const f32x2*)(cb + ch);
            const f32x2 wv0 = *(const f32x2*)(cw + 2816 + ch), wv1 = *(const f32x2*)(cw + 5632 + 2816 + ch), wv2 = *(const f32x2*)(cw + 2 * 5632 + 2816 + ch), bv = *(const f32x2*)(cb + 2816 + ch);
#pragma unroll
            for (int ai = 0; ai < 2; ++ai) {
                const int G = 4 * u.pm + 2 * ai + wr;
                f32x2 pg = {0.f, 0.f}, pv = pg;
#pragma unroll
                for (int m = 0; m < 4; ++m) {
                    const float rs = tbl[ui * 256 + ai * HALF + wr * 64 + m * 16 + fr];
                    f32x2 xg, xv, a;
                    xg[0] = acc[ai][0][m][n][e0] * rs; xg[1] = acc[ai][0][m][n][e0 + 1] * rs; xv[0] = acc[ai][1][m][n][e0] * rs; xv[1] = acc[ai][1][m][n][e0 + 1] * rs;
#pragma unroll
                    for (int e = 0; e < 2; ++e) {
                        const float g1 = dpp_row_prev<1>(xg[e], pg[e]), g2 = dpp_row_prev<2>(xg[e], pg[e]);
                        const float v1 = dpp_row_prev<1>(xv[e], pv[e]), v2 = dpp_row_prev<2>(xv[e], pv[e]);
                        const float yg = wg0[e] * g2 + wg1[e] * g1 + wg2[e] * xg[e] + bg[e];
                        const float yv = wv0[e] * v2 + wv1[e] * v1 + wv2[e] * xv[e] + bv[e];
                        a[e] = yg / (1.f + __expf(-yg)) * yv;
                    }
                    const int q = 16 * m + fr;
                    if (q >= 2) *(unsigned*)(act + (size_t)(64 * G + q) * 2816 + ch) = cvt_pk_bf16(a[0], a[1]);
                    if ((m == 0 && fr < 2) || (m == 3 && fr >= 14)) { const int slot = m == 0 ? fr : fr - 12;
                        float* bp = ub + ((size_t)G * 4 + slot) * 5632 + colg + 4 * n + e0; *(f32x2*)bp = xg; *(f32x2*)(bp + 128) = xv; }
                    pg = xg; pv = xv;
                }
            }
            asm volatile("" ::: "memory");
        }
    }
};


template <class Epi, class Sched, bool ALIGN_EPI = false, bool SP2 = false>
__device__ __forceinline__ void gemm_phase(PG8_LAS unsigned char* lds, const Gemm g, const Sched& S, const Epi& E) {
    const int tid = threadIdx.x, wid = __builtin_amdgcn_readfirstlane(tid >> 6), lane = tid & 63, wr = wid >> 2, wc = wid & 3, fr = lane & 15, fq = lane >> 4;
    const int K = g.K, nt = K / BK;
    unsigned voffA[2], voffB[2];
#pragma unroll
    for (int i = 0; i < 2; ++i) { int R, C; stage_rc(tid * 16 + i * 8192, R, C); const int Rb = Epi::PERM ? ((R & ~31) + perm32(R & 31)) : R;
        voffA[i] = (unsigned)(R * g.lda + C) * 2u; voffB[i] = (unsigned)(Rb * g.ldb + C) * 2u; }
    const size_t kstep = (size_t)(BK * 2);
    const size_t hstepA = (size_t)HALF * g.lda * 2, hstepB = (size_t)HALF * g.ldb * 2;
    const size_t tstepA = 2 * hstepA, tstepB = 2 * hstepB;
    const unsigned ldsw = (unsigned)wid * 1024u;
    const int aoff = lds_byte(wr * 64 + fr, fq * 8), boff = lds_byte(wc * 32 + fr, fq * 8);
#define PG8_SA(b, h) (((b) * 2 + (h)) * HTB)
#define PG8_SB(b, h) ((4 + (b) * 2 + (h)) * HTB)
#define PG8_STAGE(bufoff, gbase, voff) do { _Pragma("unroll") for (int _i = 0; _i < 2; ++_i) \
        __builtin_amdgcn_global_load_lds((const unsigned*)((const char*)(gbase) + (voff)[_i]), (PG8_LAS unsigned*)(lds + (bufoff) + ldsw + _i * 8192), 16, 0, 0); } while (0)
#define PG8_LDA(dst, b, h) do { _Pragma("unroll") for (int m = 0; m < 4; ++m) _Pragma("unroll") for (int k = 0; k < 2; ++k) dst[m][k] = *(const PG8_LAS bf16x8*)(lds + PG8_SA(b, h) + aoff + m * 2048 + k * 1024); } while (0)
#define PG8_LDB(dst, b, h) do { _Pragma("unroll") for (int n = 0; n < 2; ++n) _Pragma("unroll") for (int k = 0; k < 2; ++k) dst[n][k] = *(const PG8_LAS bf16x8*)(lds + PG8_SB(b, h) + boff + n * 2048 + k * 1024); } while (0)
#define PG8_MMA(ai, bj, At, Bt) do { __builtin_amdgcn_s_setprio(1); _Pragma("unroll") for (int m = 0; m < 4; ++m) _Pragma("unroll") for (int n = 0; n < 2; ++n) _Pragma("unroll") for (int k = 0; k < 2; ++k) \
        acc[ai][bj][m][n] = __builtin_amdgcn_mfma_f32_16x16x32_bf16(Bt[n][k], At[m][k], acc[ai][bj][m][n], 0, 0, 0); __builtin_amdgcn_s_setprio(0); } while (0)
#define PG8_WAIT_V(n) asm volatile("s_waitcnt vmcnt(" #n ")" ::: "memory")
#define PG8_WAIT_L(n) asm volatile("s_waitcnt lgkmcnt(" #n ")" ::: "memory")
#define PG8_BAR __builtin_amdgcn_s_barrier()
#define PG8_SCHED __builtin_amdgcn_sched_barrier(0)
    Unit cur, nxt; int ui = 0;
    if (!S.next(0, cur)) return;
    f32x4 acc[2][2][4][2];
#pragma unroll
    for (int a = 0; a < 2; ++a)
#pragma unroll
        for (int b = 0; b < 2; ++b)
#pragma unroll
            for (int m = 0; m < 4; ++m)
#pragma unroll
                for (int n = 0; n < 2; ++n) acc[a][b][m][n] = (f32x4){0.f, 0.f, 0.f, 0.f};
    bf16x8 At[4][2], B0[2][2], B1[2][2];
    const char* cA = (const char*)g.A + (size_t)cur.pm * tstepA; const char* cB = (const char*)g.Bt + (size_t)cur.pn * tstepB;
    S.a_ready(cur);
    if constexpr (SP2) {
        PG8_STAGE(PG8_SB(0, 0), cB, voffB); PG8_STAGE(PG8_SB(0, 1), cB + hstepB, voffB); PG8_STAGE(PG8_SA(0, 0), cA, voffA); PG8_STAGE(PG8_SA(0, 1), cA + hstepA, voffA);
        if (wr == 1) PG8_BAR;
        PG8_WAIT_V(2); PG8_BAR;
        PG8_STAGE(PG8_SB(1, 0), cB + kstep, voffB); PG8_STAGE(PG8_SA(1, 0), cA + kstep, voffA); PG8_STAGE(PG8_SB(1, 1), cB + hstepB + kstep, voffB);
        PG8_WAIT_V(6); PG8_BAR;
    } else {
        PG8_STAGE(PG8_SB(0, 0), cB, voffB); PG8_STAGE(PG8_SA(0, 0), cA, voffA); PG8_STAGE(PG8_SB(0, 1), cB + hstepB, voffB); PG8_STAGE(PG8_SA(0, 1), cA + hstepA, voffA);
        if (wr == 1) PG8_BAR;
        PG8_WAIT_V(4); PG8_BAR;
        PG8_STAGE(PG8_SB(1, 0), cB + kstep, voffB); PG8_STAGE(PG8_SA(1, 0), cA + kstep, voffA); PG8_STAGE(PG8_SB(1, 1), cB + hstepB + kstep, voffB);
        PG8_WAIT_V(6); PG8_BAR;
    }
    for (;;) {
        const bool has_next = S.next(ui + 1, nxt);
        const char* nA = has_next ? (const char*)g.A + (size_t)nxt.pm * tstepA : cA; const char* nB = has_next ? (const char*)g.Bt + (size_t)nxt.pn * tstepB : cB;
        for (int t = 0; t < nt; t += 2) {
            const bool last = (t == nt - 2);
            const char* a1 = cA + (size_t)(t + 1) * kstep;
            const char* a2 = last ? nA : cA + (size_t)(t + 2) * kstep; const char* b2 = last ? nB : cB + (size_t)(t + 2) * kstep;
            const char* a3 = a2 + kstep; const char* b3 = b2 + kstep;
            if (last && has_next) S.a_ready(nxt);
            if constexpr (SP2) {
            PG8_LDB(B0, 0, 0); PG8_LDB(B1, 0, 1); PG8_SCHED; PG8_LDA(At, 0, 0); PG8_STAGE(PG8_SA(1, 1), a1 + hstepA, voffA);
            PG8_WAIT_V(8); PG8_WAIT_L(0); PG8_BAR; PG8_MMA(0, 0, At, B0); PG8_MMA(0, 1, At, B1); PG8_BAR; PG8_SCHED;
            PG8_LDA(At, 0, 1); PG8_STAGE(PG8_SB(0, 0), b2, voffB); PG8_STAGE(PG8_SB(0, 1), b2 + hstepB, voffB); PG8_STAGE(PG8_SA(0, 0), a2, voffA);
            PG8_WAIT_V(8); PG8_WAIT_L(0); PG8_BAR; PG8_MMA(1, 0, At, B0); PG8_MMA(1, 1, At, B1); PG8_BAR; PG8_SCHED;
            PG8_LDB(B0, 1, 0); PG8_LDB(B1, 1, 1); PG8_SCHED; PG8_LDA(At, 1, 0); PG8_STAGE(PG8_SA(0, 1), a2 + hstepA, voffA);
            PG8_WAIT_V(8); PG8_WAIT_L(0); PG8_BAR; PG8_MMA(0, 0, At, B0); PG8_MMA(0, 1, At, B1); PG8_BAR; PG8_SCHED;
            PG8_LDA(At, 1, 1); PG8_STAGE(PG8_SB(1, 0), b3, voffB); PG8_STAGE(PG8_SB(1, 1), b3 + hstepB, voffB); PG8_STAGE(PG8_SA(1, 0), a3, voffA);
            PG8_WAIT_V(8); PG8_WAIT_L(0); PG8_BAR; PG8_MMA(1, 0, At, B0); PG8_MMA(1, 1, At, B1); PG8_BAR; PG8_SCHED;
            } else {
            PG8_LDB(B0, 0, 0); PG8_SCHED; PG8_LDA(At, 0, 0); PG8_STAGE(PG8_SA(1, 1), a1 + hstepA, voffA);
            PG8_WAIT_L(8); PG8_BAR; PG8_WAIT_L(0); PG8_MMA(0, 0, At, B0); PG8_BAR; PG8_SCHED;
            PG8_LDB(B1, 0, 1); PG8_STAGE(PG8_SB(0, 0), b2, voffB);
            PG8_BAR; PG8_WAIT_L(0); PG8_MMA(0, 1, At, B1); PG8_BAR;
            PG8_LDA(At, 0, 1); PG8_STAGE(PG8_SA(0, 0), a2, voffA);
            PG8_BAR; PG8_WAIT_L(0); PG8_MMA(1, 0, At, B0); PG8_BAR; PG8_SCHED;
            PG8_STAGE(PG8_SB(0, 1), b2 + hstepB, voffB);
            PG8_WAIT_V(6); PG8_BAR; PG8_MMA(1, 1, At, B1); PG8_BAR;
            PG8_LDB(B0, 1, 0); PG8_SCHED; PG8_LDA(At, 1, 0); PG8_STAGE(PG8_SA(0, 1), a2 + hstepA, voffA);
            PG8_WAIT_L(8); PG8_BAR; PG8_WAIT_L(0); PG8_MMA(0, 0, At, B0); PG8_BAR; PG8_SCHED;
            PG8_LDB(B1, 1, 1); PG8_STAGE(PG8_SB(1, 0), b3, voffB);
            PG8_BAR; PG8_WAIT_L(0); PG8_MMA(0, 1, At, B1); PG8_BAR;
            PG8_LDA(At, 1, 1); PG8_STAGE(PG8_SA(1, 0), a3, voffA);
            PG8_BAR; PG8_WAIT_L(0); PG8_MMA(1, 0, At, B0); PG8_BAR; PG8_SCHED;
            PG8_STAGE(PG8_SB(1, 1), b3 + hstepB, voffB);
            PG8_WAIT_V(6); PG8_BAR; PG8_MMA(1, 1, At, B1); PG8_BAR;
            }
        }
        if constexpr (ALIGN_EPI) { if (wr == 0) PG8_BAR; }
        if constexpr (!Epi::AFTER_DRAIN) { E(acc, cur, wr, wc, fr, fq, ui); S.done(cur); }
        if (!has_next) break;
#pragma unroll
        for (int a = 0; a < 2; ++a)
#pragma unroll
            for (int b = 0; b < 2; ++b)
#pragma unroll
                for (int m = 0; m < 4; ++m)
#pragma unroll
                    for (int n = 0; n < 2; ++n) acc[a][b][m][n] = (f32x4){0.f, 0.f, 0.f, 0.f};
        cur = nxt; cA = nA; cB = nB; ++ui;
        if constexpr (ALIGN_EPI) { if (wr == 1) PG8_BAR; }
    }
    PG8_WAIT_V(0);
    if constexpr (!ALIGN_EPI) { if (wr == 0) PG8_BAR; }
    PG8_BAR;
    if constexpr (Epi::AFTER_DRAIN) { E.fused(acc, cur, wr, wc, fr, fq, lds, wid, lane); S.done(cur); }
#undef PG8_SA
#undef PG8_SB
#undef PG8_STAGE
#undef PG8_LDA
#undef PG8_LDB
#undef PG8_MMA
#undef PG8_WAIT_V
#undef PG8_WAIT_L
#undef PG8_BAR
#undef PG8_SCHED
}
}
constexpr int NWAVES = 8;
constexpr size_t MiB = 1u << 20;
constexpr size_t WS_CTL = 0, CTL_ZERO_BYTES = 1 * MiB;
constexpr size_t WS_TRIG = 1 * MiB, WS_GB = 2 * MiB + 256 * 1024;
constexpr size_t WS_WUP = 3 * MiB, WS_WDOWN = 14 * MiB, WS_WGATE = 19 * MiB + 512 * 1024, WS_WPLE = 21 * MiB + 512 * 1024;
constexpr size_t WS_NBUF = 22 * MiB;
constexpr size_t WS_BIG = 56 * MiB;
constexpr size_t WS_ACT = WS_BIG;
constexpr size_t WS_US = 155 * MiB, WS_UB = 167 * MiB;
constexpr size_t WS_WIN = 192 * MiB, WS_WOUT = 200 * MiB;
constexpr size_t WS_PB = 202 * MiB, WS_PE = 211 * MiB;
constexpr size_t WS_FRHI = 202 * MiB, WS_GLAST = 2 * MiB + 896 * 1024;
constexpr size_t WS_SSQA = 250 * MiB, WS_SSQB = 252 * MiB;
constexpr size_t WS_END = 256 * MiB;
static_assert(WS_ACT + (size_t)T * DFF * 2 <= WS_US && WS_BIG + (size_t)T * NPROJ * 2 <= WS_WIN && WS_US + (size_t)TS * NUP * 2 <= WS_UB && WS_UB + (size_t)256 * 4 * NUP * 4 <= WS_WIN, "d_ws map");
constexpr int CW_BAR = 4096;
constexpr int RING_OFF = 0, RING_BYTES = 131072;
constexpr int LDS_BYTES = 163840;
constexpr int LDSCTL_OFF = LDS_BYTES - 1024, MISC_OFF = LDSCTL_OFF + 320;
#define GAS __attribute__((address_space(1)))
#define LAS __attribute__((address_space(3)))
typedef unsigned v4u __attribute__((ext_vector_type(4)));
typedef float f32x4 __attribute__((ext_vector_type(4)));
typedef short bf16x8 __attribute__((ext_vector_type(8)));
typedef GAS unsigned gu32;
typedef GAS unsigned long long gu64;
#define RLX_AGENT __ATOMIC_RELAXED, __HIP_MEMORY_SCOPE_AGENT
#define LDS_WAIT() asm volatile("s_waitcnt lgkmcnt(0)" ::: "memory")
#define VM_WAIT() asm volatile("s_waitcnt vmcnt(0)" ::: "memory")
__device__ __forceinline__ unsigned long long rt() { return __builtin_amdgcn_s_memrealtime(); }
__device__ __forceinline__ unsigned pk2(float lo, float hi) { return (unsigned)f2bf(lo) | ((unsigned)f2bf(hi) << 16); }

#define XB_TMO      128
#define XB_XCNT(j)  (256  + 64 * (j))
#define XB_XSUB(j)  (1280 + 64 * (j))
#define XB_XGEN(j)  (2304 + 64 * (j))
#define XB_TOP      3328
#define XB_TOPGEN   3392
#define XCD_BAR_WORDS 3456
#define XB_SPIN_CAP (1u << 18)

__device__ __forceinline__ unsigned xb_ld(unsigned* p)              { return __hip_atomic_load(p, __ATOMIC_RELAXED, __HIP_MEMORY_SCOPE_AGENT); }
__device__ __forceinline__ unsigned xb_add(unsigned* p, unsigned v) { return __hip_atomic_fetch_add(p, v, __ATOMIC_RELAXED, __HIP_MEMORY_SCOPE_AGENT); }
__device__ __forceinline__ unsigned xb_xcc_id() { return (unsigned)__builtin_amdgcn_s_getreg((3 << 11) | 20) & 0xFu; }
#define XB_SPIN(cond, bar) do { unsigned _sp = 0; while (cond) { __builtin_amdgcn_s_sleep(1); \
    if ((++_sp & 255u) == 0u) { if (xb_ld(&(bar)[XB_TMO])) break; if (_sp > XB_SPIN_CAP) { atomicAdd(&(bar)[XB_TMO], 1u); break; } } } } while (0)

struct XcdBarrier {
    unsigned* bar; unsigned x;
    volatile LAS unsigned* st;
};

__device__ __forceinline__ XcdBarrier xcd_barrier_post(unsigned* bar, volatile LAS unsigned* st) {
    XcdBarrier b; b.bar = bar; b.x = xb_xcc_id(); b.st = st;
    if (threadIdx.x == 0) (void)xb_add(&bar[XB_XCNT(b.x)], 1u);
    return b;
}
__device__ __forceinline__ void xcd_barrier_complete(unsigned* bar, unsigned x, unsigned& nloc, unsigned& nx) {
    const unsigned G = gridDim.x * gridDim.y * gridDim.z;
    unsigned sum, cnt, mine, sp = 0u;
    for (;;) {
        sum = 0u; cnt = 0u; mine = 0u;
#pragma unroll
        for (unsigned j = 0; j < 16; ++j) { const unsigned c = xb_ld(&bar[XB_XCNT(j)]); sum += c; cnt += (c > 0u) ? 1u : 0u; mine = (j == x) ? c : mine; }
        if (sum == G) break;
        __builtin_amdgcn_s_sleep(1);
        if ((++sp & 255u) == 0u) { if (xb_ld(&bar[XB_TMO])) break; if (sp > XB_SPIN_CAP) { atomicAdd(&bar[XB_TMO], 1u); break; } }
    }
    nloc = mine > 0u ? mine : 1u; nx = cnt > 0u ? cnt : 1u;
}

__device__ __forceinline__ void xcd_barrier(const XcdBarrier& b) {
    asm volatile("s_waitcnt vmcnt(0)" ::: "memory");
    __syncthreads();
    if (threadIdx.x == 0) {
        unsigned* bar = b.bar;
        __builtin_amdgcn_s_waitcnt(0);
        unsigned nloc = b.st[0], nx = b.st[1];
        if (nloc == 0u) { xcd_barrier_complete(bar, b.x, nloc, nx); b.st[0] = nloc; b.st[1] = nx; }
        const unsigned old = xb_add(&bar[XB_XSUB(b.x)], 1u);
        const unsigned gen = old / nloc;
        if (old + 1u == (gen + 1u) * nloc) {
            __builtin_amdgcn_fence(__ATOMIC_RELEASE, "agent");
            asm volatile("s_waitcnt vmcnt(0)" ::: "memory");
            const unsigned og = xb_add(&bar[XB_TOP], 1u);
            const unsigned tg = og / nx;
            if (og + 1u == (tg + 1u) * nx) xb_add(&bar[XB_TOPGEN], 1u);
            else XB_SPIN(xb_ld(&bar[XB_TOPGEN]) == tg, bar);
            __builtin_amdgcn_fence(__ATOMIC_ACQUIRE, "agent");
            xb_add(&bar[XB_XGEN(b.x)], 1u);
            asm volatile("s_waitcnt vmcnt(0)" ::: "memory");
        } else {
            XB_SPIN(xb_ld(&bar[XB_XGEN(b.x)]) == gen, bar);
            __builtin_amdgcn_fence(__ATOMIC_ACQUIRE, "agent");
            asm volatile("s_waitcnt vmcnt(0)" ::: "memory");
        }
    }
    __syncthreads();
}

struct Args { const float* in[25]; float* dout; unsigned char* dws; int ph_lo, ph_hi, li, pad; };
enum InIdx { I_XP = 0, I_XS, I_PP, I_PS, I_ST_CONV, I_ST_DN, I_ST_RET, I_ST_FFN, I_ATTN_NW, I_WIN, I_DN_CONVW, I_ALOG, I_DTB, I_DN_NW, I_RET_NW,
             I_WOUT, I_FFN_NW, I_WUP, I_FFN_CW, I_FFN_CB, I_WDOWN, I_PLE_NW, I_WGATE, I_WPLE, I_FINAL_NW };
struct Frame {
    LAS unsigned char* lds; volatile LAS unsigned* MISC; gu32* ctl;
    int tid, lane, wave, G, gw, NGW;
};

__device__ __forceinline__ void transpose_item(const float* W, int ldw, int oc0, int K, bf16* WT, int n0, int k0, LAS float* scr, int lane, const float* kscale) {
#pragma unroll 8
    for (int i = 0; i < 32; ++i) { const int kk = 2 * i + (lane >> 5); float v = W[(size_t)(k0 + kk) * ldw + oc0 + (lane & 31)]; if (kscale) v *= kscale[k0 + kk]; scr[kk * 33 + (lane & 31)] = v; }
    LDS_WAIT(); asm volatile("" ::: "memory");
    const int c = lane & 7;
#pragma unroll
    for (int j = 0; j < 4; ++j) { const int n = (lane >> 3) + 8 * j; const LAS float* s = scr + (8 * c) * 33 + n;
        v4u o; o.x = pk2(s[0 * 33], s[1 * 33]); o.y = pk2(s[2 * 33], s[3 * 33]); o.z = pk2(s[4 * 33], s[5 * 33]); o.w = pk2(s[6 * 33], s[7 * 33]);
        *(GAS v4u*)(WT + (size_t)(n0 + n) * K + k0 + 8 * c) = o; }
    LDS_WAIT(); asm volatile("" ::: "memory");
}
template <int MODE>
__device__ __forceinline__ void rows_norm_phase(const Frame& F, const float* xp, const float* xs, const float* w, bf16* outb,
                                                const float* w_in, const float* A_log, const float* dt_bias, float* gb) {
    const int lane = F.lane;
    for (int row = F.gw; row < T; row += F.NGW) {
        const float* x = (MODE == 0) ? (row < TP ? xp + (size_t)row * D : xs + (size_t)(row - TP) * D) : xp + (size_t)row * D;
        float v[16]; float s = 0.f;
#pragma unroll
        for (int j = 0; j < 4; ++j) { const f32x4 t = *(const f32x4*)(x + 4 * lane + 256 * j); v[4 * j] = t[0]; v[4 * j + 1] = t[1]; v[4 * j + 2] = t[2]; v[4 * j + 3] = t[3]; s += t[0] * t[0] + t[1] * t[1] + t[2] * t[2] + t[3] * t[3]; }
        s = wave_sum(s);
        const float rstd = rsqrtf(s * (1.f / D) + EPS);
#pragma unroll
        for (int j = 0; j < 4; ++j) {
            const f32x4 ww = *(const f32x4*)(w + 4 * lane + 256 * j);
            v[4 * j] *= rstd * ww[0]; v[4 * j + 1] *= rstd * ww[1]; v[4 * j + 2] *= rstd * ww[2]; v[4 * j + 3] *= rstd * ww[3];
            uint2 o; o.x = pk2(v[4 * j], v[4 * j + 1]); o.y = pk2(v[4 * j + 2], v[4 * j + 3]);
            *(uint2*)(outb + (size_t)row * D + 4 * lane + 256 * j) = o;
        }
        if (MODE == 0) {
            float acc[8];
#pragma unroll
            for (int c = 0; c < 8; ++c) acc[c] = 0.f;
#pragma unroll
            for (int j = 0; j < 4; ++j)
#pragma unroll
                for (int e = 0; e < 4; ++e) { const int k = 4 * lane + 256 * j + e; const float* wr = w_in + (size_t)k * 4104 + 2048;
                    const f32x4 w0 = *(const f32x4*)wr, w1 = *(const f32x4*)(wr + 4);
#pragma unroll
                    for (int c = 0; c < 4; ++c) { acc[c] += v[4 * j + e] * w0[c]; acc[4 + c] += v[4 * j + e] * w1[c]; } }
#pragma unroll
            for (int c = 0; c < 8; ++c) acc[c] = wave_sum(acc[c]);
            float r = 0.f;
#pragma unroll
            for (int c = 0; c < 8; ++c) r = (lane == c) ? acc[c] : r;
            if (lane < 4) gb[(size_t)row * 8 + lane] = sigmoid_f(r);
            else if (lane < 8) { const int h = lane - 4; const float xx = r + dt_bias[h]; const float sp = (xx > 20.f) ? xx : log1pf(__expf(xx)); gb[(size_t)row * 8 + lane] = -__expf(A_log[h]) * sp; }
        }
    }
}
__device__ __forceinline__ void trig_phase(const Frame& F, float2* trig) {
    for (int idx = blockIdx.x * 512 + F.tid; idx < 2056 * 64; idx += F.G * 512) {
        const int pi = idx >> 6, i = idx & 63;
        const int pos = pi < 2048 ? pi : 16384 + (pi - 2048);
        const float invf = (float)exp2(-(double)i * (2.0 / 128.0) * 13.287712379549449);
        const double a = (double)pos * (double)invf;
        const double rev = a * 0.15915494309189535;
        const double fr = rev - rint(rev);
        trig[idx] = make_float2(__builtin_amdgcn_cosf((float)fr), __builtin_amdgcn_sinf((float)fr));
    }
}
__device__ __forceinline__ void final_norm_phase(const Frame& F, float* h, const float* w) {
    const int lane = F.lane;
    for (int row = F.gw; row < T; row += F.NGW) {
        float* x = h + (size_t)row * D; f32x4 v[4]; float s = 0.f;
#pragma unroll
        for (int j = 0; j < 4; ++j) { v[j] = *(const f32x4*)(x + 4 * lane + 256 * j); s += v[j][0] * v[j][0] + v[j][1] * v[j][1] + v[j][2] * v[j][2] + v[j][3] * v[j][3]; }
        s = wave_sum(s); const float rstd = rsqrtf(s * (1.f / D) + EPS);
#pragma unroll
        for (int j = 0; j < 4; ++j) { const f32x4 ww = *(const f32x4*)(w + 4 * lane + 256 * j); *(f32x4*)(x + 4 * lane + 256 * j) = v[j] * ww * rstd; }
    }
}
__device__ __forceinline__ void bf8_to_f32(const v4u w, float* o) {
    o[0] = __uint_as_float(w.x << 16); o[1] = __uint_as_float(w.x & 0xffff0000u); o[2] = __uint_as_float(w.y << 16); o[3] = __uint_as_float(w.y & 0xffff0000u);
    o[4] = __uint_as_float(w.z << 16); o[5] = __uint_as_float(w.z & 0xffff0000u); o[6] = __uint_as_float(w.w << 16); o[7] = __uint_as_float(w.w & 0xffff0000u);
}
__device__ __forceinline__ void act_phase(const Frame& F, const bf16* u, int row0, int nrows, const float* cw, const float* cb, const float* st_ffn, bf16* act, float* out) {
    const int total = nrows * 352;
    for (int i = blockIdx.x * 512 + F.tid; i < total; i += F.G * 512) {
        const int lr = i / 352, g8 = i - lr * 352, ch = 8 * g8, row = row0 + lr;
        const bool prompt = row < TP; const int b = prompt ? row / SEQ : (row - TP) / DSEQ; const int pos = prompt ? row % SEQ : (row - TP) % DSEQ; const int L = prompt ? SEQ : DSEQ;
        const int ng = (ch >> 7) * 256 + (ch & 127), nv = ng + 128;
        float xg[3][8], xv[3][8];
#pragma unroll
        for (int r = 0; r < 3; ++r) {
            const int p = pos - 2 + r;
            if (p >= 0) { bf8_to_f32(*(const v4u*)(u + (size_t)(lr - 2 + r) * NUP + ng), xg[r]); bf8_to_f32(*(const v4u*)(u + (size_t)(lr - 2 + r) * NUP + nv), xv[r]); }
            else if (prompt) {
#pragma unroll
                for (int e = 0; e < 8; ++e) { xg[r][e] = 0.f; xv[r][e] = 0.f; }
            } else { const float* sp = st_ffn + ((size_t)b * 2 + (p + 2)) * NUP + ch;
#pragma unroll
                for (int e = 0; e < 8; ++e) { xg[r][e] = sp[e]; xv[r][e] = sp[DFF + e]; } }
        }
        float o[8];
#pragma unroll
        for (int e = 0; e < 8; ++e) {
            const int c = ch + e;
            const float ug = cw[c] * xg[0][e] + cw[NUP + c] * xg[1][e] + cw[2 * NUP + c] * xg[2][e] + cb[c];
            const float uv = cw[DFF + c] * xv[0][e] + cw[NUP + DFF + c] * xv[1][e] + cw[2 * NUP + DFF + c] * xv[2][e] + cb[DFF + c];
            o[e] = silu_f(ug) * uv;
        }
        v4u w; w.x = pk2(o[0], o[1]); w.y = pk2(o[2], o[3]); w.z = pk2(o[4], o[5]); w.w = pk2(o[6], o[7]);
        *(v4u*)(act + (size_t)row * DFF + ch) = w;
        if (pos >= L - 2) { float* op = out + (prompt ? O_FFN_P : O_FFN_S) + ((size_t)b * 2 + (pos - (L - 2))) * NUP + ch;
#pragma unroll
            for (int e = 0; e < 8; ++e) { op[e] = xg[2][e]; op[DFF + e] = xv[2][e]; } }
    }
}

__device__ __forceinline__ float grp_sum128(float v, LAS float* red, int w2, int lane) {
    v = wave_sum(v); __syncthreads(); if (lane == 0) red[w2] = v; __syncthreads(); return red[0] + red[1];
}
__device__ __forceinline__ void dn_item(LAS float* gl, int j, int w2, int lane, bool prompt, int b, int h, bf16* proj, const float* gb, const float* conv_w, const float* dn_norm_w,
                                        const float* st_conv, const float* st_dn, float* out) {
    LAS float* qs = gl; LAS float* ks = gl + 128; LAS float* red = gl + 256;
    const int L = prompt ? SEQ : DSEQ; const size_t row0 = prompt ? (size_t)b * SEQ : (size_t)TP + (size_t)b * DSEQ;
    float S[128];
#pragma unroll
    for (int d = 0; d < 128; ++d) S[d] = prompt ? 0.f : st_dn[((size_t)(b * 4 + h) * 128 + d) * 128 + j];
    const int cq = h * 128 + j, ck = 512 + h * 128 + j, cv = 1024 + h * 128 + j;
    float wq[4], wk[4], wv[4], xq[3], xk[3], xv[3];
#pragma unroll
    for (int i = 0; i < 4; ++i) { wq[i] = conv_w[i * 1536 + cq]; wk[i] = conv_w[i * 1536 + ck]; wv[i] = conv_w[i * 1536 + cv]; }
#pragma unroll
    for (int i = 0; i < 3; ++i) {
        xq[i] = prompt ? 0.f : st_conv[((size_t)b * 3 + i) * 1536 + cq];
        xk[i] = prompt ? 0.f : st_conv[((size_t)b * 3 + i) * 1536 + ck];
        xv[i] = prompt ? 0.f : st_conv[((size_t)b * 3 + i) * 1536 + cv];
    }
    const float nw = dn_norm_w[j];
    for (int t = 0; t < L; ++t) {
        const size_t row = row0 + t; bf16* pr = proj + row * NPROJ;
        const float pq = bf2f(pr[cq]), pk = bf2f(pr[ck]), pv = bf2f(pr[cv]);
        const float q0 = silu_f(wq[0] * xq[0] + wq[1] * xq[1] + wq[2] * xq[2] + wq[3] * pq);
        const float k0 = silu_f(wk[0] * xk[0] + wk[1] * xk[1] + wk[2] * xk[2] + wk[3] * pk);
        const float v0 = silu_f(wv[0] * xv[0] + wv[1] * xv[1] + wv[2] * xv[2] + wv[3] * pv);
        xq[0] = xq[1]; xq[1] = xq[2]; xq[2] = pq; xk[0] = xk[1]; xk[1] = xk[2]; xk[2] = pk; xv[0] = xv[1]; xv[1] = xv[2]; xv[2] = pv;
        const float sq = grp_sum128(q0 * q0, red, w2, lane), sk = grp_sum128(k0 * k0, red, w2, lane);
        qs[j] = q0 * rsqrtf(sq + EPS) * 0.08838834764831845f; ks[j] = k0 * rsqrtf(sk + EPS);
        __syncthreads();
        const float beta = gb[row * 8 + h], a = __expf(gb[row * 8 + 4 + h]);
        float kS = 0.f;
#pragma unroll
        for (int d = 0; d < 128; ++d) kS += ks[d] * S[d];
        const float delta = beta * (v0 - a * kS);
        float o = 0.f;
#pragma unroll
        for (int d = 0; d < 128; ++d) { S[d] = a * S[d] + ks[d] * delta; o += S[d] * qs[d]; }
        const float so = grp_sum128(o * o, red, w2, lane);
        const float z = bf2f(pr[3072 + h * 128 + j]);
        pr[3072 + h * 128 + j] = f2bf(o * rsqrtf(so * (1.f / 128.f) + EPS) * nw * silu_f(z));
    }
    float* so_ = out + (prompt ? O_DN_P : O_DN_S) + (size_t)(b * 4 + h) * 16384;
#pragma unroll
    for (int d = 0; d < 128; ++d) so_[d * 128 + j] = S[d];
    float* co = out + (prompt ? O_DNCONV_P : O_DNCONV_S) + (size_t)b * 3 * 1536;
#pragma unroll
    for (int i = 0; i < 3; ++i) { co[i * 1536 + cq] = xq[i]; co[i * 1536 + ck] = xk[i]; co[i * 1536 + cv] = xv[i]; }
}
__device__ __forceinline__ void ret_item(LAS float* gl, int j, int w2, int lane, bool prompt, int b, int h, bf16* proj, const float2* trig, const float* ret_norm_w, const float* st_ret, float* out) {
    LAS float* qs = gl; LAS float* ks = gl + 128; LAS float* red = gl + 256;
    const int L = prompt ? SEQ : DSEQ; const size_t row0 = prompt ? (size_t)b * SEQ : (size_t)TP + (size_t)b * DSEQ;
    float R[128];
#pragma unroll
    for (int d = 0; d < 128; ++d) R[d] = prompt ? 0.f : st_ret[((size_t)(b * 4 + h) * 128 + d) * 128 + j];
    const float gamma = 1.f - exp2f(-5.f - (float)h);
    const float nw = ret_norm_w[h * 128 + j];
    const int cq = 1536 + h * 128 + j, ck = 2048 + h * 128 + j, cv = 2560 + h * 128 + j, cg = 3584 + h * 128 + j;
    for (int t = 0; t < L; ++t) {
        const size_t row = row0 + t; bf16* pr = proj + row * NPROJ;
        const float q = bf2f(pr[cq]), k = bf2f(pr[ck]), v = bf2f(pr[cv]);
        __syncthreads();
        qs[j] = q; ks[j] = k;
        __syncthreads();
        const float2 cs = trig[(size_t)((prompt ? 0 : 2048) + t) * 64 + (j >> 1)];
        const float qp = qs[j ^ 1], kp = ks[j ^ 1];
        const float qr = (j & 1) ? (qp * cs.y + q * cs.x) : (q * cs.x - qp * cs.y);
        const float kr = ((j & 1) ? (kp * cs.y + k * cs.x) : (k * cs.x - kp * cs.y)) * 0.08838834764831845f;
        __syncthreads();
        qs[j] = qr; ks[j] = kr;
        __syncthreads();
        float o = 0.f;
#pragma unroll
        for (int d = 0; d < 128; ++d) { R[d] = gamma * R[d] + ks[d] * v; o += qs[d] * R[d]; }
        const float mu = grp_sum128(o, red, w2, lane) * (1.f / 128.f);
        const float dlt = o - mu;
        const float var = grp_sum128(dlt * dlt, red, w2, lane) * (1.f / 128.f);
        const float g = bf2f(pr[cg]);
        pr[cg] = f2bf(dlt * rsqrtf(var + EPS) * nw * silu_f(g));
    }
    float* so_ = out + (prompt ? O_RET_P : O_RET_S) + (size_t)(b * 4 + h) * 16384;
#pragma unroll
    for (int d = 0; d < 128; ++d) so_[d * 128 + j] = R[d];
}

__device__ __forceinline__ float grp_sum256(float v, LAS float* red, int w4, int lane) {
    v = wave_sum(v); __syncthreads(); if (lane == 0) red[w4] = v; __syncthreads(); return (red[0] + red[1]) + (red[2] + red[3]);
}
__device__ __forceinline__ void dn_item2(LAS float* gl, int t256, int w4, int lane, bool prompt, int b, int h, bf16* proj, const float* gb, const float* conv_w, const float* dn_norm_w,
                                         const float* st_conv, const float* st_dn, float* out) {
    LAS float* qs = gl; LAS float* ks = gl + 128; LAS float* red = gl + 256;
    const int j = t256 >> 1, half = t256 & 1, d0 = 64 * half; const float once = half ? 0.f : 1.f;
    const int L = prompt ? SEQ : DSEQ; const size_t row0 = prompt ? (size_t)b * SEQ : (size_t)TP + (size_t)b * DSEQ;
    float S[64];
#pragma unroll
    for (int d = 0; d < 64; ++d) S[d] = prompt ? 0.f : st_dn[((size_t)(b * 4 + h) * 128 + d0 + d) * 128 + j];
    const int cq = h * 128 + j, ck = 512 + h * 128 + j, cv = 1024 + h * 128 + j;
    float wq[4], wk[4], wv[4], xq[3], xk[3], xv[3];
#pragma unroll
    for (int i = 0; i < 4; ++i) { wq[i] = conv_w[i * 1536 + cq]; wk[i] = conv_w[i * 1536 + ck]; wv[i] = conv_w[i * 1536 + cv]; }
#pragma unroll
    for (int i = 0; i < 3; ++i) {
        xq[i] = prompt ? 0.f : st_conv[((size_t)b * 3 + i) * 1536 + cq];
        xk[i] = prompt ? 0.f : st_conv[((size_t)b * 3 + i) * 1536 + ck];
        xv[i] = prompt ? 0.f : st_conv[((size_t)b * 3 + i) * 1536 + cv];
    }
    const float nw = dn_norm_w[j];
    for (int t = 0; t < L; ++t) {
        const size_t row = row0 + t; bf16* pr = proj + row * NPROJ;
        const float pq = bf2f(pr[cq]), pk = bf2f(pr[ck]), pv = bf2f(pr[cv]);
        const float q0 = silu_f(wq[0] * xq[0] + wq[1] * xq[1] + wq[2] * xq[2] + wq[3] * pq);
        const float k0 = silu_f(wk[0] * xk[0] + wk[1] * xk[1] + wk[2] * xk[2] + wk[3] * pk);
        const float v0 = silu_f(wv[0] * xv[0] + wv[1] * xv[1] + wv[2] * xv[2] + wv[3] * pv);
        xq[0] = xq[1]; xq[1] = xq[2]; xq[2] = pq; xk[0] = xk[1]; xk[1] = xk[2]; xk[2] = pk; xv[0] = xv[1]; xv[1] = xv[2]; xv[2] = pv;
        const float sq = grp_sum256(q0 * q0 * once, red, w4, lane), sk = grp_sum256(k0 * k0 * once, red, w4, lane);
        if (!half) { qs[j] = q0 * rsqrtf(sq + EPS) * 0.08838834764831845f; ks[j] = k0 * rsqrtf(sk + EPS); }
        __syncthreads();
        const float beta = gb[row * 8 + h], a = __expf(gb[row * 8 + 4 + h]);
        float kS = 0.f;
#pragma unroll
        for (int d = 0; d < 64; ++d) kS += ks[d0 + d] * S[d];
        kS += __shfl_xor(kS, 1);
        const float delta = beta * (v0 - a * kS);
        float o = 0.f;
#pragma unroll
        for (int d = 0; d < 64; ++d) { S[d] = a * S[d] + ks[d0 + d] * delta; o += S[d] * qs[d0 + d]; }
        o += __shfl_xor(o, 1);
        const float so = grp_sum256(o * o * once, red, w4, lane);
        if (!half) { const float z = bf2f(pr[3072 + h * 128 + j]); pr[3072 + h * 128 + j] = f2bf(o * rsqrtf(so * (1.f / 128.f) + EPS) * nw * silu_f(z)); }
    }
    float* so_ = out + (prompt ? O_DN_P : O_DN_S) + (size_t)(b * 4 + h) * 16384;
#pragma unroll
    for (int d = 0; d < 64; ++d) so_[(d0 + d) * 128 + j] = S[d];
    if (!half) { float* co = out + (prompt ? O_DNCONV_P : O_DNCONV_S) + (size_t)b * 3 * 1536;
#pragma unroll
        for (int i = 0; i < 3; ++i) { co[i * 1536 + cq] = xq[i]; co[i * 1536 + ck] = xk[i]; co[i * 1536 + cv] = xv[i]; } }
}
__device__ __forceinline__ void ret_item2(LAS float* gl, int t256, int w4, int lane, bool prompt, int b, int h, bf16* proj, const float2* trig, const float* ret_norm_w, const float* st_ret, float* out) {
    LAS float* qs = gl; LAS float* ks = gl + 128; LAS float* red = gl + 256;
    const int j = t256 >> 1, half = t256 & 1, d0 = 64 * half; const float once = half ? 0.f : 1.f;
    const int L = prompt ? SEQ : DSEQ; const size_t row0 = prompt ? (size_t)b * SEQ : (size_t)TP + (size_t)b * DSEQ;
    float R[64];
#pragma unroll
    for (int d = 0; d < 64; ++d) R[d] = prompt ? 0.f : st_ret[((size_t)(b * 4 + h) * 128 + d0 + d) * 128 + j];
    const float gamma = 1.f - exp2f(-5.f - (float)h);
    const float nw = ret_norm_w[h * 128 + j];
    const int cq = 1536 + h * 128 + j, ck = 2048 + h * 128 + j, cv = 2560 + h * 128 + j, cg = 3584 + h * 128 + j;
    for (int t = 0; t < L; ++t) {
        const size_t row = row0 + t; bf16* pr = proj + row * NPROJ;
        const float q = bf2f(pr[cq]), k = bf2f(pr[ck]), v = bf2f(pr[cv]);
        __syncthreads();
        if (!half) { qs[j] = q; ks[j] = k; }
        __syncthreads();
        const float2 cs = trig[(size_t)((prompt ? 0 : 2048) + t) * 64 + (j >> 1)];
        const float qp = qs[j ^ 1], kp = ks[j ^ 1];
        const float qr = (j & 1) ? (qp * cs.y + q * cs.x) : (q * cs.x - qp * cs.y);
        const float kr = ((j & 1) ? (kp * cs.y + k * cs.x) : (k * cs.x - kp * cs.y)) * 0.08838834764831845f;
        __syncthreads();
        if (!half) { qs[j] = qr; ks[j] = kr; }
        __syncthreads();
        float o = 0.f;
#pragma unroll
        for (int d = 0; d < 64; ++d) { R[d] = gamma * R[d] + ks[d0 + d] * v; o += qs[d0 + d] * R[d]; }
        o += __shfl_xor(o, 1);
        const float mu = grp_sum256(o * once, red, w4, lane) * (1.f / 128.f);
        const float dlt = o - mu;
        const float var = grp_sum256(dlt * dlt * once, red, w4, lane) * (1.f / 128.f);
        if (!half) { const float g = bf2f(pr[cg]); pr[cg] = f2bf(dlt * rsqrtf(var + EPS) * nw * silu_f(g)); }
    }
    float* so_ = out + (prompt ? O_RET_P : O_RET_S) + (size_t)(b * 4 + h) * 16384;
#pragma unroll
    for (int d = 0; d < 64; ++d) so_[(d0 + d) * 128 + j] = R[d];
}


template <class Sched>
__device__ __forceinline__ void build_rstd_tables(const Frame& F, const Sched& S, const float* ssq, int rowbase, LAS float* tbl) {
    pg8::Unit u;
    for (int i = 0; S.next(i, u); ++i) {
        const int r = F.tid >> 1, hsel = F.tid & 1;
        const float* p = ssq + ((size_t)(rowbase + u.pm * 256 + r)) * 16 + hsel * 8;
        const f32x4 a = *(const f32x4*)p, b = *(const f32x4*)(p + 4);
        float s = ((a[0] + a[1]) + (a[2] + a[3])) + ((b[0] + b[1]) + (b[2] + b[3]));
        s += __shfl_xor(s, 1);
        if (!hsel) tbl[i * 256 + r] = rsqrtf(s * (1.f / 1024.f) + EPS);
    }
    __syncthreads();
}
__device__ __forceinline__ void final_norm_phase2(const Frame& F, float* h, const float* ssq, const float* w) {
    const int lane = F.lane;
    for (int row = F.gw; row < T; row += F.NGW) {
        float* x = h + (size_t)row * D;
        float s = lane < 16 ? ssq[(size_t)row * 16 + lane] : 0.f;
        s = wave_sum(s); const float rstd = rsqrtf(s * (1.f / D) + EPS);
#pragma unroll
        for (int j = 0; j < 4; ++j) { const f32x4 v = *(const f32x4*)(x + 4 * lane + 256 * j); const f32x4 ww = *(const f32x4*)(w + 4 * lane + 256 * j); *(f32x4*)(x + 4 * lane + 256 * j) = v * ww * rstd; }
    }
}

__device__ __forceinline__ void ffn_fixup_phase(const Frame& F, const float* ub, const float* cw, const float* cb, bf16* act, float* out) {
    const int total = 256 * 2 * 352;
    for (int i = blockIdx.x * 512 + F.tid; i < total; i += F.G * 512) {
        const int g8 = i % 352, gq = i / 352, q = gq & 1, G = gq >> 1, ch = 8 * g8, ng = (ch >> 7) * 256 + (ch & 127);
        const bool first = (G & 31) == 0;
        const float* cur = ub + ((size_t)G * 4 + q) * 5632 + ng;
        const float* p1 = q ? ub + ((size_t)G * 4) * 5632 + ng : ub + ((size_t)(G - 1) * 4 + 3) * 5632 + ng;
        const float* p2 = q ? ub + ((size_t)(G - 1) * 4 + 3) * 5632 + ng : ub + ((size_t)(G - 1) * 4 + 2) * 5632 + ng;
        const bool z1 = first && q == 0, z2 = first;
        float o[8];
#pragma unroll
        for (int hsel = 0; hsel < 2; ++hsel) {
            const f32x4 xg = *(const f32x4*)(cur + 4 * hsel), xv = *(const f32x4*)(cur + 128 + 4 * hsel);
            f32x4 g1 = {0.f, 0.f, 0.f, 0.f}, g2 = g1, v1 = g1, v2 = g1;
            if (!z1) { g1 = *(const f32x4*)(p1 + 4 * hsel); v1 = *(const f32x4*)(p1 + 128 + 4 * hsel); }
            if (!z2) { g2 = *(const f32x4*)(p2 + 4 * hsel); v2 = *(const f32x4*)(p2 + 128 + 4 * hsel); }
#pragma unroll
            for (int e = 0; e < 4; ++e) { const int c = ch + 4 * hsel + e;
                const float yg = cw[c] * g2[e] + cw[NUP + c] * g1[e] + cw[2 * NUP + c] * xg[e] + cb[c];
                const float yv = cw[DFF + c] * v2[e] + cw[NUP + DFF + c] * v1[e] + cw[2 * NUP + DFF + c] * xv[e] + cb[DFF + c];
                o[4 * hsel + e] = silu_f(yg) * yv; }
        }
        v4u w; w.x = pk2(o[0], o[1]); w.y = pk2(o[2], o[3]); w.z = pk2(o[4], o[5]); w.w = pk2(o[6], o[7]);
        *(v4u*)(act + (size_t)(64 * G + q) * DFF + ch) = w;
        if ((G & 31) == 31) {
            const float* s = ub + ((size_t)G * 4 + 2 + q) * 5632 + ng; float* op = out + O_FFN_P + ((size_t)(G >> 5) * 2 + q) * NUP + ch;
            *(f32x4*)op = *(const f32x4*)s; *(f32x4*)(op + 4) = *(const f32x4*)(s + 4); *(f32x4*)(op + DFF) = *(const f32x4*)(s + 128); *(f32x4*)(op + DFF + 4) = *(const f32x4*)(s + 132);
        }
    }
}

typedef __bf16 bfx8 __attribute__((ext_vector_type(8)));
typedef float f32x16 __attribute__((ext_vector_type(16)));
typedef float f32x8 __attribute__((ext_vector_type(8)));
#define MFMA32(a, b, c) __builtin_amdgcn_mfma_f32_32x32x16_bf16((a), (b), (c), 0, 0, 0)
__device__ __forceinline__ int crow(int reg, int h) { return (reg & 3) + 8 * (reg >> 2) + 4 * h; }
__device__ __forceinline__ bfx8 pack8(float a0, float a1, float a2, float a3, float a4, float a5, float a6, float a7) {
    const f32x8 v = {a0, a1, a2, a3, a4, a5, a6, a7}; return __builtin_convertvector(v, bfx8);
}
#define PACK_STEP(x, s) pack8((x)[8 * (s)], (x)[8 * (s) + 1], (x)[8 * (s) + 2], (x)[8 * (s) + 3], (x)[8 * (s) + 4], (x)[8 * (s) + 5], (x)[8 * (s) + 6], (x)[8 * (s) + 7])
__device__ __forceinline__ void st_frag(unsigned char* fragblk, int f, int l, bfx8 v) { *(bfx8*)(fragblk + (size_t)f * 1024 + l * 16) = v; }
constexpr int IMG_STRIDE = 132;
constexpr int IMG_BYTES = 64 * IMG_STRIDE * 4;
constexpr int MAT_STRIDE = 68;
constexpr int MAT_BYTES = 64 * MAT_STRIDE * 4;
constexpr int RET_FRAG_P = 56 * 1024, RET_FRAG_S = 17 * 1024;
constexpr int SLOT_BYTES = 56 * 1024, OBUF_OFF = 2 * SLOT_BYTES, OBUF_STRIDE = 272, OBUF_BYTES = 64 * OBUF_STRIDE;

template <int C>
__device__ __forceinline__ void ret_prep_item(const Frame& F, bool prompt, int b, int h, int chunk, const bf16* proj, const float2* trig, unsigned char* frag) {
    constexpr int MT = C == 64 ? 2 : 1, KS = C == 64 ? 4 : 1;
    LAS float* Qi = (LAS float*)(F.lds); LAS float* Ki = (LAS float*)(F.lds + IMG_BYTES); LAS float* Vi = (LAS float*)(F.lds + 2 * IMG_BYTES);
    LAS float* QKM = (LAS float*)(F.lds + 3 * IMG_BYTES);
    const int tid = F.tid, lane = F.lane, wave = F.wave, hh = lane >> 5, l31 = lane & 31;
    const size_t row0 = prompt ? (size_t)b * SEQ + (size_t)chunk * 64 : (size_t)TP + (size_t)b * DSEQ;
    const int pos0 = prompt ? chunk * 64 : 2048;
    const float lg2 = log2f(1.f - exp2f(-5.f - (float)h));
    for (int w = tid; w < C * 32; w += 512) {
        const int t = w >> 5, c4 = (w & 31) * 4;
        const bf16* pr = proj + (row0 + t) * NPROJ + 1536 + h * 128 + c4;
        const uint2 q2 = *(const uint2*)pr, k2 = *(const uint2*)(pr + 512), v2 = *(const uint2*)(pr + 1024);
        const f32x4 tr = *(const f32x4*)(&trig[(size_t)(pos0 + t) * 64 + (c4 >> 1)]);
        const float q0 = __uint_as_float(q2.x << 16), q1 = __uint_as_float(q2.x & 0xffff0000u), q2_ = __uint_as_float(q2.y << 16), q3 = __uint_as_float(q2.y & 0xffff0000u);
        const float k0 = __uint_as_float(k2.x << 16), k1 = __uint_as_float(k2.x & 0xffff0000u), k2_ = __uint_as_float(k2.y << 16), k3 = __uint_as_float(k2.y & 0xffff0000u);
        const float sc = 0.08838834764831845f;
        f32x4 qo, ko, vo;
        qo[0] = q0 * tr[0] - q1 * tr[1]; qo[1] = q0 * tr[1] + q1 * tr[0]; qo[2] = q2_ * tr[2] - q3 * tr[3]; qo[3] = q2_ * tr[3] + q3 * tr[2];
        ko[0] = (k0 * tr[0] - k1 * tr[1]) * sc; ko[1] = (k0 * tr[1] + k1 * tr[0]) * sc; ko[2] = (k2_ * tr[2] - k3 * tr[3]) * sc; ko[3] = (k2_ * tr[3] + k3 * tr[2]) * sc;
        vo[0] = __uint_as_float(v2.x << 16); vo[1] = __uint_as_float(v2.x & 0xffff0000u); vo[2] = __uint_as_float(v2.y << 16); vo[3] = __uint_as_float(v2.y & 0xffff0000u);
        *(LAS f32x4*)(Qi + t * IMG_STRIDE + c4) = qo; *(LAS f32x4*)(Ki + t * IMG_STRIDE + c4) = ko; *(LAS f32x4*)(Vi + t * IMG_STRIDE + c4) = vo;
    }
    __syncthreads();
    if (wave < (C == 64 ? 3 : 1)) {
        const int mt = wave == 0 ? 0 : 1, nt = wave == 2 ? 1 : 0;
        const int ar = 32 * mt + l31, br = 32 * nt + l31;
        f32x16 acc;
#pragma unroll
        for (int r = 0; r < 16; ++r) acc[r] = 0.f;
#pragma unroll
        for (int ks = 0; ks < 8; ++ks) {
            const int k = 16 * ks + 8 * hh;
            f32x4 a0 = {0.f, 0.f, 0.f, 0.f}, a1 = a0, b0 = a0, b1 = a0;
            if (ar < C) { a0 = *(const LAS f32x4*)(Qi + ar * IMG_STRIDE + k); a1 = *(const LAS f32x4*)(Qi + ar * IMG_STRIDE + k + 4); }
            if (br < C) { b0 = *(const LAS f32x4*)(Ki + br * IMG_STRIDE + k); b1 = *(const LAS f32x4*)(Ki + br * IMG_STRIDE + k + 4); }
            acc = MFMA32(pack8(a0[0], a0[1], a0[2], a0[3], a1[0], a1[1], a1[2], a1[3]), pack8(b0[0], b0[1], b0[2], b0[3], b1[0], b1[1], b1[2], b1[3]), acc);
        }
#pragma unroll
        for (int r = 0; r < 16; ++r) { const int i = 32 * mt + crow(r, hh), j = 32 * nt + l31;
            QKM[i * MAT_STRIDE + j] = (i >= j && i < C) ? acc[r] * exp2f((float)(i - j) * lg2) : 0.f; }
    }
    if (C == 64 && wave == 3) {
#pragma unroll
        for (int r = 0; r < 16; ++r) QKM[crow(r, hh) * MAT_STRIDE + 32 + l31] = 0.f;
    }
    __syncthreads();
    constexpr int NF = MT * 8 + MT * KS + 4 * KS + 4 * KS;
    for (int p = tid; p < NF * 64; p += 512) {
        const int f = p >> 6, l = p & 63, lh = l >> 5, ll = l & 31;
        bfx8 o;
        if (f < MT * 8) {
            const int mt = f >> 3, ks = f & 7, t = 32 * mt + ll, k0 = 32 * (ks >> 1) + 16 * (ks & 1) + 4 * lh;
            f32x4 a0 = {0.f, 0.f, 0.f, 0.f}, a1 = a0;
            if (t < C) { const float sc = exp2f((float)(t + 1) * lg2); a0 = *(const LAS f32x4*)(Qi + t * IMG_STRIDE + k0) * sc; a1 = *(const LAS f32x4*)(Qi + t * IMG_STRIDE + k0 + 8) * sc; }
            o = pack8(a0[0], a0[1], a0[2], a0[3], a1[0], a1[1], a1[2], a1[3]);
        } else if (f < MT * 8 + MT * KS) {
            const int g = f - MT * 8, mt = g / KS, ks = g % KS, i = 32 * mt + ll, k0 = 16 * ks + 8 * lh;
            const f32x4 a0 = *(const LAS f32x4*)(QKM + i * MAT_STRIDE + k0), a1 = *(const LAS f32x4*)(QKM + i * MAT_STRIDE + k0 + 4);
            o = pack8(a0[0], a0[1], a0[2], a0[3], a1[0], a1[1], a1[2], a1[3]);
        } else if (f < MT * 8 + MT * KS + 4 * KS) {
            const int g = f - MT * 8 - MT * KS, mt4 = g / KS, ks = g % KS, d = 32 * mt4 + ll, t0 = 16 * ks + 8 * lh;
            float e[8];
#pragma unroll
            for (int j = 0; j < 8; ++j) { const int t = t0 + j; e[j] = t < C ? Ki[t * IMG_STRIDE + d] * exp2f((float)(C - 1 - t) * lg2) : 0.f; }
            o = pack8(e[0], e[1], e[2], e[3], e[4], e[5], e[6], e[7]);
        } else {
            const int g = f - MT * 8 - MT * KS - 4 * KS, s = g / KS, ks = g % KS, dv = 32 * s + ll, t0 = 16 * ks + 8 * lh;
            float e[8];
#pragma unroll
            for (int j = 0; j < 8; ++j) { const int t = t0 + j; e[j] = t < C ? Vi[t * IMG_STRIDE + dv] : 0.f; }
            o = pack8(e[0], e[1], e[2], e[3], e[4], e[5], e[6], e[7]);
        }
        st_frag(frag, f, l, o);
    }
    __syncthreads();
}

__device__ __forceinline__ void ret_stream(const Frame& F, int b, int h, const unsigned char* frag0, bf16* proj, const float* ret_norm_w, float* out) {
    const int lane = F.lane, wave = F.wave, hh = lane >> 5, l31 = lane & 31;
    constexpr int NC = 32;
    const float cd = exp2f(64.f * log2f(1.f - exp2f(-5.f - (float)h)));
    if (wave < 4) {
        const int s = wave;
        f32x16 R[4];
#pragma unroll
        for (int t = 0; t < 4; ++t)
#pragma unroll
            for (int r = 0; r < 16; ++r) R[t][r] = 0.f;
        for (int c = 0; c < NC; ++c) {
            __syncthreads();
            const LAS unsigned char* slot = F.lds + (c & 1) * SLOT_BYTES + lane * 16;
            LAS unsigned char* ob = F.lds + OBUF_OFF + (c & 1) * OBUF_BYTES;
            f32x16 accO[2];
#pragma unroll
            for (int mt = 0; mt < 2; ++mt)
#pragma unroll
                for (int r = 0; r < 16; ++r) accO[mt][r] = 0.f;
#pragma unroll
            for (int ks = 0; ks < 8; ++ks) {
                const bfx8 rb = (ks & 1) ? PACK_STEP(R[ks >> 1], 1) : PACK_STEP(R[ks >> 1], 0);
#pragma unroll
                for (int mt = 0; mt < 2; ++mt) accO[mt] = MFMA32(*(const LAS bfx8*)(slot + (mt * 8 + ks) * 1024), rb, accO[mt]);
            }
            bfx8 vt[4];
#pragma unroll
            for (int ks = 0; ks < 4; ++ks) vt[ks] = *(const LAS bfx8*)(slot + (40 + s * 4 + ks) * 1024);
#pragma unroll
            for (int ks = 0; ks < 4; ++ks)
#pragma unroll
                for (int mt = 0; mt < 2; ++mt) accO[mt] = MFMA32(*(const LAS bfx8*)(slot + (16 + mt * 4 + ks) * 1024), vt[ks], accO[mt]);
#pragma unroll
            for (int t = 0; t < 4; ++t) {
                R[t] = R[t] * cd;
#pragma unroll
                for (int ks = 0; ks < 4; ++ks) R[t] = MFMA32(*(const LAS bfx8*)(slot + (24 + t * 4 + ks) * 1024), vt[ks], R[t]);
            }
#pragma unroll
            for (int mt = 0; mt < 2; ++mt)
#pragma unroll
                for (int r = 0; r < 16; ++r) *(LAS bf16*)(ob + (32 * mt + crow(r, hh)) * OBUF_STRIDE + (32 * s + l31) * 2) = f2bf(accO[mt][r]);
        }
        __syncthreads();
        float* so = out + O_RET_P + (size_t)(b * 4 + h) * 16384;
#pragma unroll
        for (int t = 0; t < 4; ++t)
#pragma unroll
            for (int r = 0; r < 16; ++r) so[(unsigned)((32 * t + crow(r, hh)) * 128 + 32 * s + l31)] = R[t][r];
    } else {
        const int hw = wave - 4;
#pragma unroll
        for (int i = 0; i < 14; ++i) { const int f = hw + 4 * i;
            __builtin_amdgcn_global_load_lds((const unsigned*)(frag0 + (size_t)f * 1024 + lane * 16), (LAS unsigned*)(F.lds + f * 1024), 16, 0, 0); }
        VM_WAIT();
        for (int c = 0; c <= NC; ++c) {
            __syncthreads();
            if (c + 1 < NC) {
                const unsigned char* src = frag0 + (size_t)(c + 1) * RET_FRAG_P; LAS unsigned char* dst = F.lds + ((c + 1) & 1) * SLOT_BYTES;
#pragma unroll
                for (int i = 0; i < 14; ++i) { const int f = hw + 4 * i;
                    __builtin_amdgcn_global_load_lds((const unsigned*)(src + (size_t)f * 1024 + lane * 16), (LAS unsigned*)(dst + f * 1024), 16, 0, 0); }
            }
            if (c >= 1) {
                const int cc = c - 1, tok = 16 * hw + (lane & 15), part = lane >> 4;
                const LAS unsigned char* ob = F.lds + OBUF_OFF + (cc & 1) * OBUF_BYTES + tok * OBUF_STRIDE + part * 64;
                float o[32];
#pragma unroll
                for (int q = 0; q < 4; ++q) bf8_to_f32(*(const LAS v4u*)(ob + q * 16), o + 8 * q);
                float sm = 0.f;
#pragma unroll
                for (int e = 0; e < 32; ++e) sm += o[e];
                sm += __shfl_xor(sm, 16); sm += __shfl_xor(sm, 32);
                const float mu = sm * (1.f / 128.f); float vs = 0.f;
#pragma unroll
                for (int e = 0; e < 32; ++e) { o[e] -= mu; vs += o[e] * o[e]; }
                vs += __shfl_xor(vs, 16); vs += __shfl_xor(vs, 32);
                const float rstd = rsqrtf(vs * (1.f / 128.f) + EPS);
                bf16* gp = proj + ((size_t)b * SEQ + (size_t)cc * 64 + tok) * NPROJ + 3584 + h * 128 + part * 32;
                const float* nw = ret_norm_w + h * 128 + part * 32;
#pragma unroll
                for (int q = 0; q < 4; ++q) {
                    float g[8]; bf8_to_f32(*(const v4u*)(gp + 8 * q), g);
                    float y[8];
#pragma unroll
                    for (int e = 0; e < 8; ++e) y[e] = o[8 * q + e] * rstd * nw[8 * q + e] * silu_f(g[e]);
                    v4u w; w.x = pk2(y[0], y[1]); w.y = pk2(y[2], y[3]); w.z = pk2(y[4], y[5]); w.w = pk2(y[6], y[7]);
                    *(v4u*)(gp + 8 * q) = w;
                }
            }
            VM_WAIT();
        }
    }
}

__device__ __forceinline__ void ret_sample_item(const Frame& F, bool active, int b, int h, const unsigned char* frag, bf16* proj, const float* ret_norm_w, const float* st_ret, float* out) {
    int lane = F.lane; asm volatile("" : "+v"(lane));
    const int wave = F.wave, s = wave & 3, team = wave >> 2, hh = lane >> 5, l31 = lane & 31;
    LAS float* xch = (LAS float*)(F.lds) + team * 64;
    f32x16 R[4]; f32x16 accO;
    if (active) {
        const float* sp = st_ret + (size_t)(b * 4 + h) * 16384;
#pragma unroll
        for (int t = 0; t < 4; ++t)
#pragma unroll
            for (int r = 0; r < 16; ++r) R[t][r] = sp[(unsigned)((32 * t + crow(r, hh)) * 128 + 32 * s + l31)];
        const unsigned char* fb = frag + lane * 16;
#pragma unroll
        for (int r = 0; r < 16; ++r) accO[r] = 0.f;
#pragma unroll
        for (int ks = 0; ks < 8; ++ks) {
            const bfx8 rb = (ks & 1) ? PACK_STEP(R[ks >> 1], 1) : PACK_STEP(R[ks >> 1], 0);
            accO = MFMA32(*(const bfx8*)(fb + ks * 1024), rb, accO);
        }
        const bfx8 vt = *(const bfx8*)(fb + (13 + s) * 1024);
        accO = MFMA32(*(const bfx8*)(fb + 8 * 1024), vt, accO);
        const float cd = exp2f(8.f * log2f(1.f - exp2f(-5.f - (float)h)));
#pragma unroll
        for (int t = 0; t < 4; ++t) { R[t] = R[t] * cd; R[t] = MFMA32(*(const bfx8*)(fb + (9 + t) * 1024), vt, R[t]); }
#pragma unroll
        for (int r = 0; r < 4; ++r) {
            float sm = accO[r], sq = accO[r] * accO[r];
#pragma unroll
            for (int o = 1; o < 32; o <<= 1) { sm += __shfl_xor(sm, o); sq += __shfl_xor(sq, o); }
            if (l31 == 0) { xch[((4 * hh + r) * 4 + s) * 2] = sm; xch[((4 * hh + r) * 4 + s) * 2 + 1] = sq; }
        }
    }
    __syncthreads();
    if (active) {
#pragma unroll
        for (int r = 0; r < 4; ++r) {
            const int tok = 4 * hh + r; float sm = 0.f, sq = 0.f;
#pragma unroll
            for (int q = 0; q < 4; ++q) { sm += xch[(tok * 4 + q) * 2]; sq += xch[(tok * 4 + q) * 2 + 1]; }
            const float mu = sm * (1.f / 128.f), var = fmaxf(sq * (1.f / 128.f) - mu * mu, 0.f);
            bf16* gp = proj + ((size_t)TP + (size_t)b * DSEQ + tok) * NPROJ + 3584 + h * 128 + 32 * s + l31;
            const float g = bf2f(*gp);
            *gp = f2bf((accO[r] - mu) * rsqrtf(var + EPS) * ret_norm_w[h * 128 + 32 * s + l31] * silu_f(g));
        }
        float* so = out + O_RET_S + (size_t)(b * 4 + h) * 16384;
#pragma unroll
        for (int t = 0; t < 4; ++t)
#pragma unroll
            for (int r = 0; r < 16; ++r) so[(unsigned)((32 * t + crow(r, hh)) * 128 + 32 * s + l31)] = R[t][r];
    }
    __syncthreads();
}

constexpr int DN_FRAG_P = 72 * 1024, DN_FRAG_S = 29 * 1024;
constexpr int VEC_OFF = 3 * IMG_BYTES + 2 * MAT_BYTES;
template <int C>
__device__ __forceinline__ void dn_prep_item(const Frame& F, bool prompt, int b, int h, int chunk, const bf16* proj, const float* gb, const float* conv_w, const float* st_conv,
                                             unsigned char* frag, float* glast, float* out) {
    constexpr int MT = C == 64 ? 2 : 1, KS = C == 64 ? 4 : 1, TQ = C == 64 ? 16 : 8, NQ = C / TQ;
    LAS float* Qi = (LAS float*)(F.lds); LAS float* Ki = (LAS float*)(F.lds + IMG_BYTES); LAS float* Vi = (LAS float*)(F.lds + 2 * IMG_BYTES);
    LAS float* AM = (LAS float*)(F.lds + 3 * IMG_BYTES); LAS float* QKM = (LAS float*)(F.lds + 3 * IMG_BYTES + MAT_BYTES);
    LAS float* gcv = (LAS float*)(F.lds + VEC_OFF); LAS float* betav = gcv + 64; LAS float* egv = gcv + 128;
    const int tid = F.tid, lane = F.lane, wave = F.wave, hh = lane >> 5, l31 = lane & 31;
    const size_t row0 = prompt ? (size_t)b * SEQ + (size_t)chunk * 64 : (size_t)TP + (size_t)b * DSEQ;
    if (tid < 96 * NQ) {
        const int cgi = tid % 96, tq = tid / 96, which = cgi >> 5, c4 = (cgi & 31) * 4, col = which * 512 + h * 128 + c4, t0 = tq * TQ;
        f32x4 w[4];
#pragma unroll
        for (int j = 0; j < 4; ++j) w[j] = *(const f32x4*)(conv_w + j * 1536 + col);
        f32x4 x0, x1, x2;
        if (t0 == 0 && chunk == 0) {
            if (prompt) { x0 = (f32x4){0.f, 0.f, 0.f, 0.f}; x1 = x0; x2 = x0; }
            else { const float* sp = st_conv + (size_t)b * 3 * 1536 + col; x0 = *(const f32x4*)sp; x1 = *(const f32x4*)(sp + 1536); x2 = *(const f32x4*)(sp + 2 * 1536); }
        } else {
            const bf16* pp = proj + (row0 + t0 - 3) * NPROJ + col;
            const uint2 a = *(const uint2*)pp, bq = *(const uint2*)(pp + NPROJ), cq = *(const uint2*)(pp + 2 * NPROJ);
            x0 = (f32x4){__uint_as_float(a.x << 16), __uint_as_float(a.x & 0xffff0000u), __uint_as_float(a.y << 16), __uint_as_float(a.y & 0xffff0000u)};
            x1 = (f32x4){__uint_as_float(bq.x << 16), __uint_as_float(bq.x & 0xffff0000u), __uint_as_float(bq.y << 16), __uint_as_float(bq.y & 0xffff0000u)};
            x2 = (f32x4){__uint_as_float(cq.x << 16), __uint_as_float(cq.x & 0xffff0000u), __uint_as_float(cq.y << 16), __uint_as_float(cq.y & 0xffff0000u)};
        }
        LAS float* img = (which == 0 ? Qi : (which == 1 ? Ki : Vi));
        for (int t = t0; t < t0 + TQ; ++t) {
            const uint2 a = *(const uint2*)(proj + (row0 + t) * NPROJ + col);
            const f32x4 x3 = {__uint_as_float(a.x << 16), __uint_as_float(a.x & 0xffff0000u), __uint_as_float(a.y << 16), __uint_as_float(a.y & 0xffff0000u)};
            const f32x4 y = w[0] * x0 + w[1] * x1 + w[2] * x2 + w[3] * x3;
            f32x4 o;
#pragma unroll
            for (int e = 0; e < 4; ++e) o[e] = silu_f(y[e]);
            *(LAS f32x4*)(img + t * IMG_STRIDE + c4) = o;
            x0 = x1; x1 = x2; x2 = x3;
        }
        if ((prompt && chunk == 31 && tq == NQ - 1) || !prompt) {
            float* co = out + (prompt ? O_DNCONV_P : O_DNCONV_S) + (size_t)b * 3 * 1536 + col;
            *(f32x4*)co = x0; *(f32x4*)(co + 1536) = x1; *(f32x4*)(co + 2 * 1536) = x2;
        }
    }
    __syncthreads();
    if (tid < C * 8) {
        const int tok = tid >> 3, part = tid & 7;
        LAS float* qp = Qi + tok * IMG_STRIDE + part * 16; LAS float* kp = Ki + tok * IMG_STRIDE + part * 16;
        f32x4 q[4], k[4]; float sq = 0.f, sk = 0.f;
#pragma unroll
        for (int i = 0; i < 4; ++i) { q[i] = *(LAS f32x4*)(qp + 4 * i); k[i] = *(LAS f32x4*)(kp + 4 * i);
            sq += q[i][0] * q[i][0] + q[i][1] * q[i][1] + q[i][2] * q[i][2] + q[i][3] * q[i][3]; sk += k[i][0] * k[i][0] + k[i][1] * k[i][1] + k[i][2] * k[i][2] + k[i][3] * k[i][3]; }
        sq += __shfl_xor(sq, 1); sq += __shfl_xor(sq, 2); sq += __shfl_xor(sq, 4);
        sk += __shfl_xor(sk, 1); sk += __shfl_xor(sk, 2); sk += __shfl_xor(sk, 4);
        const float rq = rsqrtf(sq + EPS) * 0.08838834764831845f, rk = rsqrtf(sk + EPS);
#pragma unroll
        for (int i = 0; i < 4; ++i) { *(LAS f32x4*)(qp + 4 * i) = q[i] * rq; *(LAS f32x4*)(kp + 4 * i) = k[i] * rk; }
    }
    if (wave == 7) {
        float g = lane < C ? gb[(row0 + lane) * 8 + 4 + h] : 0.f;
#pragma unroll
        for (int o = 1; o < 64; o <<= 1) { const float t = __shfl_up(g, o); if (lane >= o) g += t; }
        if (lane < C) { gcv[lane] = g; egv[lane] = __expf(g); betav[lane] = gb[(row0 + lane) * 8 + h]; }
        else { gcv[lane] = 0.f; egv[lane] = 0.f; betav[lane] = 0.f; }
    }
    __syncthreads();
    {
        constexpr int NTL = C == 64 ? 3 : 1;
        if (wave < 2 * NTL) {
            const int kind = wave / NTL, ti = wave % NTL, mt = ti == 0 ? 0 : 1, nt = ti == 2 ? 1 : 0;
            const int ar = 32 * mt + l31, br = 32 * nt + l31;
            const LAS float* Ai = kind == 0 ? Ki : Qi;
            f32x16 acc;
#pragma unroll
            for (int r = 0; r < 16; ++r) acc[r] = 0.f;
#pragma unroll
            for (int ks = 0; ks < 8; ++ks) {
                const int k = 16 * ks + 8 * hh;
                f32x4 a0 = {0.f, 0.f, 0.f, 0.f}, a1 = a0, b0 = a0, b1 = a0;
                if (ar < C) { a0 = *(const LAS f32x4*)(Ai + ar * IMG_STRIDE + k); a1 = *(const LAS f32x4*)(Ai + ar * IMG_STRIDE + k + 4); }
                if (br < C) { b0 = *(const LAS f32x4*)(Ki + br * IMG_STRIDE + k); b1 = *(const LAS f32x4*)(Ki + br * IMG_STRIDE + k + 4); }
                acc = MFMA32(pack8(a0[0], a0[1], a0[2], a0[3], a1[0], a1[1], a1[2], a1[3]), pack8(b0[0], b0[1], b0[2], b0[3], b1[0], b1[1], b1[2], b1[3]), acc);
            }
            LAS float* M = kind == 0 ? AM : QKM;
            const int j = 32 * nt + l31; const float gj = gcv[j];
#pragma unroll
            for (int r = 0; r < 16; ++r) { const int i = 32 * mt + crow(r, hh);
                const bool keep = (kind == 0 ? i > j : i >= j) && i < C;
                float v = 0.f;
                if (keep) v = acc[r] * __expf(gcv[i] - gj) * (kind == 0 ? betav[i] : 1.f);
                M[i * MAT_STRIDE + j] = v; }
        } else if (C == 64) {
            LAS float* M = wave == 6 ? AM : QKM;
#pragma unroll
            for (int r = 0; r < 16; ++r) M[crow(r, hh) * MAT_STRIDE + 32 + l31] = 0.f;
        }
    }
    {
        constexpr int F_KT = 2 * MT * 8 + MT * KS;
        const float gl = gcv[C - 1];
        for (int p = tid; p < 4 * KS * 64; p += 512) {
            const int g = p >> 6, l = p & 63, lh = l >> 5, ll = l & 31, mt4 = g / KS, ks = g % KS, d = 32 * mt4 + ll, k0 = 32 * (ks >> 1) + 16 * (ks & 1) + 4 * lh;
            float e[8];
#pragma unroll
            for (int j = 0; j < 8; ++j) { const int t = k0 + (j & 3) + 8 * (j >> 2); e[j] = t < C ? Ki[t * IMG_STRIDE + d] * __expf(gl - gcv[t]) : 0.f; }
            st_frag(frag, F_KT + g, l, pack8(e[0], e[1], e[2], e[3], e[4], e[5], e[6], e[7]));
        }
    }
    __syncthreads();
    if (wave < 4) {
        const bool isw = wave >= 2; const int c = tid & 127;
        LAS float* img = (isw ? Ki : Vi) + c;
        for (int t = 0; t < C; ++t) img[t * IMG_STRIDE] *= betav[t] * (isw ? egv[t] : 1.f);
        constexpr int BS = C == 64 ? 16 : 8, NBK = C / BS;
        for (int blk = 0; blk < NBK; ++blk) {
            const int r0 = blk * BS;
            float x[BS];
#pragma unroll
            for (int i = 0; i < BS; ++i) x[i] = img[(r0 + i) * IMG_STRIDE];
#pragma unroll
            for (int i = 1; i < BS; ++i) {
                float a0 = 0.f, a1 = 0.f, a2 = 0.f, a3 = 0.f;
#pragma unroll
                for (int q = 0; q < (i + 3) / 4; ++q) {
                    const f32x4 a = *(const LAS f32x4*)(AM + (r0 + i) * MAT_STRIDE + r0 + 4 * q);
                    a0 += a[0] * x[4 * q];
                    if (4 * q + 1 < i) a1 += a[1] * x[4 * q + 1];
                    if (4 * q + 2 < i) a2 += a[2] * x[4 * q + 2];
                    if (4 * q + 3 < i) a3 += a[3] * x[4 * q + 3];
                }
                x[i] -= (a0 + a1) + (a2 + a3);
            }
#pragma unroll
            for (int i = 0; i < BS; ++i) img[(r0 + i) * IMG_STRIDE] = x[i];
            for (int r = r0 + BS; r < C; ++r) {
                float a0 = 0.f, a1 = 0.f, a2 = 0.f, a3 = 0.f;
#pragma unroll
                for (int q = 0; q < BS / 4; ++q) {
                    const f32x4 a = *(const LAS f32x4*)(AM + r * MAT_STRIDE + r0 + 4 * q);
                    a0 += a[0] * x[4 * q]; a1 += a[1] * x[4 * q + 1]; a2 += a[2] * x[4 * q + 2]; a3 += a[3] * x[4 * q + 3];
                }
                img[r * IMG_STRIDE] -= (a0 + a1) + (a2 + a3);
            }
        }
    } else {
        constexpr int F_QD = MT * 8, F_QK = 2 * MT * 8, NFH = MT * 8 + MT * KS;
        for (int p = tid - 256; p < NFH * 64; p += 256) {
            const int fi = p >> 6, l = p & 63, lh = l >> 5, ll = l & 31;
            bfx8 o; int f;
            if (fi < MT * 8) {
                const int mt = fi >> 3, ks = fi & 7, t = 32 * mt + ll, k0 = 32 * (ks >> 1) + 16 * (ks & 1) + 4 * lh;
                f32x4 a0 = {0.f, 0.f, 0.f, 0.f}, a1 = a0;
                if (t < C) { const float sc = egv[t]; a0 = *(const LAS f32x4*)(Qi + t * IMG_STRIDE + k0) * sc; a1 = *(const LAS f32x4*)(Qi + t * IMG_STRIDE + k0 + 8) * sc; }
                o = pack8(a0[0], a0[1], a0[2], a0[3], a1[0], a1[1], a1[2], a1[3]); f = F_QD + fi;
            } else {
                const int g = fi - MT * 8, mt = g / KS, ks = g % KS, i = 32 * mt + ll, k0 = 32 * (ks >> 1) + 16 * (ks & 1) + 4 * lh;
                const f32x4 a0 = *(const LAS f32x4*)(QKM + i * MAT_STRIDE + k0), a1 = *(const LAS f32x4*)(QKM + i * MAT_STRIDE + k0 + 8);
                o = pack8(a0[0], a0[1], a0[2], a0[3], a1[0], a1[1], a1[2], a1[3]); f = F_QK + g;
            }
            st_frag(frag, f, l, o);
        }
    }
    __syncthreads();
    {
        constexpr int F_U = 2 * MT * 8 + MT * KS + 4 * KS, NF6 = MT * 8 + 4 * MT * 2;
        for (int p = tid; p < NF6 * 64; p += 512) {
            const int fi = p >> 6, l = p & 63, lh = l >> 5, ll = l & 31;
            bfx8 o; int f;
            if (fi < MT * 8) {
                const int mt = fi >> 3, ks = fi & 7, t = 32 * mt + ll, k0 = 32 * (ks >> 1) + 16 * (ks & 1) + 4 * lh;
                f32x4 a0 = {0.f, 0.f, 0.f, 0.f}, a1 = a0;
                if (t < C) { a0 = -*(const LAS f32x4*)(Ki + t * IMG_STRIDE + k0); a1 = -*(const LAS f32x4*)(Ki + t * IMG_STRIDE + k0 + 8); }
                o = pack8(a0[0], a0[1], a0[2], a0[3], a1[0], a1[1], a1[2], a1[3]); f = fi;
            } else {
                const int g = fi - MT * 8, half = g & 1, sm = g >> 1, mt = sm % MT, s = sm / MT, dv = 32 * s + ll;
                float e[8];
#pragma unroll
                for (int j = 0; j < 8; ++j) { const int t = 32 * mt + crow(8 * half + j, lh); e[j] = t < C ? Vi[t * IMG_STRIDE + dv] : 0.f; }
                o = pack8(e[0], e[1], e[2], e[3], e[4], e[5], e[6], e[7]); f = F_U + g;
            }
            st_frag(frag, f, l, o);
        }
        if (tid == 0) *glast = egv[C - 1];
    }
    __syncthreads();
}

__device__ __forceinline__ void dn_stream(const Frame& F, int b, int h, const unsigned char* frag_lo, const unsigned char* frag_hi, int split,
                                          const float* glast, bf16* proj, const float* dn_norm_w, float* out) {
    const int lane = F.lane, wave = F.wave, hh = lane >> 5, l31 = lane & 31;
    constexpr int NC = 32;
    const int it0 = (b * 4 + h) * 32;
#define DN_ITEM_PTR(c) (((it0 + (c)) < split) ? frag_lo + (size_t)(it0 + (c)) * DN_FRAG_P : frag_hi + (size_t)(it0 + (c) - split) * DN_FRAG_P)
    if (wave < 4) {
        const int s = wave;
        f32x16 S[4];
#pragma unroll
        for (int t = 0; t < 4; ++t)
#pragma unroll
            for (int r = 0; r < 16; ++r) S[t][r] = 0.f;
        for (int c = 0; c < NC; ++c) {
            const unsigned char* ub = DN_ITEM_PTR(c) + (size_t)(56 + s * 4) * 1024 + lane * 16;
            const v4u u00 = *(const v4u*)(ub), u01 = *(const v4u*)(ub + 1024), u10 = *(const v4u*)(ub + 2048), u11 = *(const v4u*)(ub + 3072);
            const float dec = glast[it0 + c];
            __syncthreads();
            const LAS unsigned char* slot = F.lds + (c & 1) * SLOT_BYTES + lane * 16;
            LAS unsigned char* ob = F.lds + OBUF_OFF + (c & 1) * OBUF_BYTES;
            f32x16 accV[2], accO[2];
            { float t8[8];
              bf8_to_f32(u00, t8);
#pragma unroll
              for (int e = 0; e < 8; ++e) accV[0][e] = t8[e];
              bf8_to_f32(u01, t8);
#pragma unroll
              for (int e = 0; e < 8; ++e) accV[0][8 + e] = t8[e];
              bf8_to_f32(u10, t8);
#pragma unroll
              for (int e = 0; e < 8; ++e) accV[1][e] = t8[e];
              bf8_to_f32(u11, t8);
#pragma unroll
              for (int e = 0; e < 8; ++e) accV[1][8 + e] = t8[e]; }
#pragma unroll
            for (int mt = 0; mt < 2; ++mt)
#pragma unroll
                for (int r = 0; r < 16; ++r) accO[mt][r] = 0.f;
#pragma unroll
            for (int ks = 0; ks < 8; ++ks) {
                const bfx8 sb = (ks & 1) ? PACK_STEP(S[ks >> 1], 1) : PACK_STEP(S[ks >> 1], 0);
#pragma unroll
                for (int mt = 0; mt < 2; ++mt) {
                    accV[mt] = MFMA32(*(const LAS bfx8*)(slot + (mt * 8 + ks) * 1024), sb, accV[mt]);
                    accO[mt] = MFMA32(*(const LAS bfx8*)(slot + (16 + mt * 8 + ks) * 1024), sb, accO[mt]);
                }
                if (ks & 1) asm volatile("" ::: "memory");
            }
            bfx8 vb[4];
            vb[0] = PACK_STEP(accV[0], 0); vb[1] = PACK_STEP(accV[0], 1); vb[2] = PACK_STEP(accV[1], 0); vb[3] = PACK_STEP(accV[1], 1);
#pragma unroll
            for (int ks = 0; ks < 4; ++ks)
#pragma unroll
                for (int mt = 0; mt < 2; ++mt) accO[mt] = MFMA32(*(const LAS bfx8*)(slot + (32 + mt * 4 + ks) * 1024), vb[ks], accO[mt]);
#pragma unroll
            for (int t = 0; t < 4; ++t) {
                S[t] = S[t] * dec;
#pragma unroll
                for (int ks = 0; ks < 4; ++ks) S[t] = MFMA32(*(const LAS bfx8*)(slot + (40 + t * 4 + ks) * 1024), vb[ks], S[t]);
            }
#pragma unroll
            for (int mt = 0; mt < 2; ++mt)
#pragma unroll
                for (int r = 0; r < 16; ++r) *(LAS bf16*)(ob + (32 * mt + crow(r, hh)) * OBUF_STRIDE + (32 * s + l31) * 2) = f2bf(accO[mt][r]);
        }
        __syncthreads();
        float* so = out + O_DN_P + (size_t)(b * 4 + h) * 16384;
#pragma unroll
        for (int t = 0; t < 4; ++t)
#pragma unroll
            for (int r = 0; r < 16; ++r) so[(unsigned)((32 * t + crow(r, hh)) * 128 + 32 * s + l31)] = S[t][r];
    } else {
        const int hw = wave - 4;
        { const unsigned char* src = DN_ITEM_PTR(0);
#pragma unroll
          for (int i = 0; i < 14; ++i) { const int f = hw + 4 * i;
              __builtin_amdgcn_global_load_lds((const unsigned*)(src + (size_t)f * 1024 + lane * 16), (LAS unsigned*)(F.lds + f * 1024), 16, 0, 0); } }
        VM_WAIT();
        for (int c = 0; c <= NC; ++c) {
            __syncthreads();
            if (c + 1 < NC) {
                const unsigned char* src = DN_ITEM_PTR(c + 1); LAS unsigned char* dst = F.lds + ((c + 1) & 1) * SLOT_BYTES;
#pragma unroll
                for (int i = 0; i < 14; ++i) { const int f = hw + 4 * i;
                    __builtin_amdgcn_global_load_lds((const unsigned*)(src + (size_t)f * 1024 + lane * 16), (LAS unsigned*)(dst + f * 1024), 16, 0, 0); }
            }
            if (c >= 1) {
                const int cc = c - 1, tok = 16 * hw + (lane & 15), part = lane >> 4;
                const LAS unsigned char* ob = F.lds + OBUF_OFF + (cc & 1) * OBUF_BYTES + tok * OBUF_STRIDE + part * 64;
                float o[32];
#pragma unroll
                for (int q = 0; q < 4; ++q) bf8_to_f32(*(const LAS v4u*)(ob + q * 16), o + 8 * q);
                float vs = 0.f;
#pragma unroll
                for (int e = 0; e < 32; ++e) vs += o[e] * o[e];
                vs += __shfl_xor(vs, 16); vs += __shfl_xor(vs, 32);
                const float rstd = rsqrtf(vs * (1.f / 128.f) + EPS);
                bf16* gp = proj + ((size_t)b * SEQ + (size_t)cc * 64 + tok) * NPROJ + 3072 + h * 128 + part * 32;
                const float* nw = dn_norm_w + part * 32;
#pragma unroll
                for (int q = 0; q < 4; ++q) {
                    float g[8]; bf8_to_f32(*(const v4u*)(gp + 8 * q), g);
                    float y[8];
#pragma unroll
                    for (int e = 0; e < 8; ++e) y[e] = o[8 * q + e] * rstd * nw[8 * q + e] * silu_f(g[e]);
                    v4u w; w.x = pk2(y[0], y[1]); w.y = pk2(y[2], y[3]); w.z = pk2(y[4], y[5]); w.w = pk2(y[6], y[7]);
                    *(v4u*)(gp + 8 * q) = w;
                }
            }
            VM_WAIT();
        }
    }
#undef DN_ITEM_PTR
}

__device__ __forceinline__ void dn_sample_item(const Frame& F, bool active, int b, int h, const unsigned char* frag, float dec, bf16* proj, const float* dn_norm_w, const float* st_dn, float* out) {
    int lane = F.lane; asm volatile("" : "+v"(lane));
    const int wave = F.wave, s = wave & 3, team = wave >> 2, hh = lane >> 5, l31 = lane & 31;
    LAS float* xch = (LAS float*)(F.lds) + team * 64;
    f32x16 S[4]; f32x16 accO;
    if (active) {
        const float* sp = st_dn + (size_t)(b * 4 + h) * 16384;
#pragma unroll
        for (int t = 0; t < 4; ++t)
#pragma unroll
            for (int r = 0; r < 16; ++r) S[t][r] = sp[(unsigned)((32 * t + crow(r, hh)) * 128 + 32 * s + l31)];
        const unsigned char* fb = frag + lane * 16;
        f32x16 accV;
        { const v4u u0 = *(const v4u*)(fb + (21 + s * 2) * 1024), u1 = *(const v4u*)(fb + (22 + s * 2) * 1024); float t8[8];
          bf8_to_f32(u0, t8);
#pragma unroll
          for (int e = 0; e < 8; ++e) accV[e] = t8[e];
          bf8_to_f32(u1, t8);
#pragma unroll
          for (int e = 0; e < 8; ++e) accV[8 + e] = t8[e]; }
#pragma unroll
        for (int r = 0; r < 16; ++r) accO[r] = 0.f;
#pragma unroll
        for (int ks = 0; ks < 8; ++ks) {
            const bfx8 sb = (ks & 1) ? PACK_STEP(S[ks >> 1], 1) : PACK_STEP(S[ks >> 1], 0);
            accV = MFMA32(*(const bfx8*)(fb + ks * 1024), sb, accV);
            accO = MFMA32(*(const bfx8*)(fb + (8 + ks) * 1024), sb, accO);
        }
        const bfx8 vb = PACK_STEP(accV, 0);
        accO = MFMA32(*(const bfx8*)(fb + 16 * 1024), vb, accO);
#pragma unroll
        for (int t = 0; t < 4; ++t) { S[t] = S[t] * dec; S[t] = MFMA32(*(const bfx8*)(fb + (17 + t) * 1024), vb, S[t]); }
#pragma unroll
        for (int r = 0; r < 4; ++r) {
            float sq = accO[r] * accO[r];
#pragma unroll
            for (int o = 1; o < 32; o <<= 1) sq += __shfl_xor(sq, o);
            if (l31 == 0) xch[(4 * hh + r) * 4 + s] = sq;
        }
    }
    __syncthreads();
    if (active) {
#pragma unroll
        for (int r = 0; r < 4; ++r) {
            const int tok = 4 * hh + r;
            const float sq = (xch[tok * 4] + xch[tok * 4 + 1]) + (xch[tok * 4 + 2] + xch[tok * 4 + 3]);
            bf16* gp = proj + ((size_t)TP + (size_t)b * DSEQ + tok) * NPROJ + 3072 + h * 128 + 32 * s + l31;
            const float z = bf2f(*gp);
            *gp = f2bf(accO[r] * rsqrtf(sq * (1.f / 128.f) + EPS) * dn_norm_w[32 * s + l31] * silu_f(z));
        }
        float* so = out + O_DN_S + (size_t)(b * 4 + h) * 16384;
#pragma unroll
        for (int t = 0; t < 4; ++t)
#pragma unroll
            for (int r = 0; r < 16; ++r) so[(unsigned)((32 * t + crow(r, hh)) * 128 + 32 * s + l31)] = S[t][r];
    }
    __syncthreads();
}
constexpr int N_PHASES = 10;
#ifndef DN_CHUNKED
#define DN_CHUNKED 0
#endif
__global__ void __launch_bounds__(NWAVES * 64, 2) mk_fwd(Args args) {
    extern __shared__ __attribute__((aligned(16))) unsigned char lds[];
    Frame F;
    F.lds = (LAS unsigned char*)lds;
    F.MISC = (volatile LAS unsigned*)(F.lds + MISC_OFF);
    F.tid = threadIdx.x; F.lane = F.tid & 63; F.wave = __builtin_amdgcn_readfirstlane(F.tid >> 6);
    F.G = gridDim.x;
    { const int bx = blockIdx.x; const int vcu = (F.G % 8 == 0) ? (bx % 8) * (F.G / 8) + bx / 8 : bx; F.gw = vcu * NWAVES + F.wave; F.NGW = F.G * NWAVES; }
    F.ctl = (gu32*)(args.dws + WS_CTL);
    for (int u = F.tid; u < (LDS_BYTES - LDSCTL_OFF) / 4; u += NWAVES * 64) ((LAS unsigned*)(F.lds + LDSCTL_OFF))[u] = 0u;
    __syncthreads();
    XcdBarrier bar = xcd_barrier_post((unsigned*)(F.ctl + CW_BAR) + args.li * XCD_BAR_WORDS, F.MISC + 8);
    const int lo = args.ph_lo, hi = args.ph_hi;
#define IN(k) (lo <= (k) && (k) < hi)
#define SEAM(k) do { if (IN(k) && IN((k) + 1)) xcd_barrier(bar); } while (0)
#define out (args.dout)
#define hf (args.dout + O_Y)
#define ws (args.dws)
#define nbuf ((bf16*)(args.dws + WS_NBUF))
#define big ((bf16*)(args.dws + WS_BIG))
#define act ((bf16*)(args.dws + WS_ACT))
#define Wt_in ((bf16*)(args.dws + WS_WIN))
#define Wt_out ((bf16*)(args.dws + WS_WOUT))
#define Wt_up ((bf16*)(args.dws + WS_WUP))
#define Wt_down ((bf16*)(args.dws + WS_WDOWN))
#define Wt_gate ((bf16*)(args.dws + WS_WGATE))
#define Wt_ple ((bf16*)(args.dws + WS_WPLE))
#define gb ((float*)(args.dws + WS_GB))
#define trig ((float2*)(args.dws + WS_TRIG))
#define pe ((bf16*)(args.dws + WS_PE))
#define pb ((bf16*)(args.dws + WS_PB))
#define fr_ret_p ((unsigned char*)(args.dout + O_Y))
#define fr_ret_s (fr_ret_p + (size_t)1024 * RET_FRAG_P)
    constexpr int DN_SPLIT = 480;
#define fr_dn_lo (args.dws + WS_NBUF)
#define fr_dn_hi (args.dws + WS_FRHI)
#define fr_dn_s (fr_dn_hi + (size_t)(1024 - DN_SPLIT) * DN_FRAG_P)
#define glast_p ((float*)(args.dws + WS_GLAST))
#define glast_s (glast_p + 1024)
#define ssqa ((float*)(args.dws + WS_SSQA))
#define ssqb ((float*)(args.dws + WS_SSQB))
#define RTBL ((LAS float*)(F.lds + RING_BYTES))
#define usb ((bf16*)(args.dws + WS_US))
#define ubb ((float*)(args.dws + WS_UB))
    using pg8::Gemm; using pg8::StaticOrder; using pg8::EpiStore; using pg8::EpiResid; using pg8::EpiPle; using pg8::EpiResidN; using pg8::EpiScaleStore; using pg8::EpiPleN; using pg8::EpiFfnAct;
    const int bx = blockIdx.x;

    if (IN(0)) {
        trig_phase(F, trig);
        LAS float* scr = (LAS float*)(F.lds + RING_OFF + F.wave * 16384);
        constexpr int I_IN = 16 * 128, I_OUT = 16 * 32, I_UP = 16 * 176, I_DOWN = 44 * 32, I_GATE = 16 * 32, I_PLEI = 4 * 32;
        constexpr int NITEMS = I_IN + I_OUT + I_UP + I_DOWN + I_GATE + I_PLEI;
        for (int it = F.gw; it < NITEMS; it += F.NGW) {
            int r = it;
            if (r < I_IN) { const int kb = r / 128, nb = r % 128; transpose_item(args.in[I_WIN], 4104, proj_orig_col(32 * nb), D, Wt_in, 32 * nb, 64 * kb, scr, F.lane, nullptr); continue; } r -= I_IN;
            if (r < I_OUT) { const int kb = r / 32, nb = r % 32; transpose_item(args.in[I_WOUT], D, 32 * nb, D, Wt_out, 32 * nb, 64 * kb, scr, F.lane, nullptr); continue; } r -= I_OUT;
            if (r < I_UP) { const int kb = r / 176, nb = r % 176; transpose_item(args.in[I_WUP], NUP, up_orig_col(32 * nb), D, Wt_up, 32 * nb, 64 * kb, scr, F.lane, args.in[I_FFN_NW]); continue; } r -= I_UP;
            if (r < I_DOWN) { const int kb = r / 32, nb = r % 32; transpose_item(args.in[I_WDOWN], D, 32 * nb, DFF, Wt_down, 32 * nb, 64 * kb, scr, F.lane, nullptr); continue; } r -= I_DOWN;
            if (r < I_GATE) { const int kb = r / 32, nb = r % 32; transpose_item(args.in[I_WGATE], D, 32 * nb, D, Wt_gate, 32 * nb, 64 * kb, scr, F.lane, args.in[I_PLE_NW]); continue; } r -= I_GATE;
            { const int kb = r / 32, nb = r % 32; transpose_item(args.in[I_WPLE], D, 32 * nb, PLE, Wt_ple, 32 * nb, 64 * kb, scr, F.lane, nullptr); }
        }
        rows_norm_phase<0>(F, args.in[I_XP], args.in[I_XS], args.in[I_ATTN_NW], nbuf, args.in[I_WIN], args.in[I_ALOG], args.in[I_DTB], gb);
    }
    SEAM(0);
    if (IN(1)) {
        Gemm g{nbuf, Wt_in, T, NPROJ, D, D, D}; StaticOrder S; S.init(T, NPROJ, F.G, bx);
        EpiStore E{big, NPROJ};
        pg8::gemm_phase<EpiStore, StaticOrder, true, true>(F.lds + RING_OFF, g, S, E);
    }
    SEAM(1);
    if (IN(2)) {
        for (int it = bx; it < 1024; it += F.G) { const int bh = it >> 5, c = it & 31;
            dn_prep_item<64>(F, true, bh >> 2, bh & 3, c, big, gb, args.in[I_DN_CONVW], args.in[I_ST_CONV],
                             it < DN_SPLIT ? fr_dn_lo + (size_t)it * DN_FRAG_P : fr_dn_hi + (size_t)(it - DN_SPLIT) * DN_FRAG_P, glast_p + it, out); }
        for (int it = bx; it < 1024; it += F.G) { const int bh = it >> 5, c = it & 31; ret_prep_item<64>(F, true, bh >> 2, bh & 3, c, big, trig, fr_ret_p + (size_t)it * RET_FRAG_P); }
        for (int it = bx; it < 512; it += F.G) dn_prep_item<8>(F, false, it >> 2, it & 3, 0, big, gb, args.in[I_DN_CONVW], args.in[I_ST_CONV], fr_dn_s + (size_t)it * DN_FRAG_S, glast_s + it, out);
        for (int it = bx; it < 512; it += F.G) ret_prep_item<8>(F, false, it >> 2, it & 3, 0, big, trig, fr_ret_s + (size_t)it * RET_FRAG_S);
    }
    SEAM(2);
    if (IN(3)) {
        if (bx < 32) dn_stream(F, bx >> 2, bx & 3, fr_dn_lo, fr_dn_hi, DN_SPLIT, glast_p, big, args.in[I_DN_NW], out);
        else if (bx < 64) ret_stream(F, (bx - 32) >> 2, bx & 3, fr_ret_p + (size_t)(bx - 32) * 32 * RET_FRAG_P, big, args.in[I_RET_NW], out);
        else {
            const int tm = (bx - 64) * 2 + (F.wave >> 2);
#pragma unroll 1
            for (int k = 0; k < 3; ++k) {
                const int idx = tm + 384 * k;
                if (idx < 512) dn_sample_item(F, true, idx >> 2, idx & 3, fr_dn_s + (size_t)idx * DN_FRAG_S, glast_s[idx], big, args.in[I_DN_NW], args.in[I_ST_DN], out);
                else { const int it = idx - 512; const bool active = it < 512;
                    ret_sample_item(F, active, it >> 2, it & 3, fr_ret_s + (size_t)(active ? it : 0) * RET_FRAG_S, big, args.in[I_RET_NW], args.in[I_ST_RET], out); }
            }
        }
    }
    SEAM(3);
    if (IN(4)) {
        Gemm g{big + 3072, Wt_out, T, D, D, NPROJ, D}; StaticOrder S; S.init(T, D, F.G, bx);
        EpiResidN E{hf, args.in[I_XP], args.in[I_XS], nbuf, ssqa};
        pg8::gemm_phase<EpiResidN, StaticOrder, true, true>(F.lds + RING_OFF, g, S, E);
        const float* pp = args.in[I_PP]; const float* ps = args.in[I_PS];
        const size_t n4 = (size_t)T * PLE / 4, np4 = (size_t)TP * PLE / 4;
        for (size_t i = (size_t)bx * 512 + F.tid; i < n4; i += (size_t)F.G * 512) {
            const f32x4 v = i < np4 ? ((const f32x4*)pp)[i] : ((const f32x4*)ps)[i - np4];
            uint2 o; o.x = pk2(v[0], v[1]); o.y = pk2(v[2], v[3]); ((uint2*)pb)[i] = o;
        }
    }
    SEAM(4);
    if (IN(5)) {
        Gemm g{nbuf, Wt_up, T, NUP, D, D, D}; StaticOrder S; S.init(T, NUP, F.G, bx);
        build_rstd_tables(F, S, ssqa, 0, RTBL);
        EpiFfnAct E{act, usb, ubb, args.in[I_FFN_CW], args.in[I_FFN_CB], RTBL};
        pg8::gemm_phase<EpiFfnAct, StaticOrder, true, true>(F.lds + RING_OFF, g, S, E);
    }
    SEAM(5);
    if (IN(6)) {
        ffn_fixup_phase(F, ubb, args.in[I_FFN_CW], args.in[I_FFN_CB], act, out);
        act_phase(F, usb, TP, TS, args.in[I_FFN_CW], args.in[I_FFN_CB], args.in[I_ST_FFN], act, out);
        Gemm g{pb, Wt_ple, T, D, PLE, PLE, PLE}; StaticOrder S; S.init(T, D, F.G, bx);
        EpiStore E{pe, D};
        pg8::gemm_phase<EpiStore, StaticOrder, true, true>(F.lds + RING_OFF, g, S, E);
    }
    SEAM(6);
    if (IN(7)) {
        Gemm g{act, Wt_down, T, D, DFF, DFF, DFF}; StaticOrder S; S.init(T, D, F.G, bx);
        EpiResidN E{hf, nullptr, nullptr, nbuf, ssqb};
        pg8::gemm_phase<EpiResidN, StaticOrder, true, true>(F.lds + RING_OFF, g, S, E);
    }
    SEAM(7);
    if (IN(8)) {
        Gemm g{nbuf, Wt_gate, T, D, D, D, D}; StaticOrder S; S.init(T, D, F.G, bx);
        build_rstd_tables(F, S, ssqb, 0, RTBL);
        EpiPleN E{hf, pe, RTBL, ssqa};
        pg8::gemm_phase<EpiPleN, StaticOrder, true, true>(F.lds + RING_OFF, g, S, E);
    }
    SEAM(8);
    if (IN(9)) final_norm_phase2(F, hf, ssqa, args.in[I_FINAL_NW]);
#undef IN
#undef SEAM
#undef out
#undef hf
#undef ws
#undef nbuf
#undef big
#undef act
#undef Wt_in
#undef Wt_out
#undef Wt_up
#undef Wt_down
#undef Wt_gate
#undef Wt_ple
#undef gb
#undef trig
#undef pe
#undef pb
#undef fr_ret_p
#undef fr_ret_s
#undef fr_dn_lo
#undef fr_dn_hi
#undef fr_dn_s
#undef glast_p
#undef glast_s
#undef ssqa
#undef ssqb
#undef RTBL
#undef usb
#undef ubb
}

extern "C" void kernel_launch(void* const* d_in, const int* in_sizes, int n_in, void* d_out, int out_size, void* d_ws, size_t ws_size, hipStream_t stream) {
    static int grid = 0;
    if (grid == 0) {
        int dev = 0, cus = 0;
        if (n_in != 25 || ws_size < WS_END) { fprintf(stderr, "kernel_launch: unexpected n_in %d / ws_size %zu\n", n_in, ws_size); grid = -1; return; }
        if (hipGetDevice(&dev) != hipSuccess || hipDeviceGetAttribute(&cus, hipDeviceAttributeMultiprocessorCount, dev) != hipSuccess) { grid = -1; return; }
        if (hipFuncSetAttribute((const void*)mk_fwd, hipFuncAttributeMaxDynamicSharedMemorySize, LDS_BYTES) != hipSuccess) { fprintf(stderr, "kernel_launch: hipFuncSetAttribute failed\n"); grid = -1; return; }
        (void)hipGetLastError();
        grid = cus;
    }
    if (grid < 0) return;
    (void)hipMemsetAsync((char*)d_ws + WS_CTL, 0, CTL_ZERO_BYTES, stream);
    Args a{};
    for (int i = 0; i < 25; ++i) a.in[i] = (const float*)d_in[i];
    a.dout = (float*)d_out; a.dws = (unsigned char*)d_ws;
    a.ph_lo = 0; a.ph_hi = N_PHASES; a.li = 0;
    hipLaunchKernelGGL(mk_fwd, dim3(grid), dim3(NWAVES * 64), LDS_BYTES, stream, a);
}
```

```cpp
#include <hip/hip_runtime.h>
#include <cstdio>
#include <cstdint>

typedef unsigned short bf16;
constexpr int TP = 16384, TS = 1024, T = TP + TS;
constexpr int D = 1024, NPROJ = 4096, DFF = 2816, NUP = 5632, PLE = 256;
constexpr int SEQ = 2048, DSEQ = 8, NB = 8, NSB = 128;
constexpr float EPS = 1e-6f;

constexpr size_t O_Y = 0, O_DNCONV_P = 17825792, O_DN_P = 17862656, O_RET_P = 18386944, O_FFN_P = 18911232,
                 O_DNCONV_S = 19001344, O_DN_S = 19591168, O_RET_S = 27979776, O_FFN_S = 36368384;

__device__ __forceinline__ float bf2f(bf16 v) { return __uint_as_float(((unsigned)v) << 16); }
__device__ __forceinline__ bf16 f2bf(float f) { unsigned u = __float_as_uint(f); return (bf16)((u + 0x7fffu + ((u >> 16) & 1u)) >> 16); }
__device__ __forceinline__ float sigmoid_f(float x) { return __builtin_amdgcn_rcpf(1.f + __builtin_amdgcn_exp2f(-1.4426950408889634f * x)); }
__device__ __forceinline__ float silu_f(float x) { return x * sigmoid_f(x); }
__device__ __forceinline__ float wave_sum(float v) {
#pragma unroll
    for (int o = 1; o < 64; o <<= 1) v += __shfl_xor(v, o);
    return v;
}
__host__ __device__ __forceinline__ int proj_orig_col(int n) {
    if (n < 1536) return n;
    if (n < 3072) return 2056 + (n - 1536);
    if (n < 3584) return 1536 + (n - 3072);
    return 3592 + (n - 3584);
}
__host__ __device__ __forceinline__ int up_orig_col(int n) { const int t = n >> 8, half = (n >> 7) & 1, j = n & 127; return half * DFF + 128 * t + j; }

namespace pg8 {
#define PG8_LAS __attribute__((address_space(3)))
typedef unsigned short bf16_t;
typedef short bf16x8 __attribute__((ext_vector_type(8)));
typedef float f32x4 __attribute__((ext_vector_type(4)));
typedef unsigned u32x4 __attribute__((ext_vector_type(4)));
constexpr int BM = 256, BK = 64, HALF = 128, HTB = HALF * BK * 2  , STAGE_BYTES = 8 * HTB, NXCD = 8, WGM = 8;

__host__ __device__ __forceinline__ int lds_byte(int r, int c) { const int st = (r >> 4) * 2 + (c >> 5), rr = r & 15, cc = c & 31, ob = rr * 64 + cc * 2; return st * 1024 + (ob ^ (((ob >> 9) & 1) << 5)); }
__host__ __device__ __forceinline__ void stage_rc(int b, int& R, int& C) { const int st = b / 1024, sb = b % 1024, swz = sb ^ (((sb >> 9) & 1) << 5); R = (st >> 1) * 16 + swz / 64; C = (st & 1) * 32 + (swz % 64) / 2; }
__host__ __device__ __forceinline__ int perm32(int rho) { const int n = rho >> 4, i = rho & 15; return 8 * (i >> 2) + 4 * n + (i & 3); }

struct Unit { int pm, pn; };
struct Gemm { const bf16_t* A; const bf16_t* Bt; int M, N, K, lda, ldb; };

struct StaticOrder {
    int nM, nN, nwg, G, c;
    __host__ __device__ void init(int M, int N, int G_, int c_) { nM = M / BM; nN = N / BM; nwg = nM * nN; G = G_; c = c_; }
    __host__ __device__ bool next(int i, Unit& u) const {
        const long L = (long)i * G + c; if (L >= nwg) return false;
        int wgid = (int)L; { const int q = nwg / NXCD, r = nwg % NXCD, xcd = wgid % NXCD, off = wgid / NXCD; wgid = (xcd < r ? xcd * (q + 1) : r * (q + 1) + (xcd - r) * q) + off; }
        const int nig = WGM * nN, gid = wgid / nig, fm = gid * WGM, gsz = (nM - fm) < WGM ? (nM - fm) : WGM;
        u.pm = fm + ((wgid % nig) % gsz); u.pn = (wgid % nig) / gsz; return true;
    }
    __device__ __forceinline__ void a_ready(const Unit&) const {}
    __device__ __forceinline__ void done(const Unit&) const {}
};

__device__ __forceinline__ unsigned cvt_pk_bf16(float lo, float hi) { unsigned r; asm volatile("v_cvt_pk_bf16_f32 %0, %1, %2" : "=v"(r) : "v"(lo), "v"(hi)); return r; }

struct EpiStore {
    static constexpr bool PERM = true, AFTER_DRAIN = false;
    bf16_t* O; int ldc;
    __device__ __forceinline__ void operator()(const f32x4 (&acc)[2][2][4][2], const Unit& u, int wr, int wc, int fr, int fq, int ui) const {
        const int row0 = u.pm * BM + wr * 64 + fr, col0 = u.pn * BM + wc * 32 + 8 * fq;
#pragma unroll
        for (int ai = 0; ai < 2; ++ai)
#pragma unroll
            for (int m = 0; m < 4; ++m) { bf16_t* rowp = O + (size_t)(row0 + ai * HALF + m * 16) * ldc + col0;
#pragma unroll
                for (int bj = 0; bj < 2; ++bj) { const f32x4 v0 = acc[ai][bj][m][0], v1 = acc[ai][bj][m][1];
                    u32x4 w; w.x = cvt_pk_bf16(v0[0], v0[1]); w.y = cvt_pk_bf16(v0[2], v0[3]); w.z = cvt_pk_bf16(v1[0], v1[1]); w.w = cvt_pk_bf16(v1[2], v1[3]);
                    *(u32x4*)(rowp + bj * HALF) = w; } }
    }
};
struct EpiResid {
    static constexpr bool PERM = true, AFTER_DRAIN = false;
    float* hf; const float* xp; const float* xs;
    __device__ __forceinline__ void operator()(const f32x4 (&acc)[2][2][4][2], const Unit& u, int wr, int wc, int fr, int fq, int ui) const {
        const int row0 = u.pm * BM + wr * 64 + fr, col0 = u.pn * BM + wc * 32 + 8 * fq;
#pragma unroll
        for (int ai = 0; ai < 2; ++ai)
#pragma unroll
            for (int m = 0; m < 4; ++m) { const int row = row0 + ai * HALF + m * 16;
                const float* bp = xs ? (row < 16384 ? xp + (size_t)row * 1024 : xs + (size_t)(row - 16384) * 1024) : hf + (size_t)row * 1024;
                float* op = hf + (size_t)row * 1024;
#pragma unroll
                for (int bj = 0; bj < 2; ++bj) { const int c = col0 + bj * HALF;
                    const f32x4 b0 = *(const f32x4*)(bp + c), b1 = *(const f32x4*)(bp + c + 4);
                    *(f32x4*)(op + c) = b0 + acc[ai][bj][m][0]; *(f32x4*)(op + c + 4) = b1 + acc[ai][bj][m][1]; } }
    }
};
struct EpiPle {
    static constexpr bool PERM = true, AFTER_DRAIN = false;
    float* hf; const bf16_t* pe;
    __device__ __forceinline__ void operator()(const f32x4 (&acc)[2][2][4][2], const Unit& u, int wr, int wc, int fr, int fq, int ui) const {
        const int row0 = u.pm * BM + wr * 64 + fr, col0 = u.pn * BM + wc * 32 + 8 * fq;
#pragma unroll
        for (int ai = 0; ai < 2; ++ai)
#pragma unroll
            for (int m = 0; m < 4; ++m) { const int row = row0 + ai * HALF + m * 16; float* op = hf + (size_t)row * 1024;
#pragma unroll
                for (int bj = 0; bj < 2; ++bj) { const int c = col0 + bj * HALF;
                    const u32x4 pw = *(const u32x4*)(pe + (size_t)row * 1024 + c);
                    const f32x4 h0 = *(const f32x4*)(op + c), h1 = *(const f32x4*)(op + c + 4);
                    const f32x4 a0 = acc[ai][bj][m][0], a1 = acc[ai][bj][m][1];
                    f32x4 p0, p1;
                    p0[0] = __uint_as_float(pw.x << 16); p0[1] = __uint_as_float(pw.x & 0xffff0000u); p0[2] = __uint_as_float(pw.y << 16); p0[3] = __uint_as_float(pw.y & 0xffff0000u);
                    p1[0] = __uint_as_float(pw.z << 16); p1[1] = __uint_as_float(pw.z & 0xffff0000u); p1[2] = __uint_as_float(pw.w << 16); p1[3] = __uint_as_float(pw.w & 0xffff0000u);
                    f32x4 o0, o1;
#pragma unroll
                    for (int e = 0; e < 4; ++e) { o0[e] = h0[e] + p0[e] * __builtin_amdgcn_rcpf(1.f + __builtin_amdgcn_exp2f(-1.4426950408889634f * a0[e])); o1[e] = h1[e] + p1[e] * __builtin_amdgcn_rcpf(1.f + __builtin_amdgcn_exp2f(-1.4426950408889634f * a1[e])); }
                    *(f32x4*)(op + c) = o0; *(f32x4*)(op + c + 4) = o1; } }
    }
};


struct EpiResidN {
    static constexpr bool PERM = true, AFTER_DRAIN = false;
    float* hf; const float* xp; const float* xs; bf16_t* hb; float* ssq;
    __device__ __forceinline__ void operator()(const f32x4 (&acc)[2][2][4][2], const Unit& u, int wr, int wc, int fr, int fq, int ui) const {
        const int row0 = u.pm * BM + wr * 64 + fr, col0 = u.pn * BM + wc * 32 + 8 * fq;
#pragma unroll
        for (int ai = 0; ai < 2; ++ai)
#pragma unroll
            for (int m = 0; m < 4; ++m) { const int row = row0 + ai * HALF + m * 16;
                const float* bp = xs ? (row < 16384 ? xp + (size_t)row * 1024 : xs + (size_t)(row - 16384) * 1024) : hf + (size_t)row * 1024;
                float* op = hf + (size_t)row * 1024; bf16_t* ob = hb + (size_t)row * 1024; float s = 0.f;
#pragma unroll
                for (int bj = 0; bj < 2; ++bj) { const int c = col0 + bj * HALF;
                    const f32x4 v0 = *(const f32x4*)(bp + c) + acc[ai][bj][m][0], v1 = *(const f32x4*)(bp + c + 4) + acc[ai][bj][m][1];
                    *(f32x4*)(op + c) = v0; *(f32x4*)(op + c + 4) = v1;
                    s += (v0[0] * v0[0] + v0[1] * v0[1]) + (v0[2] * v0[2] + v0[3] * v0[3]) + (v1[0] * v1[0] + v1[1] * v1[1]) + (v1[2] * v1[2] + v1[3] * v1[3]);
                    u32x4 w; w.x = cvt_pk_bf16(v0[0], v0[1]); w.y = cvt_pk_bf16(v0[2], v0[3]); w.z = cvt_pk_bf16(v1[0], v1[1]); w.w = cvt_pk_bf16(v1[2], v1[3]);
                    *(u32x4*)(ob + c) = w; }
                s += __shfl_xor(s, 16); s += __shfl_xor(s, 32);
                if (fq == 0) ssq[(size_t)row * 16 + u.pn * 4 + wc] = s; }
    }
};
struct EpiScaleStore {
    static constexpr bool PERM = true, AFTER_DRAIN = false;
    bf16_t* O; int ldc; const PG8_LAS float* tbl;
    __device__ __forceinline__ void operator()(const f32x4 (&acc)[2][2][4][2], const Unit& u, int wr, int wc, int fr, int fq, int ui) const {
        const int row0 = u.pm * BM + wr * 64 + fr, col0 = u.pn * BM + wc * 32 + 8 * fq;
#pragma unroll
        for (int ai = 0; ai < 2; ++ai)
#pragma unroll
            for (int m = 0; m < 4; ++m) { bf16_t* rowp = O + (size_t)(row0 + ai * HALF + m * 16) * ldc + col0;
                const float rs = tbl[ui * 256 + ai * HALF + wr * 64 + m * 16 + fr];
#pragma unroll
                for (int bj = 0; bj < 2; ++bj) { const f32x4 v0 = acc[ai][bj][m][0] * rs, v1 = acc[ai][bj][m][1] * rs;
                    u32x4 w; w.x = cvt_pk_bf16(v0[0], v0[1]); w.y = cvt_pk_bf16(v0[2], v0[3]); w.z = cvt_pk_bf16(v1[0], v1[1]); w.w = cvt_pk_bf16(v1[2], v1[3]);
                    *(u32x4*)(rowp + bj * HALF) = w; } }
    }
};
struct EpiPleN {
    static constexpr bool PERM = true, AFTER_DRAIN = false;
    float* hf; const bf16_t* pe; const PG8_LAS float* tbl; float* ssq;
    __device__ __forceinline__ void operator()(const f32x4 (&acc)[2][2][4][2], const Unit& u, int wr, int wc, int fr, int fq, int ui) const {
        const int row0 = u.pm * BM + wr * 64 + fr, col0 = u.pn * BM + wc * 32 + 8 * fq;
#pragma unroll
        for (int ai = 0; ai < 2; ++ai)
#pragma unroll
            for (int m = 0; m < 4; ++m) { const int row = row0 + ai * HALF + m * 16; float* op = hf + (size_t)row * 1024; float s = 0.f;
                const float rs = tbl[ui * 256 + ai * HALF + wr * 64 + m * 16 + fr];
#pragma unroll
                for (int bj = 0; bj < 2; ++bj) { const int c = col0 + bj * HALF;
                    const u32x4 pw = *(const u32x4*)(pe + (size_t)row * 1024 + c);
                    const f32x4 h0 = *(const f32x4*)(op + c), h1 = *(const f32x4*)(op + c + 4);
                    const f32x4 a0 = acc[ai][bj][m][0] * rs, a1 = acc[ai][bj][m][1] * rs;
                    f32x4 p0, p1;
                    p0[0] = __uint_as_float(pw.x << 16); p0[1] = __uint_as_float(pw.x & 0xffff0000u); p0[2] = __uint_as_float(pw.y << 16); p0[3] = __uint_as_float(pw.y & 0xffff0000u);
                    p1[0] = __uint_as_float(pw.z << 16); p1[1] = __uint_as_float(pw.z & 0xffff0000u); p1[2] = __uint_as_float(pw.w << 16); p1[3] = __uint_as_float(pw.w & 0xffff0000u);
                    f32x4 o0, o1;
#pragma unroll
                    for (int e = 0; e < 4; ++e) { o0[e] = h0[e] + p0[e] * __builtin_amdgcn_rcpf(1.f + __builtin_amdgcn_exp2f(-1.4426950408889634f * a0[e])); o1[e] = h1[e] + p1[e] * __builtin_amdgcn_rcpf(1.f + __builtin_amdgcn_exp2f(-1.4426950408889634f * a1[e])); }
                    *(f32x4*)(op + c) = o0; *(f32x4*)(op + c + 4) = o1;
                    s += (o0[0] * o0[0] + o0[1] * o0[1]) + (o0[2] * o0[2] + o0[3] * o0[3]) + (o1[0] * o1[0] + o1[1] * o1[1]) + (o1[2] * o1[2] + o1[3] * o1[3]); }
                s += __shfl_xor(s, 16); s += __shfl_xor(s, 32);
                if (fq == 0) ssq[(size_t)row * 16 + u.pn * 4 + wc] = s; }
    }
};


template <int N> __device__ __forceinline__ float dpp_row_prev(float cur, float prevreg) {
    const int w = __builtin_amdgcn_update_dpp(0, __float_as_int(prevreg), 0x100 + (16 - N), 0xf, 0xf, false);
    return __int_as_float(__builtin_amdgcn_update_dpp(w, __float_as_int(cur), 0x110 + N, 0xf, 0xf, false));
}
struct EpiFfnAct {
    static constexpr bool PERM = true, AFTER_DRAIN = false;
    bf16_t* act; bf16_t* us; float* ub; const float* cw; const float* cb; const PG8_LAS float* tbl;
    __device__ __forceinline__ void operator()(const f32x4 (&acc)[2][2][4][2], const Unit& u, int wr, int wc, int fr, int fq, int ui) const {
        if (u.pm >= 64) {
            const int row0 = (u.pm - 64) * BM + wr * 64 + fr, col0 = u.pn * BM + wc * 32 + 8 * fq;
#pragma unroll
            for (int ai = 0; ai < 2; ++ai)
#pragma unroll
                for (int m = 0; m < 4; ++m) { bf16_t* rowp = us + (size_t)(row0 + ai * HALF + m * 16) * 5632 + col0;
                    const float rs = tbl[ui * 256 + ai * HALF + wr * 64 + m * 16 + fr];
#pragma unroll
                    for (int bj = 0; bj < 2; ++bj) { const f32x4 v0 = acc[ai][bj][m][0] * rs, v1 = acc[ai][bj][m][1] * rs;
                        u32x4 w; w.x = cvt_pk_bf16(v0[0], v0[1]); w.y = cvt_pk_bf16(v0[2], v0[3]); w.z = cvt_pk_bf16(v1[0], v1[1]); w.w = cvt_pk_bf16(v1[2], v1[3]);
                        *(u32x4*)(rowp + bj * HALF) = w; } }
            return;
        }
        const int ch0 = 128 * u.pn + 32 * wc + 8 * fq, colg = 256 * u.pn + 32 * wc + 8 * fq;
        typedef float f32x2 __attribute__((ext_vector_type(2)));
#pragma unroll
        for (int np = 0; np < 4; ++np) {
            const int n = np >> 1, e0 = 2 * (np & 1), ch = ch0 + 4 * n + e0;
            const f32x2 wg0 = *(const f32x2*)(cw + ch), wg1 = *(const f32x2*)(cw + 5632 + ch), wg2 = *(const f32x2*)(cw + 2 * 5632 + ch), bg = *(const f32x2*)(cb + ch);
            const f32x2 wv0 = *(const f32x2*)(cw + 2816 + ch), wv1 = *(const f32x2*)(cw + 5632 + 2816 + ch), wv2 = *(const f32x2*)(cw + 2 * 5632 + 2816 + ch), bv = *(const f32x2*)(cb + 2816 + ch);
#pragma unroll
            for (int ai = 0; ai < 2; ++ai) {
                const int G = 4 * u.pm + 2 * ai + wr;
                f32x2 pg = {0.f, 0.f}, pv = pg;
#pragma unroll
                for (int m = 0; m < 4; ++m) {
                    const float rs = tbl[ui * 256 + ai * HALF + wr * 64 + m * 16 + fr];
                    f32x2 xg, xv, a;
                    xg[0] = acc[ai][0][m][n][e0] * rs; xg[1] = acc[ai][0][m][n][e0 + 1] * rs; xv[0] = acc[ai][1][m][n][e0] * rs; xv[1] = acc[ai][1][m][n][e0 + 1] * rs;
#pragma unroll
                    for (int e = 0; e < 2; ++e) {
                        const float g1 = dpp_row_prev<1>(xg[e], pg[e]), g2 = dpp_row_prev<2>(xg[e], pg[e]);
                        const float v1 = dpp_row_prev<1>(xv[e], pv[e]), v2 = dpp_row_prev<2>(xv[e], pv[e]);
                        const float yg = wg0[e] * g2 + wg1[e] * g1 + wg2[e] * xg[e] + bg[e];
                        const float yv = wv0[e] * v2 + wv1[e] * v1 + wv2[e] * xv[e] + bv[e];
                        a[e] = yg * __builtin_amdgcn_rcpf(1.f + __builtin_amdgcn_exp2f(-1.4426950408889634f * yg)) * yv;
                    }
                    const int q = 16 * m + fr;
                    if (q >= 2) *(unsigned*)(act + (size_t)(64 * G + q) * 2816 + ch) = cvt_pk_bf16(a[0], a[1]);
                    if ((m == 0 && fr < 2) || (m == 3 && fr >= 14)) { const int slot = m == 0 ? fr : fr - 12;
                        float* bp = ub + ((size_t)G * 4 + slot) * 5632 + colg + 4 * n + e0; *(f32x2*)bp = xg; *(f32x2*)(bp + 128) = xv; }
                    pg = xg; pv = xv;
                }
            }
            asm volatile("" ::: "memory");
        }
    }
};


template <class Epi, class Sched, bool ALIGN_EPI = false, bool SP2 = false>
__device__ __forceinline__ void gemm_phase(PG8_LAS unsigned char* lds, const Gemm g, const Sched& S, const Epi& E) {
    const int tid = threadIdx.x, wid = __builtin_amdgcn_readfirstlane(tid >> 6), lane = tid & 63, wr = wid >> 2, wc = wid & 3, fr = lane & 15, fq = lane >> 4;
    const int K = g.K, nt = K / BK;
    unsigned voffA[2], voffB[2];
#pragma unroll
    for (int i = 0; i < 2; ++i) { int R, C; stage_rc(tid * 16 + i * 8192, R, C); const int Rb = Epi::PERM ? ((R & ~31) + perm32(R & 31)) : R;
        voffA[i] = (unsigned)(R * g.lda + C) * 2u; voffB[i] = (unsigned)(Rb * g.ldb + C) * 2u; }
    const size_t kstep = (size_t)(BK * 2);
    const size_t hstepA = (size_t)HALF * g.lda * 2, hstepB = (size_t)HALF * g.ldb * 2;
    const size_t tstepA = 2 * hstepA, tstepB = 2 * hstepB;
    const unsigned ldsw = (unsigned)wid * 1024u;
    const int aoff = lds_byte(wr * 64 + fr, fq * 8), boff = lds_byte(wc * 32 + fr, fq * 8);
#define PG8_SA(b, h) (((b) * 2 + (h)) * HTB)
#define PG8_SB(b, h) ((4 + (b) * 2 + (h)) * HTB)
#define PG8_STAGE(bufoff, gbase, voff) do { _Pragma("unroll") for (int _i = 0; _i < 2; ++_i) \
        __builtin_amdgcn_global_load_lds((const unsigned*)((const char*)(gbase) + (voff)[_i]), (PG8_LAS unsigned*)(lds + (bufoff) + ldsw + _i * 8192), 16, 0, 0); } while (0)
#define PG8_LDA(dst, b, h) do { _Pragma("unroll") for (int m = 0; m < 4; ++m) _Pragma("unroll") for (int k = 0; k < 2; ++k) dst[m][k] = *(const PG8_LAS bf16x8*)(lds + PG8_SA(b, h) + aoff + m * 2048 + k * 1024); } while (0)
#define PG8_LDB(dst, b, h) do { _Pragma("unroll") for (int n = 0; n < 2; ++n) _Pragma("unroll") for (int k = 0; k < 2; ++k) dst[n][k] = *(const PG8_LAS bf16x8*)(lds + PG8_SB(b, h) + boff + n * 2048 + k * 1024); } while (0)
#define PG8_MMA(ai, bj, At, Bt) do { __builtin_amdgcn_s_setprio(1); _Pragma("unroll") for (int m = 0; m < 4; ++m) _Pragma("unroll") for (int n = 0; n < 2; ++n) _Pragma("unroll") for (int k = 0; k < 2; ++k) \
        acc[ai][bj][m][n] = __builtin_amdgcn_mfma_f32_16x16x32_bf16(Bt[n][k], At[m][k], acc[ai][bj][m][n], 0, 0, 0); __builtin_amdgcn_s_setprio(0); } while (0)
#define PG8_WAIT_V(n) asm volatile("s_waitcnt vmcnt(" #n ")" ::: "memory")
#define PG8_WAIT_L(n) asm volatile("s_waitcnt lgkmcnt(" #n ")" ::: "memory")
#define PG8_BAR __builtin_amdgcn_s_barrier()
#define PG8_SCHED __builtin_amdgcn_sched_barrier(0)
    Unit cur, nxt; int ui = 0;
    if (!S.next(0, cur)) return;
    f32x4 acc[2][2][4][2];
#pragma unroll
    for (int a = 0; a < 2; ++a)
#pragma unroll
        for (int b = 0; b < 2; ++b)
#pragma unroll
            for (int m = 0; m < 4; ++m)
#pragma unroll
                for (int n = 0; n < 2; ++n) acc[a][b][m][n] = (f32x4){0.f, 0.f, 0.f, 0.f};
    bf16x8 At[4][2], B0[2][2], B1[2][2];
    const char* cA = (const char*)g.A + (size_t)cur.pm * tstepA; const char* cB = (const char*)g.Bt + (size_t)cur.pn * tstepB;
    S.a_ready(cur);
    if constexpr (SP2) {
        PG8_STAGE(PG8_SB(0, 0), cB, voffB); PG8_STAGE(PG8_SB(0, 1), cB + hstepB, voffB); PG8_STAGE(PG8_SA(0, 0), cA, voffA); PG8_STAGE(PG8_SA(0, 1), cA + hstepA, voffA);
        if (wr == 1) PG8_BAR;
        PG8_WAIT_V(2); PG8_BAR;
        PG8_STAGE(PG8_SB(1, 0), cB + kstep, voffB); PG8_STAGE(PG8_SA(1, 0), cA + kstep, voffA); PG8_STAGE(PG8_SB(1, 1), cB + hstepB + kstep, voffB);
        PG8_WAIT_V(6); PG8_BAR;
    } else {
        PG8_STAGE(PG8_SB(0, 0), cB, voffB); PG8_STAGE(PG8_SA(0, 0), cA, voffA); PG8_STAGE(PG8_SB(0, 1), cB + hstepB, voffB); PG8_STAGE(PG8_SA(0, 1), cA + hstepA, voffA);
        if (wr == 1) PG8_BAR;
        PG8_WAIT_V(4); PG8_BAR;
        PG8_STAGE(PG8_SB(1, 0), cB + kstep, voffB); PG8_STAGE(PG8_SA(1, 0), cA + kstep, voffA); PG8_STAGE(PG8_SB(1, 1), cB + hstepB + kstep, voffB);
        PG8_WAIT_V(6); PG8_BAR;
    }
    for (;;) {
        const bool has_next = S.next(ui + 1, nxt);
        const char* nA = has_next ? (const char*)g.A + (size_t)nxt.pm * tstepA : cA; const char* nB = has_next ? (const char*)g.Bt + (size_t)nxt.pn * tstepB : cB;
        for (int t = 0; t < nt; t += 2) {
            const bool last = (t == nt - 2);
            const char* a1 = cA + (size_t)(t + 1) * kstep;
            const char* a2 = last ? nA : cA + (size_t)(t + 2) * kstep; const char* b2 = last ? nB : cB + (size_t)(t + 2) * kstep;
            const char* a3 = a2 + kstep; const char* b3 = b2 + kstep;
            if (last && has_next) S.a_ready(nxt);
            if constexpr (SP2) {
            PG8_LDB(B0, 0, 0); PG8_LDB(B1, 0, 1); PG8_SCHED; PG8_LDA(At, 0, 0); PG8_STAGE(PG8_SA(1, 1), a1 + hstepA, voffA);
            PG8_WAIT_V(8); PG8_WAIT_L(0); PG8_BAR; PG8_MMA(0, 0, At, B0); PG8_MMA(0, 1, At, B1); PG8_BAR; PG8_SCHED;
            PG8_LDA(At, 0, 1); PG8_STAGE(PG8_SB(0, 0), b2, voffB); PG8_STAGE(PG8_SB(0, 1), b2 + hstepB, voffB); PG8_STAGE(PG8_SA(0, 0), a2, voffA);
            PG8_WAIT_V(8); PG8_WAIT_L(0); PG8_BAR; PG8_MMA(1, 0, At, B0); PG8_MMA(1, 1, At, B1); PG8_BAR; PG8_SCHED;
            PG8_LDB(B0, 1, 0); PG8_LDB(B1, 1, 1); PG8_SCHED; PG8_LDA(At, 1, 0); PG8_STAGE(PG8_SA(0, 1), a2 + hstepA, voffA);
            PG8_WAIT_V(8); PG8_WAIT_L(0); PG8_BAR; PG8_MMA(0, 0, At, B0); PG8_MMA(0, 1, At, B1); PG8_BAR; PG8_SCHED;
            PG8_LDA(At, 1, 1); PG8_STAGE(PG8_SB(1, 0), b3, voffB); PG8_STAGE(PG8_SB(1, 1), b3 + hstepB, voffB); PG8_STAGE(PG8_SA(1, 0), a3, voffA);
            PG8_WAIT_V(8); PG8_WAIT_L(0); PG8_BAR; PG8_MMA(1, 0, At, B0); PG8_MMA(1, 1, At, B1); PG8_BAR; PG8_SCHED;
            } else {
            PG8_LDB(B0, 0, 0); PG8_SCHED; PG8_LDA(At, 0, 0); PG8_STAGE(PG8_SA(1, 1), a1 + hstepA, voffA);
            PG8_WAIT_L(8); PG8_BAR; PG8_WAIT_L(0); PG8_MMA(0, 0, At, B0); PG8_BAR; PG8_SCHED;
            PG8_LDB(B1, 0, 1); PG8_STAGE(PG8_SB(0, 0), b2, voffB);
            PG8_BAR; PG8_WAIT_L(0); PG8_MMA(0, 1, At, B1); PG8_BAR;
            PG8_LDA(At, 0, 1); PG8_STAGE(PG8_SA(0, 0), a2, voffA);
            PG8_BAR; PG8_WAIT_L(0); PG8_MMA(1, 0, At, B0); PG8_BAR; PG8_SCHED;
            PG8_STAGE(PG8_SB(0, 1), b2 + hstepB, voffB);
            PG8_WAIT_V(6); PG8_BAR; PG8_MMA(1, 1, At, B1); PG8_BAR;
            PG8_LDB(B0, 1, 0); PG8_SCHED; PG8_LDA(At, 1, 0); PG8_STAGE(PG8_SA(0, 1), a2 + hstepA, voffA);
            PG8_WAIT_L(8); PG8_BAR; PG8_WAIT_L(0); PG8_MMA(0, 0, At, B0); PG8_BAR; PG8_SCHED;
            PG8_LDB(B1, 1, 1); PG8_STAGE(PG8_SB(1, 0), b3, voffB);
            PG8_BAR; PG8_WAIT_L(0); PG8_MMA(0, 1, At, B1); PG8_BAR;
            PG8_LDA(At, 1, 1); PG8_STAGE(PG8_SA(1, 0), a3, voffA);
            PG8_BAR; PG8_WAIT_L(0); PG8_MMA(1, 0, At, B0); PG8_BAR; PG8_SCHED;
            PG8_STAGE(PG8_SB(1, 1), b3 + hstepB, voffB);
            PG8_WAIT_V(6); PG8_BAR; PG8_MMA(1, 1, At, B1); PG8_BAR;
            }
        }
        if constexpr (ALIGN_EPI) { if (wr == 0) PG8_BAR; }
        if constexpr (!Epi::AFTER_DRAIN) { E(acc, cur, wr, wc, fr, fq, ui); S.done(cur); }
        if (!has_next) break;
#pragma unroll
        for (int a = 0; a < 2; ++a)
#pragma unroll
            for (int b = 0; b < 2; ++b)
#pragma unroll
                for (int m = 0; m < 4; ++m)
#pragma unroll
                    for (int n = 0; n < 2; ++n) acc[a][b][m][n] = (f32x4){0.f, 0.f, 0.f, 0.f};
        cur = nxt; cA = nA; cB = nB; ++ui;
        if constexpr (ALIGN_EPI) { if (wr == 1) PG8_BAR; }
    }
    PG8_WAIT_V(0);
    if constexpr (!ALIGN_EPI) { if (wr == 0) PG8_BAR; }
    PG8_BAR;
    if constexpr (Epi::AFTER_DRAIN) { E.fused(acc, cur, wr, wc, fr, fq, lds, wid, lane); S.done(cur); }
#undef PG8_SA
#undef PG8_SB
#undef PG8_STAGE
#undef PG8_LDA
#undef PG8_LDB
#undef PG8_MMA
#undef PG8_WAIT_V
#undef PG8_WAIT_L
#undef PG8_BAR
#undef PG8_SCHED
}
}
constexpr int NWAVES = 8;
constexpr size_t MiB = 1u << 20;
constexpr size_t WS_CTL = 0, CTL_ZERO_BYTES = 1 * MiB;
constexpr size_t WS_TRIG = 1 * MiB, WS_GB = 2 * MiB + 256 * 1024;
constexpr size_t WS_WUP = 3 * MiB, WS_WDOWN = 14 * MiB, WS_WGATE = 19 * MiB + 512 * 1024, WS_WPLE = 21 * MiB + 512 * 1024;
constexpr size_t WS_NBUF = 22 * MiB;
constexpr size_t WS_BIG = 56 * MiB;
constexpr size_t WS_ACT = WS_BIG;
constexpr size_t WS_US = 155 * MiB, WS_UB = 167 * MiB;
constexpr size_t WS_WIN = 192 * MiB, WS_WOUT = 200 * MiB;
constexpr size_t WS_PB = 202 * MiB, WS_PE = 211 * MiB;
constexpr size_t WS_FRHI = 202 * MiB, WS_GLAST = 2 * MiB + 896 * 1024;
constexpr size_t WS_SSQA = 250 * MiB, WS_SSQB = 252 * MiB;
constexpr size_t WS_END = 256 * MiB;
static_assert(WS_ACT + (size_t)T * DFF * 2 <= WS_US && WS_BIG + (size_t)T * NPROJ * 2 <= WS_WIN && WS_US + (size_t)TS * NUP * 2 <= WS_UB && WS_UB + (size_t)256 * 4 * NUP * 4 <= WS_WIN, "d_ws map");
constexpr int CW_BAR = 4096;
constexpr int RING_OFF = 0, RING_BYTES = 131072;
constexpr int LDS_BYTES = 163840;
constexpr int LDSCTL_OFF = LDS_BYTES - 1024, MISC_OFF = LDSCTL_OFF + 320;
#define GAS __attribute__((address_space(1)))
#define LAS __attribute__((address_space(3)))
typedef unsigned v4u __attribute__((ext_vector_type(4)));
typedef float f32x4 __attribute__((ext_vector_type(4)));
typedef short bf16x8 __attribute__((ext_vector_type(8)));
typedef GAS unsigned gu32;
typedef GAS unsigned long long gu64;
#define RLX_AGENT __ATOMIC_RELAXED, __HIP_MEMORY_SCOPE_AGENT
#define LDS_WAIT() asm volatile("s_waitcnt lgkmcnt(0)" ::: "memory")
#define VM_WAIT() asm volatile("s_waitcnt vmcnt(0)" ::: "memory")
__device__ __forceinline__ unsigned long long rt() { return __builtin_amdgcn_s_memrealtime(); }
__device__ __forceinline__ unsigned pk2(float lo, float hi) { typedef float f2_ __attribute__((ext_vector_type(2))); typedef __bf16 b2_ __attribute__((ext_vector_type(2))); const f2_ v = {lo, hi}; return __builtin_bit_cast(unsigned, __builtin_convertvector(v, b2_)); }

#define XB_TMO      128
#define XB_XCNT(j)  (256  + 64 * (j))
#define XB_XSUB(j)  (1280 + 64 * (j))
#define XB_XGEN(j)  (2304 + 64 * (j))
#define XB_TOP      3328
#define XB_TOPGEN   3392
#define XCD_BAR_WORDS 3456
#define XB_SPIN_CAP (1u << 18)

__device__ __forceinline__ unsigned xb_ld(unsigned* p)              { return __hip_atomic_load(p, __ATOMIC_RELAXED, __HIP_MEMORY_SCOPE_AGENT); }
__device__ __forceinline__ unsigned xb_add(unsigned* p, unsigned v) { return __hip_atomic_fetch_add(p, v, __ATOMIC_RELAXED, __HIP_MEMORY_SCOPE_AGENT); }
__device__ __forceinline__ unsigned xb_xcc_id() { return (unsigned)__builtin_amdgcn_s_getreg((3 << 11) | 20) & 0xFu; }
#define XB_SPIN(cond, bar) do { unsigned _sp = 0; while (cond) { __builtin_amdgcn_s_sleep(1); \
    if ((++_sp & 255u) == 0u) { if (xb_ld(&(bar)[XB_TMO])) break; if (_sp > XB_SPIN_CAP) { atomicAdd(&(bar)[XB_TMO], 1u); break; } } } } while (0)

struct XcdBarrier {
    unsigned* bar; unsigned x;
    volatile LAS unsigned* st;
};

__device__ __forceinline__ XcdBarrier xcd_barrier_post(unsigned* bar, volatile LAS unsigned* st) {
    XcdBarrier b; b.bar = bar; b.x = xb_xcc_id(); b.st = st;
    if (threadIdx.x == 0) (void)xb_add(&bar[XB_XCNT(b.x)], 1u);
    return b;
}
__device__ __forceinline__ void xcd_barrier_complete(unsigned* bar, unsigned x, unsigned& nloc, unsigned& nx) {
    const unsigned G = gridDim.x * gridDim.y * gridDim.z;
    unsigned sum, cnt, mine, sp = 0u;
    for (;;) {
        sum = 0u; cnt = 0u; mine = 0u;
#pragma unroll
        for (unsigned j = 0; j < 16; ++j) { const unsigned c = xb_ld(&bar[XB_XCNT(j)]); sum += c; cnt += (c > 0u) ? 1u : 0u; mine = (j == x) ? c : mine; }
        if (sum == G) break;
        __builtin_amdgcn_s_sleep(1);
        if ((++sp & 255u) == 0u) { if (xb_ld(&bar[XB_TMO])) break; if (sp > XB_SPIN_CAP) { atomicAdd(&bar[XB_TMO], 1u); break; } }
    }
    nloc = mine > 0u ? mine : 1u; nx = cnt > 0u ? cnt : 1u;
}

__device__ __forceinline__ void xcd_barrier(const XcdBarrier& b) {
    asm volatile("s_waitcnt vmcnt(0)" ::: "memory");
    __syncthreads();
    if (threadIdx.x == 0) {
        unsigned* bar = b.bar;
        __builtin_amdgcn_s_waitcnt(0);
        unsigned nloc = b.st[0], nx = b.st[1];
        if (nloc == 0u) { xcd_barrier_complete(bar, b.x, nloc, nx); b.st[0] = nloc; b.st[1] = nx; }
        const unsigned old = xb_add(&bar[XB_XSUB(b.x)], 1u);
        const unsigned gen = old / nloc;
        if (old + 1u == (gen + 1u) * nloc) {
            __builtin_amdgcn_fence(__ATOMIC_RELEASE, "agent");
            asm volatile("s_waitcnt vmcnt(0)" ::: "memory");
            const unsigned og = xb_add(&bar[XB_TOP], 1u);
            const unsigned tg = og / nx;
            if (og + 1u == (tg + 1u) * nx) xb_add(&bar[XB_TOPGEN], 1u);
            else XB_SPIN(xb_ld(&bar[XB_TOPGEN]) == tg, bar);
            __builtin_amdgcn_fence(__ATOMIC_ACQUIRE, "agent");
            xb_add(&bar[XB_XGEN(b.x)], 1u);
            asm volatile("s_waitcnt vmcnt(0)" ::: "memory");
        } else {
            XB_SPIN(xb_ld(&bar[XB_XGEN(b.x)]) == gen, bar);
            __builtin_amdgcn_fence(__ATOMIC_ACQUIRE, "agent");
            asm volatile("s_waitcnt vmcnt(0)" ::: "memory");
        }
    }
    __syncthreads();
}

struct Args { const float* in[25]; float* dout; unsigned char* dws; int ph_lo, ph_hi, li, pad; };
enum InIdx { I_XP = 0, I_XS, I_PP, I_PS, I_ST_CONV, I_ST_DN, I_ST_RET, I_ST_FFN, I_ATTN_NW, I_WIN, I_DN_CONVW, I_ALOG, I_DTB, I_DN_NW, I_RET_NW,
             I_WOUT, I_FFN_NW, I_WUP, I_FFN_CW, I_FFN_CB, I_WDOWN, I_PLE_NW, I_WGATE, I_WPLE, I_FINAL_NW };
struct Frame {
    LAS unsigned char* lds; volatile LAS unsigned* MISC; gu32* ctl;
    int tid, lane, wave, G, gw, NGW;
};

__device__ __forceinline__ void transpose_item(const float* W, int ldw, int oc0, int K, bf16* WT, int n0, int k0, LAS float* scr, int lane, const float* kscale) {
#pragma unroll
    for (int i = 0; i < 32; ++i) { const int kk = 2 * i + (lane >> 5); float v = W[(size_t)(k0 + kk) * ldw + oc0 + (lane & 31)]; if (kscale) v *= kscale[k0 + kk]; scr[kk * 33 + (lane & 31)] = v; }
    LDS_WAIT(); asm volatile("" ::: "memory");
    const int c = lane & 7;
#pragma unroll
    for (int j = 0; j < 4; ++j) { const int n = (lane >> 3) + 8 * j; const LAS float* s = scr + (8 * c) * 33 + n;
        v4u o; o.x = pk2(s[0 * 33], s[1 * 33]); o.y = pk2(s[2 * 33], s[3 * 33]); o.z = pk2(s[4 * 33], s[5 * 33]); o.w = pk2(s[6 * 33], s[7 * 33]);
        *(GAS v4u*)(WT + (size_t)(n0 + n) * K + k0 + 8 * c) = o; }
    LDS_WAIT(); asm volatile("" ::: "memory");
}
template <int MODE>
__device__ __forceinline__ void rows_norm_phase(const Frame& F, const float* xp, const float* xs, const float* w, bf16* outb,
                                                const float* w_in, const float* A_log, const float* dt_bias, float* gb, LAS float* wsT) {
    const int lane = F.lane;
    if (MODE == 0) {
        for (int i = F.tid; i < 8192; i += 512) { const int k = i >> 3, c = i & 7; wsT[c * 1024 + k] = w_in[(size_t)k * 4104 + 2048 + c]; }
        __syncthreads();
    }
    f32x4 ww[4];
#pragma unroll
    for (int j = 0; j < 4; ++j) ww[j] = *(const f32x4*)(w + 4 * lane + 256 * j);
    int row = F.gw;
    f32x4 nx[4];
    if (row < T) { const float* x = (MODE == 0) ? (row < TP ? xp + (size_t)row * D : xs + (size_t)(row - TP) * D) : xp + (size_t)row * D;
#pragma unroll
        for (int j = 0; j < 4; ++j) nx[j] = *(const f32x4*)(x + 4 * lane + 256 * j); }
    for (; row < T; row += F.NGW) {
        f32x4 v[4];
#pragma unroll
        for (int j = 0; j < 4; ++j) v[j] = nx[j];
        const int nrow = row + F.NGW;
        if (nrow < T) { const float* x = (MODE == 0) ? (nrow < TP ? xp + (size_t)nrow * D : xs + (size_t)(nrow - TP) * D) : xp + (size_t)nrow * D;
#pragma unroll
            for (int j = 0; j < 4; ++j) nx[j] = *(const f32x4*)(x + 4 * lane + 256 * j); }
        float s = 0.f;
#pragma unroll
        for (int j = 0; j < 4; ++j) s += (v[j][0] * v[j][0] + v[j][1] * v[j][1]) + (v[j][2] * v[j][2] + v[j][3] * v[j][3]);
        s = wave_sum(s);
        const float rstd = rsqrtf(s * (1.f / D) + EPS);
#pragma unroll
        for (int j = 0; j < 4; ++j) {
            v[j] = v[j] * ww[j] * rstd;
            uint2 o; o.x = pk2(v[j][0], v[j][1]); o.y = pk2(v[j][2], v[j][3]);
            *(uint2*)(outb + (size_t)row * D + 4 * lane + 256 * j) = o;
        }
        if (MODE == 0) {
            float acc[8];
#pragma unroll
            for (int c = 0; c < 8; ++c) { float a = 0.f;
#pragma unroll
                for (int j = 0; j < 4; ++j) { const f32x4 wv = *(const LAS f32x4*)(wsT + c * 1024 + 4 * lane + 256 * j); a += (v[j][0] * wv[0] + v[j][1] * wv[1]) + (v[j][2] * wv[2] + v[j][3] * wv[3]); }
                acc[c] = wave_sum(a); }
            float r = 0.f;
#pragma unroll
            for (int c = 0; c < 8; ++c) r = (lane == c) ? acc[c] : r;
            if (lane < 4) gb[(size_t)row * 8 + lane] = sigmoid_f(r);
            else if (lane < 8) { const int h = lane - 4; const float xx = r + dt_bias[h]; const float sp = (xx > 20.f) ? xx : log1pf(__expf(xx)); gb[(size_t)row * 8 + lane] = -__expf(A_log[h]) * sp; }
        }
    }
}
__device__ __forceinline__ void trig_phase(const Frame& F, float2* trig) {
    for (int idx = blockIdx.x * 512 + F.tid; idx < 2056 * 64; idx += F.G * 512) {
        const int pi = idx >> 6, i = idx & 63;
        const int pos = pi < 2048 ? pi : 16384 + (pi - 2048);
        const float invf = (float)exp2(-(double)i * (2.0 / 128.0) * 13.287712379549449);
        const double a = (double)pos * (double)invf;
        const double rev = a * 0.15915494309189535;
        const double fr = rev - rint(rev);
        trig[idx] = make_float2(__builtin_amdgcn_cosf((float)fr), __builtin_amdgcn_sinf((float)fr));
    }
}
__device__ __forceinline__ void final_norm_phase(const Frame& F, float* h, const float* w) {
    const int lane = F.lane;
    for (int row = F.gw; row < T; row += F.NGW) {
        float* x = h + (size_t)row * D; f32x4 v[4]; float s = 0.f;
#pragma unroll
        for (int j = 0; j < 4; ++j) { v[j] = *(const f32x4*)(x + 4 * lane + 256 * j); s += v[j][0] * v[j][0] + v[j][1] * v[j][1] + v[j][2] * v[j][2] + v[j][3] * v[j][3]; }
        s = wave_sum(s); const float rstd = rsqrtf(s * (1.f / D) + EPS);
#pragma unroll
        for (int j = 0; j < 4; ++j) { const f32x4 ww = *(const f32x4*)(w + 4 * lane + 256 * j); *(f32x4*)(x + 4 * lane + 256 * j) = v[j] * ww * rstd; }
    }
}
__device__ __forceinline__ void bf8_to_f32(const v4u w, float* o) {
    o[0] = __uint_as_float(w.x << 16); o[1] = __uint_as_float(w.x & 0xffff0000u); o[2] = __uint_as_float(w.y << 16); o[3] = __uint_as_float(w.y & 0xffff0000u);
    o[4] = __uint_as_float(w.z << 16); o[5] = __uint_as_float(w.z & 0xffff0000u); o[6] = __uint_as_float(w.w << 16); o[7] = __uint_as_float(w.w & 0xffff0000u);
}
__device__ __forceinline__ void act_phase(const Frame& F, const bf16* u, int row0, int nrows, const float* cw, const float* cb, const float* st_ffn, bf16* act, float* out) {
    const int total = nrows * 352;
    for (int i = blockIdx.x * 512 + F.tid; i < total; i += F.G * 512) {
        const int lr = i / 352, g8 = i - lr * 352, ch = 8 * g8, row = row0 + lr;
        const bool prompt = row < TP; const int b = prompt ? row / SEQ : (row - TP) / DSEQ; const int pos = prompt ? row % SEQ : (row - TP) % DSEQ; const int L = prompt ? SEQ : DSEQ;
        const int ng = (ch >> 7) * 256 + (ch & 127), nv = ng + 128;
        float xg[3][8], xv[3][8];
#pragma unroll
        for (int r = 0; r < 3; ++r) {
            const int p = pos - 2 + r;
            if (p >= 0) { bf8_to_f32(*(const v4u*)(u + (size_t)(lr - 2 + r) * NUP + ng), xg[r]); bf8_to_f32(*(const v4u*)(u + (size_t)(lr - 2 + r) * NUP + nv), xv[r]); }
            else if (prompt) {
#pragma unroll
                for (int e = 0; e < 8; ++e) { xg[r][e] = 0.f; xv[r][e] = 0.f; }
            } else { const float* sp = st_ffn + ((size_t)b * 2 + (p + 2)) * NUP + ch;
#pragma unroll
                for (int e = 0; e < 8; ++e) { xg[r][e] = sp[e]; xv[r][e] = sp[DFF + e]; } }
        }
        float o[8];
#pragma unroll
        for (int e = 0; e < 8; ++e) {
            const int c = ch + e;
            const float ug = cw[c] * xg[0][e] + cw[NUP + c] * xg[1][e] + cw[2 * NUP + c] * xg[2][e] + cb[c];
            const float uv = cw[DFF + c] * xv[0][e] + cw[NUP + DFF + c] * xv[1][e] + cw[2 * NUP + DFF + c] * xv[2][e] + cb[DFF + c];
            o[e] = silu_f(ug) * uv;
        }
        v4u w; w.x = pk2(o[0], o[1]); w.y = pk2(o[2], o[3]); w.z = pk2(o[4], o[5]); w.w = pk2(o[6], o[7]);
        *(v4u*)(act + (size_t)row * DFF + ch) = w;
        if (pos >= L - 2) { float* op = out + (prompt ? O_FFN_P : O_FFN_S) + ((size_t)b * 2 + (pos - (L - 2))) * NUP + ch;
#pragma unroll
            for (int e = 0; e < 8; ++e) { op[e] = xg[2][e]; op[DFF + e] = xv[2][e]; } }
    }
}

__device__ __forceinline__ float grp_sum128(float v, LAS float* red, int w2, int lane) {
    v = wave_sum(v); __syncthreads(); if (lane == 0) red[w2] = v; __syncthreads(); return red[0] + red[1];
}
__device__ __forceinline__ void dn_item(LAS float* gl, int j, int w2, int lane, bool prompt, int b, int h, bf16* proj, const float* gb, const float* conv_w, const float* dn_norm_w,
                                        const float* st_conv, const float* st_dn, float* out) {
    LAS float* qs = gl; LAS float* ks = gl + 128; LAS float* red = gl + 256;
    const int L = prompt ? SEQ : DSEQ; const size_t row0 = prompt ? (size_t)b * SEQ : (size_t)TP + (size_t)b * DSEQ;
    float S[128];
#pragma unroll
    for (int d = 0; d < 128; ++d) S[d] = prompt ? 0.f : st_dn[((size_t)(b * 4 + h) * 128 + d) * 128 + j];
    const int cq = h * 128 + j, ck = 512 + h * 128 + j, cv = 1024 + h * 128 + j;
    float wq[4], wk[4], wv[4], xq[3], xk[3], xv[3];
#pragma unroll
    for (int i = 0; i < 4; ++i) { wq[i] = conv_w[i * 1536 + cq]; wk[i] = conv_w[i * 1536 + ck]; wv[i] = conv_w[i * 1536 + cv]; }
#pragma unroll
    for (int i = 0; i < 3; ++i) {
        xq[i] = prompt ? 0.f : st_conv[((size_t)b * 3 + i) * 1536 + cq];
        xk[i] = prompt ? 0.f : st_conv[((size_t)b * 3 + i) * 1536 + ck];
        xv[i] = prompt ? 0.f : st_conv[((size_t)b * 3 + i) * 1536 + cv];
    }
    const float nw = dn_norm_w[j];
    for (int t = 0; t < L; ++t) {
        const size_t row = row0 + t; bf16* pr = proj + row * NPROJ;
        const float pq = bf2f(pr[cq]), pk = bf2f(pr[ck]), pv = bf2f(pr[cv]);
        const float q0 = silu_f(wq[0] * xq[0] + wq[1] * xq[1] + wq[2] * xq[2] + wq[3] * pq);
        const float k0 = silu_f(wk[0] * xk[0] + wk[1] * xk[1] + wk[2] * xk[2] + wk[3] * pk);
        const float v0 = silu_f(wv[0] * xv[0] + wv[1] * xv[1] + wv[2] * xv[2] + wv[3] * pv);
        xq[0] = xq[1]; xq[1] = xq[2]; xq[2] = pq; xk[0] = xk[1]; xk[1] = xk[2]; xk[2] = pk; xv[0] = xv[1]; xv[1] = xv[2]; xv[2] = pv;
        const float sq = grp_sum128(q0 * q0, red, w2, lane), sk = grp_sum128(k0 * k0, red, w2, lane);
        qs[j] = q0 * rsqrtf(sq + EPS) * 0.08838834764831845f; ks[j] = k0 * rsqrtf(sk + EPS);
        __syncthreads();
        const float beta = gb[row * 8 + h], a = __expf(gb[row * 8 + 4 + h]);
        float kS = 0.f;
#pragma unroll
        for (int d = 0; d < 128; ++d) kS += ks[d] * S[d];
        const float delta = beta * (v0 - a * kS);
        float o = 0.f;
#pragma unroll
        for (int d = 0; d < 128; ++d) { S[d] = a * S[d] + ks[d] * delta; o += S[d] * qs[d]; }
        const float so = grp_sum128(o * o, red, w2, lane);
        const float z = bf2f(pr[3072 + h * 128 + j]);
        pr[3072 + h * 128 + j] = f2bf(o * rsqrtf(so * (1.f / 128.f) + EPS) * nw * silu_f(z));
    }
    float* so_ = out + (prompt ? O_DN_P : O_DN_S) + (size_t)(b * 4 + h) * 16384;
#pragma unroll
    for (int d = 0; d < 128; ++d) so_[d * 128 + j] = S[d];
    float* co = out + (prompt ? O_DNCONV_P : O_DNCONV_S) + (size_t)b * 3 * 1536;
#pragma unroll
    for (int i = 0; i < 3; ++i) { co[i * 1536 + cq] = xq[i]; co[i * 1536 + ck] = xk[i]; co[i * 1536 + cv] = xv[i]; }
}
__device__ __forceinline__ void ret_item(LAS float* gl, int j, int w2, int lane, bool prompt, int b, int h, bf16* proj, const float2* trig, const float* ret_norm_w, const float* st_ret, float* out) {
    LAS float* qs = gl; LAS float* ks = gl + 128; LAS float* red = gl + 256;
    const int L = prompt ? SEQ : DSEQ; const size_t row0 = prompt ? (size_t)b * SEQ : (size_t)TP + (size_t)b * DSEQ;
    float R[128];
#pragma unroll
    for (int d = 0; d < 128; ++d) R[d] = prompt ? 0.f : st_ret[((size_t)(b * 4 + h) * 128 + d) * 128 + j];
    const float gamma = 1.f - exp2f(-5.f - (float)h);
    const float nw = ret_norm_w[h * 128 + j];
    const int cq = 1536 + h * 128 + j, ck = 2048 + h * 128 + j, cv = 2560 + h * 128 + j, cg = 3584 + h * 128 + j;
    for (int t = 0; t < L; ++t) {
        const size_t row = row0 + t; bf16* pr = proj + row * NPROJ;
        const float q = bf2f(pr[cq]), k = bf2f(pr[ck]), v = bf2f(pr[cv]);
        __syncthreads();
        qs[j] = q; ks[j] = k;
        __syncthreads();
        const float2 cs = trig[(size_t)((prompt ? 0 : 2048) + t) * 64 + (j >> 1)];
        const float qp = qs[j ^ 1], kp = ks[j ^ 1];
        const float qr = (j & 1) ? (qp * cs.y + q * cs.x) : (q * cs.x - qp * cs.y);
        const float kr = ((j & 1) ? (kp * cs.y + k * cs.x) : (k * cs.x - kp * cs.y)) * 0.08838834764831845f;
        __syncthreads();
        qs[j] = qr; ks[j] = kr;
        __syncthreads();
        float o = 0.f;
#pragma unroll
        for (int d = 0; d < 128; ++d) { R[d] = gamma * R[d] + ks[d] * v; o += qs[d] * R[d]; }
        const float mu = grp_sum128(o, red, w2, lane) * (1.f / 128.f);
        const float dlt = o - mu;
        const float var = grp_sum128(dlt * dlt, red, w2, lane) * (1.f / 128.f);
        const float g = bf2f(pr[cg]);
        pr[cg] = f2bf(dlt * rsqrtf(var + EPS) * nw * silu_f(g));
    }
    float* so_ = out + (prompt ? O_RET_P : O_RET_S) + (size_t)(b * 4 + h) * 16384;
#pragma unroll
    for (int d = 0; d < 128; ++d) so_[d * 128 + j] = R[d];
}

__device__ __forceinline__ float grp_sum256(float v, LAS float* red, int w4, int lane) {
    v = wave_sum(v); __syncthreads(); if (lane == 0) red[w4] = v; __syncthreads(); return (red[0] + red[1]) + (red[2] + red[3]);
}
__device__ __forceinline__ void dn_item2(LAS float* gl, int t256, int w4, int lane, bool prompt, int b, int h, bf16* proj, const float* gb, const float* conv_w, const float* dn_norm_w,
                                         const float* st_conv, const float* st_dn, float* out) {
    LAS float* qs = gl; LAS float* ks = gl + 128; LAS float* red = gl + 256;
    const int j = t256 >> 1, half = t256 & 1, d0 = 64 * half; const float once = half ? 0.f : 1.f;
    const int L = prompt ? SEQ : DSEQ; const size_t row0 = prompt ? (size_t)b * SEQ : (size_t)TP + (size_t)b * DSEQ;
    float S[64];
#pragma unroll
    for (int d = 0; d < 64; ++d) S[d] = prompt ? 0.f : st_dn[((size_t)(b * 4 + h) * 128 + d0 + d) * 128 + j];
    const int cq = h * 128 + j, ck = 512 + h * 128 + j, cv = 1024 + h * 128 + j;
    float wq[4], wk[4], wv[4], xq[3], xk[3], xv[3];
#pragma unroll
    for (int i = 0; i < 4; ++i) { wq[i] = conv_w[i * 1536 + cq]; wk[i] = conv_w[i * 1536 + ck]; wv[i] = conv_w[i * 1536 + cv]; }
#pragma unroll
    for (int i = 0; i < 3; ++i) {
        xq[i] = prompt ? 0.f : st_conv[((size_t)b * 3 + i) * 1536 + cq];
        xk[i] = prompt ? 0.f : st_conv[((size_t)b * 3 + i) * 1536 + ck];
        xv[i] = prompt ? 0.f : st_conv[((size_t)b * 3 + i) * 1536 + cv];
    }
    const float nw = dn_norm_w[j];
    for (int t = 0; t < L; ++t) {
        const size_t row = row0 + t; bf16* pr = proj + row * NPROJ;
        const float pq = bf2f(pr[cq]), pk = bf2f(pr[ck]), pv = bf2f(pr[cv]);
        const float q0 = silu_f(wq[0] * xq[0] + wq[1] * xq[1] + wq[2] * xq[2] + wq[3] * pq);
        const float k0 = silu_f(wk[0] * xk[0] + wk[1] * xk[1] + wk[2] * xk[2] + wk[3] * pk);
        const float v0 = silu_f(wv[0] * xv[0] + wv[1] * xv[1] + wv[2] * xv[2] + wv[3] * pv);
        xq[0] = xq[1]; xq[1] = xq[2]; xq[2] = pq; xk[0] = xk[1]; xk[1] = xk[2]; xk[2] = pk; xv[0] = xv[1]; xv[1] = xv[2]; xv[2] = pv;
        const float sq = grp_sum256(q0 * q0 * once, red, w4, lane), sk = grp_sum256(k0 * k0 * once, red, w4, lane);
        if (!half) { qs[j] = q0 * rsqrtf(sq + EPS) * 0.08838834764831845f; ks[j] = k0 * rsqrtf(sk + EPS); }
        __syncthreads();
        const float beta = gb[row * 8 + h], a = __expf(gb[row * 8 + 4 + h]);
        float kS = 0.f;
#pragma unroll
        for (int d = 0; d < 64; ++d) kS += ks[d0 + d] * S[d];
        kS += __shfl_xor(kS, 1);
        const float delta = beta * (v0 - a * kS);
        float o = 0.f;
#pragma unroll
        for (int d = 0; d < 64; ++d) { S[d] = a * S[d] + ks[d0 + d] * delta; o += S[d] * qs[d0 + d]; }
        o += __shfl_xor(o, 1);
        const float so = grp_sum256(o * o * once, red, w4, lane);
        if (!half) { const float z = bf2f(pr[3072 + h * 128 + j]); pr[3072 + h * 128 + j] = f2bf(o * rsqrtf(so * (1.f / 128.f) + EPS) * nw * silu_f(z)); }
    }
    float* so_ = out + (prompt ? O_DN_P : O_DN_S) + (size_t)(b * 4 + h) * 16384;
#pragma unroll
    for (int d = 0; d < 64; ++d) so_[(d0 + d) * 128 + j] = S[d];
    if (!half) { float* co = out + (prompt ? O_DNCONV_P : O_DNCONV_S) + (size_t)b * 3 * 1536;
#pragma unroll
        for (int i = 0; i < 3; ++i) { co[i * 1536 + cq] = xq[i]; co[i * 1536 + ck] = xk[i]; co[i * 1536 + cv] = xv[i]; } }
}
__device__ __forceinline__ void ret_item2(LAS float* gl, int t256, int w4, int lane, bool prompt, int b, int h, bf16* proj, const float2* trig, const float* ret_norm_w, const float* st_ret, float* out) {
    LAS float* qs = gl; LAS float* ks = gl + 128; LAS float* red = gl + 256;
    const int j = t256 >> 1, half = t256 & 1, d0 = 64 * half; const float once = half ? 0.f : 1.f;
    const int L = prompt ? SEQ : DSEQ; const size_t row0 = prompt ? (size_t)b * SEQ : (size_t)TP + (size_t)b * DSEQ;
    float R[64];
#pragma unroll
    for (int d = 0; d < 64; ++d) R[d] = prompt ? 0.f : st_ret[((size_t)(b * 4 + h) * 128 + d0 + d) * 128 + j];
    const float gamma = 1.f - exp2f(-5.f - (float)h);
    const float nw = ret_norm_w[h * 128 + j];
    const int cq = 1536 + h * 128 + j, ck = 2048 + h * 128 + j, cv = 2560 + h * 128 + j, cg = 3584 + h * 128 + j;
    for (int t = 0; t < L; ++t) {
        const size_t row = row0 + t; bf16* pr = proj + row * NPROJ;
        const float q = bf2f(pr[cq]), k = bf2f(pr[ck]), v = bf2f(pr[cv]);
        __syncthreads();
        if (!half) { qs[j] = q; ks[j] = k; }
        __syncthreads();
        const float2 cs = trig[(size_t)((prompt ? 0 : 2048) + t) * 64 + (j >> 1)];
        const float qp = qs[j ^ 1], kp = ks[j ^ 1];
        const float qr = (j & 1) ? (qp * cs.y + q * cs.x) : (q * cs.x - qp * cs.y);
        const float kr = ((j & 1) ? (kp * cs.y + k * cs.x) : (k * cs.x - kp * cs.y)) * 0.08838834764831845f;
        __syncthreads();
        if (!half) { qs[j] = qr; ks[j] = kr; }
        __syncthreads();
        float o = 0.f;
#pragma unroll
        for (int d = 0; d < 64; ++d) { R[d] = gamma * R[d] + ks[d0 + d] * v; o += qs[d0 + d] * R[d]; }
        o += __shfl_xor(o, 1);
        const float mu = grp_sum256(o * once, red, w4, lane) * (1.f / 128.f);
        const float dlt = o - mu;
        const float var = grp_sum256(dlt * dlt * once, red, w4, lane) * (1.f / 128.f);
        if (!half) { const float g = bf2f(pr[cg]); pr[cg] = f2bf(dlt * rsqrtf(var + EPS) * nw * silu_f(g)); }
    }
    float* so_ = out + (prompt ? O_RET_P : O_RET_S) + (size_t)(b * 4 + h) * 16384;
#pragma unroll
    for (int d = 0; d < 64; ++d) so_[(d0 + d) * 128 + j] = R[d];
}


template <class Sched>
__device__ __forceinline__ void build_rstd_tables(const Frame& F, const Sched& S, const float* ssq, int rowbase, LAS float* tbl) {
    pg8::Unit u;
    for (int i = 0; S.next(i, u); ++i) {
        const int r = F.tid >> 1, hsel = F.tid & 1;
        const float* p = ssq + ((size_t)(rowbase + u.pm * 256 + r)) * 16 + hsel * 8;
        const f32x4 a = *(const f32x4*)p, b = *(const f32x4*)(p + 4);
        float s = ((a[0] + a[1]) + (a[2] + a[3])) + ((b[0] + b[1]) + (b[2] + b[3]));
        s += __shfl_xor(s, 1);
        if (!hsel) tbl[i * 256 + r] = rsqrtf(s * (1.f / 1024.f) + EPS);
    }
    __syncthreads();
}
__device__ __forceinline__ void final_norm_phase2(const Frame& F, float* h, const float* ssq, const float* w) {
    const int lane = F.lane;
    for (int row = F.gw; row < T; row += F.NGW) {
        float* x = h + (size_t)row * D;
        float s = lane < 16 ? ssq[(size_t)row * 16 + lane] : 0.f;
        s = wave_sum(s); const float rstd = rsqrtf(s * (1.f / D) + EPS);
#pragma unroll
        for (int j = 0; j < 4; ++j) { const f32x4 v = *(const f32x4*)(x + 4 * lane + 256 * j); const f32x4 ww = *(const f32x4*)(w + 4 * lane + 256 * j); *(f32x4*)(x + 4 * lane + 256 * j) = v * ww * rstd; }
    }
}

__device__ __forceinline__ void ffn_fixup_phase(const Frame& F, const float* ub, const float* cw, const float* cb, bf16* act, float* out) {
    const int total = 256 * 2 * 352;
    for (int i = blockIdx.x * 512 + F.tid; i < total; i += F.G * 512) {
        const int g8 = i % 352, gq = i / 352, q = gq & 1, G = gq >> 1, ch = 8 * g8, ng = (ch >> 7) * 256 + (ch & 127);
        const bool first = (G & 31) == 0;
        const float* cur = ub + ((size_t)G * 4 + q) * 5632 + ng;
        const float* p1 = q ? ub + ((size_t)G * 4) * 5632 + ng : ub + ((size_t)(G - 1) * 4 + 3) * 5632 + ng;
        const float* p2 = q ? ub + ((size_t)(G - 1) * 4 + 3) * 5632 + ng : ub + ((size_t)(G - 1) * 4 + 2) * 5632 + ng;
        const bool z1 = first && q == 0, z2 = first;
        float o[8];
#pragma unroll
        for (int hsel = 0; hsel < 2; ++hsel) {
            const f32x4 xg = *(const f32x4*)(cur + 4 * hsel), xv = *(const f32x4*)(cur + 128 + 4 * hsel);
            f32x4 g1 = {0.f, 0.f, 0.f, 0.f}, g2 = g1, v1 = g1, v2 = g1;
            if (!z1) { g1 = *(const f32x4*)(p1 + 4 * hsel); v1 = *(const f32x4*)(p1 + 128 + 4 * hsel); }
            if (!z2) { g2 = *(const f32x4*)(p2 + 4 * hsel); v2 = *(const f32x4*)(p2 + 128 + 4 * hsel); }
#pragma unroll
            for (int e = 0; e < 4; ++e) { const int c = ch + 4 * hsel + e;
                const float yg = cw[c] * g2[e] + cw[NUP + c] * g1[e] + cw[2 * NUP + c] * xg[e] + cb[c];
                const float yv = cw[DFF + c] * v2[e] + cw[NUP + DFF + c] * v1[e] + cw[2 * NUP + DFF + c] * xv[e] + cb[DFF + c];
                o[4 * hsel + e] = silu_f(yg) * yv; }
        }
        v4u w; w.x = pk2(o[0], o[1]); w.y = pk2(o[2], o[3]); w.z = pk2(o[4], o[5]); w.w = pk2(o[6], o[7]);
        *(v4u*)(act + (size_t)(64 * G + q) * DFF + ch) = w;
        if ((G & 31) == 31) {
            const float* s = ub + ((size_t)G * 4 + 2 + q) * 5632 + ng; float* op = out + O_FFN_P + ((size_t)(G >> 5) * 2 + q) * NUP + ch;
            *(f32x4*)op = *(const f32x4*)s; *(f32x4*)(op + 4) = *(const f32x4*)(s + 4); *(f32x4*)(op + DFF) = *(const f32x4*)(s + 128); *(f32x4*)(op + DFF + 4) = *(const f32x4*)(s + 132);
        }
    }
}

typedef __bf16 bfx8 __attribute__((ext_vector_type(8)));
typedef float f32x16 __attribute__((ext_vector_type(16)));
typedef float f32x8 __attribute__((ext_vector_type(8)));
#define MFMA32(a, b, c) __builtin_amdgcn_mfma_f32_32x32x16_bf16((a), (b), (c), 0, 0, 0)
__device__ __forceinline__ int crow(int reg, int h) { return (reg & 3) + 8 * (reg >> 2) + 4 * h; }
__device__ __forceinline__ bfx8 pack8(float a0, float a1, float a2, float a3, float a4, float a5, float a6, float a7) {
    const f32x8 v = {a0, a1, a2, a3, a4, a5, a6, a7}; return __builtin_convertvector(v, bfx8);
}
#define PACK_STEP(x, s) pack8((x)[8 * (s)], (x)[8 * (s) + 1], (x)[8 * (s) + 2], (x)[8 * (s) + 3], (x)[8 * (s) + 4], (x)[8 * (s) + 5], (x)[8 * (s) + 6], (x)[8 * (s) + 7])
__device__ __forceinline__ void st_frag(unsigned char* fragblk, int f, int l, bfx8 v) { *(bfx8*)(fragblk + (size_t)f * 1024 + l * 16) = v; }
__device__ __forceinline__ void lds_barrier() { asm volatile("s_waitcnt lgkmcnt(0)" ::: "memory"); __builtin_amdgcn_s_barrier(); asm volatile("" ::: "memory"); }
constexpr int IMG_STRIDE = 132;
constexpr int IMG_BYTES = 64 * IMG_STRIDE * 4;
constexpr int MAT_STRIDE = 68;
constexpr int MAT_BYTES = 64 * MAT_STRIDE * 4;
constexpr int RET_FRAG_P = 56 * 1024, RET_FRAG_S = 17 * 1024;
constexpr int SLOT_BYTES = 56 * 1024, OBUF_OFF = 2 * SLOT_BYTES, OBUF_STRIDE = 272, OBUF_BYTES = 64 * OBUF_STRIDE;

template <int C>
__device__ __forceinline__ void ret_prep_item(const Frame& F, bool prompt, int b, int h, int chunk, const bf16* proj, const float2* trig, unsigned char* frag) {
    constexpr int MT = C == 64 ? 2 : 1, KS = C == 64 ? 4 : 1;
    LAS float* Qi = (LAS float*)(F.lds); LAS float* Ki = (LAS float*)(F.lds + IMG_BYTES); LAS float* Vi = (LAS float*)(F.lds + 2 * IMG_BYTES);
    LAS float* QKM = (LAS float*)(F.lds + 3 * IMG_BYTES);
    const int tid = F.tid, lane = F.lane, wave = F.wave, hh = lane >> 5, l31 = lane & 31;
    const size_t row0 = prompt ? (size_t)b * SEQ + (size_t)chunk * 64 : (size_t)TP + (size_t)b * DSEQ;
    const int pos0 = prompt ? chunk * 64 : 2048;
    const float lg2 = log2f(1.f - exp2f(-5.f - (float)h));
    for (int w = tid; w < C * 32; w += 512) {
        const int t = w >> 5, c4 = (w & 31) * 4;
        const bf16* pr = proj + (row0 + t) * NPROJ + 1536 + h * 128 + c4;
        const uint2 q2 = *(const uint2*)pr, k2 = *(const uint2*)(pr + 512), v2 = *(const uint2*)(pr + 1024);
        const f32x4 tr = *(const f32x4*)(&trig[(size_t)(pos0 + t) * 64 + (c4 >> 1)]);
        const float q0 = __uint_as_float(q2.x << 16), q1 = __uint_as_float(q2.x & 0xffff0000u), q2_ = __uint_as_float(q2.y << 16), q3 = __uint_as_float(q2.y & 0xffff0000u);
        const float k0 = __uint_as_float(k2.x << 16), k1 = __uint_as_float(k2.x & 0xffff0000u), k2_ = __uint_as_float(k2.y << 16), k3 = __uint_as_float(k2.y & 0xffff0000u);
        const float sc = 0.08838834764831845f;
        f32x4 qo, ko, vo;
        qo[0] = q0 * tr[0] - q1 * tr[1]; qo[1] = q0 * tr[1] + q1 * tr[0]; qo[2] = q2_ * tr[2] - q3 * tr[3]; qo[3] = q2_ * tr[3] + q3 * tr[2];
        ko[0] = (k0 * tr[0] - k1 * tr[1]) * sc; ko[1] = (k0 * tr[1] + k1 * tr[0]) * sc; ko[2] = (k2_ * tr[2] - k3 * tr[3]) * sc; ko[3] = (k2_ * tr[3] + k3 * tr[2]) * sc;
        vo[0] = __uint_as_float(v2.x << 16); vo[1] = __uint_as_float(v2.x & 0xffff0000u); vo[2] = __uint_as_float(v2.y << 16); vo[3] = __uint_as_float(v2.y & 0xffff0000u);
        *(LAS f32x4*)(Qi + t * IMG_STRIDE + c4) = qo; *(LAS f32x4*)(Ki + t * IMG_STRIDE + c4) = ko; *(LAS f32x4*)(Vi + t * IMG_STRIDE + c4) = vo;
    }
    lds_barrier();
    if (wave < (C == 64 ? 3 : 1)) {
        const int mt = wave == 0 ? 0 : 1, nt = wave == 2 ? 1 : 0;
        const int ar = 32 * mt + l31, br = 32 * nt + l31;
        f32x16 acc;
#pragma unroll
        for (int r = 0; r < 16; ++r) acc[r] = 0.f;
#pragma unroll
        for (int ks = 0; ks < 8; ++ks) {
            const int k = 16 * ks + 8 * hh;
            f32x4 a0 = {0.f, 0.f, 0.f, 0.f}, a1 = a0, b0 = a0, b1 = a0;
            if (ar < C) { a0 = *(const LAS f32x4*)(Qi + ar * IMG_STRIDE + k); a1 = *(const LAS f32x4*)(Qi + ar * IMG_STRIDE + k + 4); }
            if (br < C) { b0 = *(const LAS f32x4*)(Ki + br * IMG_STRIDE + k); b1 = *(const LAS f32x4*)(Ki + br * IMG_STRIDE + k + 4); }
            acc = MFMA32(pack8(a0[0], a0[1], a0[2], a0[3], a1[0], a1[1], a1[2], a1[3]), pack8(b0[0], b0[1], b0[2], b0[3], b1[0], b1[1], b1[2], b1[3]), acc);
        }
#pragma unroll
        for (int r = 0; r < 16; ++r) { const int i = 32 * mt + crow(r, hh), j = 32 * nt + l31;
            QKM[i * MAT_STRIDE + j] = (i >= j && i < C) ? acc[r] * exp2f((float)(i - j) * lg2) : 0.f; }
    }
    if (C == 64 && wave == 3) {
#pragma unroll
        for (int r = 0; r < 16; ++r) QKM[crow(r, hh) * MAT_STRIDE + 32 + l31] = 0.f;
    }
    lds_barrier();
    constexpr int NF = MT * 8 + MT * KS + 4 * KS + 4 * KS;
    for (int p = tid; p < NF * 64; p += 512) {
        const int f = p >> 6, l = p & 63, lh = l >> 5, ll = l & 31;
        bfx8 o;
        if (f < MT * 8) {
            const int mt = f >> 3, ks = f & 7, t = 32 * mt + ll, k0 = 32 * (ks >> 1) + 16 * (ks & 1) + 4 * lh;
            f32x4 a0 = {0.f, 0.f, 0.f, 0.f}, a1 = a0;
            if (t < C) { const float sc = exp2f((float)(t + 1) * lg2); a0 = *(const LAS f32x4*)(Qi + t * IMG_STRIDE + k0) * sc; a1 = *(const LAS f32x4*)(Qi + t * IMG_STRIDE + k0 + 8) * sc; }
            o = pack8(a0[0], a0[1], a0[2], a0[3], a1[0], a1[1], a1[2], a1[3]);
        } else if (f < MT * 8 + MT * KS) {
            const int g = f - MT * 8, mt = g / KS, ks = g % KS, i = 32 * mt + ll, k0 = 16 * ks + 8 * lh;
            const f32x4 a0 = *(const LAS f32x4*)(QKM + i * MAT_STRIDE + k0), a1 = *(const LAS f32x4*)(QKM + i * MAT_STRIDE + k0 + 4);
            o = pack8(a0[0], a0[1], a0[2], a0[3], a1[0], a1[1], a1[2], a1[3]);
        } else if (f < MT * 8 + MT * KS + 4 * KS) {
            const int g = f - MT * 8 - MT * KS, mt4 = g / KS, ks = g % KS, d = 32 * mt4 + ll, t0 = 16 * ks + 8 * lh;
            float e[8];
#pragma unroll
            for (int j = 0; j < 8; ++j) { const int t = t0 + j; e[j] = t < C ? Ki[t * IMG_STRIDE + d] * exp2f((float)(C - 1 - t) * lg2) : 0.f; }
            o = pack8(e[0], e[1], e[2], e[3], e[4], e[5], e[6], e[7]);
        } else {
            const int g = f - MT * 8 - MT * KS - 4 * KS, s = g / KS, ks = g % KS, dv = 32 * s + ll, t0 = 16 * ks + 8 * lh;
            float e[8];
#pragma unroll
            for (int j = 0; j < 8; ++j) { const int t = t0 + j; e[j] = t < C ? Vi[t * IMG_STRIDE + dv] : 0.f; }
            o = pack8(e[0], e[1], e[2], e[3], e[4], e[5], e[6], e[7]);
        }
        st_frag(frag, f, l, o);
    }
    lds_barrier();
}

__device__ __forceinline__ void ret_stream(const Frame& F, int b, int h, const unsigned char* frag0, bf16* proj, const float* ret_norm_w, float* out) {
    const int lane = F.lane, wave = F.wave, hh = lane >> 5, l31 = lane & 31;
    constexpr int NC = 32;
    const float cd = exp2f(64.f * log2f(1.f - exp2f(-5.f - (float)h)));
    if (wave < 4) {
        const int s = wave;
        f32x16 R[4];
#pragma unroll
        for (int t = 0; t < 4; ++t)
#pragma unroll
            for (int r = 0; r < 16; ++r) R[t][r] = 0.f;
        for (int c = 0; c < NC; ++c) {
            lds_barrier();
            const LAS unsigned char* slot = F.lds + (c & 1) * SLOT_BYTES + lane * 16;
            LAS unsigned char* ob = F.lds + OBUF_OFF + (c & 1) * OBUF_BYTES;
            f32x16 accO[2];
#pragma unroll
            for (int mt = 0; mt < 2; ++mt)
#pragma unroll
                for (int r = 0; r < 16; ++r) accO[mt][r] = 0.f;
#pragma unroll
            for (int ks = 0; ks < 8; ++ks) {
                const bfx8 rb = (ks & 1) ? PACK_STEP(R[ks >> 1], 1) : PACK_STEP(R[ks >> 1], 0);
#pragma unroll
                for (int mt = 0; mt < 2; ++mt) accO[mt] = MFMA32(*(const LAS bfx8*)(slot + (mt * 8 + ks) * 1024), rb, accO[mt]);
            }
            bfx8 vt[4];
#pragma unroll
            for (int ks = 0; ks < 4; ++ks) vt[ks] = *(const LAS bfx8*)(slot + (40 + s * 4 + ks) * 1024);
#pragma unroll
            for (int ks = 0; ks < 4; ++ks)
#pragma unroll
                for (int mt = 0; mt < 2; ++mt) accO[mt] = MFMA32(*(const LAS bfx8*)(slot + (16 + mt * 4 + ks) * 1024), vt[ks], accO[mt]);
#pragma unroll
            for (int t = 0; t < 4; ++t) {
                R[t] = R[t] * cd;
#pragma unroll
                for (int ks = 0; ks < 4; ++ks) R[t] = MFMA32(*(const LAS bfx8*)(slot + (24 + t * 4 + ks) * 1024), vt[ks], R[t]);
            }
#pragma unroll
            for (int mt = 0; mt < 2; ++mt)
#pragma unroll
                for (int r = 0; r < 16; ++r) *(LAS bf16*)(ob + (32 * mt + crow(r, hh)) * OBUF_STRIDE + (32 * s + l31) * 2) = f2bf(accO[mt][r]);
        }
        lds_barrier();
        float* so = out + O_RET_P + (size_t)(b * 4 + h) * 16384;
#pragma unroll
        for (int t = 0; t < 4; ++t)
#pragma unroll
            for (int r = 0; r < 16; ++r) so[(unsigned)((32 * t + crow(r, hh)) * 128 + 32 * s + l31)] = R[t][r];
    } else {
        const int hw = wave - 4, part = lane >> 4, tok = 16 * hw + (lane & 15);
        float nw[32];
#pragma unroll
        for (int e = 0; e < 32; ++e) nw[e] = ret_norm_w[h * 128 + part * 32 + e];
        { const unsigned char* src = frag0;
#pragma unroll
          for (int i = 0; i < 14; ++i) { const int f = hw + 4 * i;
              __builtin_amdgcn_global_load_lds((const unsigned*)(src + (size_t)f * 1024 + lane * 16), (LAS unsigned*)(F.lds + f * 1024), 16, 0, 0); } }
        VM_WAIT();
        v4u gz[4], gn[4];
#pragma unroll
        for (int q = 0; q < 4; ++q) gz[q] = gn[q] = (v4u){0u, 0u, 0u, 0u};
        for (int c = 0; c <= NC; ++c) {
            lds_barrier();
#pragma unroll
            for (int q = 0; q < 4; ++q) { gz[q] = gn[q]; asm volatile("" : "+v"(gz[q])); }
            if (c + 1 < NC) {
                const unsigned char* src = frag0 + (size_t)(c + 1) * RET_FRAG_P; LAS unsigned char* dst = F.lds + ((c + 1) & 1) * SLOT_BYTES;
#pragma unroll
                for (int i = 0; i < 14; ++i) { const int f = hw + 4 * i;
                    __builtin_amdgcn_global_load_lds((const unsigned*)(src + (size_t)f * 1024 + lane * 16), (LAS unsigned*)(dst + f * 1024), 16, 0, 0); }
            }
            if (c < NC) {
                const bf16* gpn = proj + ((size_t)b * SEQ + (size_t)c * 64 + tok) * NPROJ + 3584 + h * 128 + part * 32;
#pragma unroll
                for (int q = 0; q < 4; ++q) gn[q] = *(const v4u*)(gpn + 8 * q);
            }
            if (c >= 1) {
                const int cc = c - 1;
                const LAS unsigned char* ob = F.lds + OBUF_OFF + (cc & 1) * OBUF_BYTES + tok * OBUF_STRIDE + part * 64;
                float o[32];
#pragma unroll
                for (int q = 0; q < 4; ++q) bf8_to_f32(*(const LAS v4u*)(ob + q * 16), o + 8 * q);
                float sm = 0.f;
#pragma unroll
                for (int e = 0; e < 32; ++e) sm += o[e];
                sm += __shfl_xor(sm, 16); sm += __shfl_xor(sm, 32);
                const float mu = sm * (1.f / 128.f); float vs = 0.f;
#pragma unroll
                for (int e = 0; e < 32; ++e) { o[e] -= mu; vs += o[e] * o[e]; }
                vs += __shfl_xor(vs, 16); vs += __shfl_xor(vs, 32);
                const float rstd = rsqrtf(vs * (1.f / 128.f) + EPS);
                bf16* gp = proj + ((size_t)b * SEQ + (size_t)cc * 64 + tok) * NPROJ + 512 + h * 128 + part * 32;
#pragma unroll
                for (int q = 0; q < 4; ++q) {
                    float g[8]; bf8_to_f32(gz[q], g);
                    float y[8];
#pragma unroll
                    for (int e = 0; e < 8; ++e) y[e] = o[8 * q + e] * rstd * nw[8 * q + e] * silu_f(g[e]);
                    v4u w; w.x = pk2(y[0], y[1]); w.y = pk2(y[2], y[3]); w.z = pk2(y[4], y[5]); w.w = pk2(y[6], y[7]);
                    *(v4u*)(gp + 8 * q) = w;
                }
            }
            VM_WAIT();
        }
    }
}

__device__ __forceinline__ void ret_sample_item(const Frame& F, bool active, int b, int h, const unsigned char* frag, bf16* proj, const float* ret_norm_w, const float* st_ret, float* out) {
    int lane = F.lane; asm volatile("" : "+v"(lane));
    const int wave = F.wave, s = wave & 3, team = wave >> 2, hh = lane >> 5, l31 = lane & 31;
    LAS float* xch = (LAS float*)(F.lds) + team * 64;
    f32x16 R[4]; f32x16 accO;
    if (active) {
        const float* sp = st_ret + (size_t)(b * 4 + h) * 16384;
#pragma unroll
        for (int t = 0; t < 4; ++t)
#pragma unroll
            for (int r = 0; r < 16; ++r) R[t][r] = sp[(unsigned)((32 * t + crow(r, hh)) * 128 + 32 * s + l31)];
        const unsigned char* fb = frag + lane * 16;
#pragma unroll
        for (int r = 0; r < 16; ++r) accO[r] = 0.f;
#pragma unroll
        for (int ks = 0; ks < 8; ++ks) {
            const bfx8 rb = (ks & 1) ? PACK_STEP(R[ks >> 1], 1) : PACK_STEP(R[ks >> 1], 0);
            accO = MFMA32(*(const bfx8*)(fb + ks * 1024), rb, accO);
        }
        const bfx8 vt = *(const bfx8*)(fb + (13 + s) * 1024);
        accO = MFMA32(*(const bfx8*)(fb + 8 * 1024), vt, accO);
        const float cd = exp2f(8.f * log2f(1.f - exp2f(-5.f - (float)h)));
#pragma unroll
        for (int t = 0; t < 4; ++t) { R[t] = R[t] * cd; R[t] = MFMA32(*(const bfx8*)(fb + (9 + t) * 1024), vt, R[t]); }
#pragma unroll
        for (int r = 0; r < 4; ++r) {
            float sm = accO[r], sq = accO[r] * accO[r];
#pragma unroll
            for (int o = 1; o < 32; o <<= 1) { sm += __shfl_xor(sm, o); sq += __shfl_xor(sq, o); }
            if (l31 == 0) { xch[((4 * hh + r) * 4 + s) * 2] = sm; xch[((4 * hh + r) * 4 + s) * 2 + 1] = sq; }
        }
    }
    __syncthreads();
    if (active) {
#pragma unroll
        for (int r = 0; r < 4; ++r) {
            const int tok = 4 * hh + r; float sm = 0.f, sq = 0.f;
#pragma unroll
            for (int q = 0; q < 4; ++q) { sm += xch[(tok * 4 + q) * 2]; sq += xch[(tok * 4 + q) * 2 + 1]; }
            const float mu = sm * (1.f / 128.f), var = fmaxf(sq * (1.f / 128.f) - mu * mu, 0.f);
            bf16* gp = proj + ((size_t)TP + (size_t)b * DSEQ + tok) * NPROJ + 3584 + h * 128 + 32 * s + l31;
            const float g = bf2f(*gp);
            *(gp - 3072) = f2bf((accO[r] - mu) * rsqrtf(var + EPS) * ret_norm_w[h * 128 + 32 * s + l31] * silu_f(g));
        }
        float* so = out + O_RET_S + (size_t)(b * 4 + h) * 16384;
#pragma unroll
        for (int t = 0; t < 4; ++t)
#pragma unroll
            for (int r = 0; r < 16; ++r) so[(unsigned)((32 * t + crow(r, hh)) * 128 + 32 * s + l31)] = R[t][r];
    }
    __syncthreads();
}

constexpr int DN_FRAG_P = 72 * 1024, DN_FRAG_S = 29 * 1024;
constexpr int VEC_OFF = 3 * IMG_BYTES + 2 * MAT_BYTES;
template <int C>
__device__ __forceinline__ void dn_prep_item(const Frame& F, bool prompt, int b, int h, int chunk, const bf16* proj, const float* gb, const float* conv_w, const float* st_conv,
                                             unsigned char* frag, float* glast, float* out) {
    constexpr int MT = C == 64 ? 2 : 1, KS = C == 64 ? 4 : 1, TQ = C == 64 ? 16 : 8, NQ = C / TQ;
    LAS float* Qi = (LAS float*)(F.lds); LAS float* Ki = (LAS float*)(F.lds + IMG_BYTES); LAS float* Vi = (LAS float*)(F.lds + 2 * IMG_BYTES);
    LAS float* AM = (LAS float*)(F.lds + 3 * IMG_BYTES); LAS float* QKM = (LAS float*)(F.lds + 3 * IMG_BYTES + MAT_BYTES);
    LAS float* gcv = (LAS float*)(F.lds + VEC_OFF); LAS float* betav = gcv + 64; LAS float* egv = gcv + 128;
    const int tid = F.tid, lane = F.lane, wave = F.wave, hh = lane >> 5, l31 = lane & 31;
    const size_t row0 = prompt ? (size_t)b * SEQ + (size_t)chunk * 64 : (size_t)TP + (size_t)b * DSEQ;
    if (tid < 96 * NQ) {
        const int cgi = tid % 96, tq = tid / 96, which = cgi >> 5, c4 = (cgi & 31) * 4, col = which * 512 + h * 128 + c4, t0 = tq * TQ;
        f32x4 w[4];
#pragma unroll
        for (int j = 0; j < 4; ++j) w[j] = *(const f32x4*)(conv_w + j * 1536 + col);
        f32x4 x0, x1, x2;
        if (t0 == 0 && chunk == 0) {
            if (prompt) { x0 = (f32x4){0.f, 0.f, 0.f, 0.f}; x1 = x0; x2 = x0; }
            else { const float* sp = st_conv + (size_t)b * 3 * 1536 + col; x0 = *(const f32x4*)sp; x1 = *(const f32x4*)(sp + 1536); x2 = *(const f32x4*)(sp + 2 * 1536); }
        } else {
            const bf16* pp = proj + (row0 + t0 - 3) * NPROJ + col;
            const uint2 a = *(const uint2*)pp, bq = *(const uint2*)(pp + NPROJ), cq = *(const uint2*)(pp + 2 * NPROJ);
            x0 = (f32x4){__uint_as_float(a.x << 16), __uint_as_float(a.x & 0xffff0000u), __uint_as_float(a.y << 16), __uint_as_float(a.y & 0xffff0000u)};
            x1 = (f32x4){__uint_as_float(bq.x << 16), __uint_as_float(bq.x & 0xffff0000u), __uint_as_float(bq.y << 16), __uint_as_float(bq.y & 0xffff0000u)};
            x2 = (f32x4){__uint_as_float(cq.x << 16), __uint_as_float(cq.x & 0xffff0000u), __uint_as_float(cq.y << 16), __uint_as_float(cq.y & 0xffff0000u)};
        }
        LAS float* img = (which == 0 ? Qi : (which == 1 ? Ki : Vi));
        uint2 raw[TQ];
#pragma unroll
        for (int i = 0; i < TQ; ++i) raw[i] = *(const uint2*)(proj + (row0 + t0 + i) * NPROJ + col);
#pragma unroll
        for (int i = 0; i < TQ; ++i) {
            const uint2 a = raw[i];
            const f32x4 x3 = {__uint_as_float(a.x << 16), __uint_as_float(a.x & 0xffff0000u), __uint_as_float(a.y << 16), __uint_as_float(a.y & 0xffff0000u)};
            const f32x4 y = w[0] * x0 + w[1] * x1 + w[2] * x2 + w[3] * x3;
            f32x4 o;
#pragma unroll
            for (int e = 0; e < 4; ++e) o[e] = silu_f(y[e]);
            *(LAS f32x4*)(img + (t0 + i) * IMG_STRIDE + c4) = o;
            x0 = x1; x1 = x2; x2 = x3;
        }
        if ((prompt && chunk == 31 && tq == NQ - 1) || !prompt) {
            float* co = out + (prompt ? O_DNCONV_P : O_DNCONV_S) + (size_t)b * 3 * 1536 + col;
            *(f32x4*)co = x0; *(f32x4*)(co + 1536) = x1; *(f32x4*)(co + 2 * 1536) = x2;
        }
    }
    lds_barrier();
    if (tid < C * 8) {
        const int tok = tid >> 3, part = tid & 7;
        LAS float* qp = Qi + tok * IMG_STRIDE + part * 16; LAS float* kp = Ki + tok * IMG_STRIDE + part * 16;
        f32x4 q[4], k[4]; float sq = 0.f, sk = 0.f;
#pragma unroll
        for (int i = 0; i < 4; ++i) { q[i] = *(LAS f32x4*)(qp + 4 * i); k[i] = *(LAS f32x4*)(kp + 4 * i);
            sq += q[i][0] * q[i][0] + q[i][1] * q[i][1] + q[i][2] * q[i][2] + q[i][3] * q[i][3]; sk += k[i][0] * k[i][0] + k[i][1] * k[i][1] + k[i][2] * k[i][2] + k[i][3] * k[i][3]; }
        sq += __shfl_xor(sq, 1); sq += __shfl_xor(sq, 2); sq += __shfl_xor(sq, 4);
        sk += __shfl_xor(sk, 1); sk += __shfl_xor(sk, 2); sk += __shfl_xor(sk, 4);
        const float rq = rsqrtf(sq + EPS) * 0.08838834764831845f, rk = rsqrtf(sk + EPS);
#pragma unroll
        for (int i = 0; i < 4; ++i) { *(LAS f32x4*)(qp + 4 * i) = q[i] * rq; *(LAS f32x4*)(kp + 4 * i) = k[i] * rk; }
    }
    if (wave == 7) {
        float g = lane < C ? gb[(row0 + lane) * 8 + 4 + h] : 0.f;
#pragma unroll
        for (int o = 1; o < 64; o <<= 1) { const float t = __shfl_up(g, o); if (lane >= o) g += t; }
        if (lane < C) { gcv[lane] = g; egv[lane] = __expf(g); betav[lane] = gb[(row0 + lane) * 8 + h]; }
        else { gcv[lane] = 0.f; egv[lane] = 0.f; betav[lane] = 0.f; }
    }
    lds_barrier();
    {
        constexpr int NTL = C == 64 ? 3 : 1;
        if (wave < 2 * NTL) {
            const int kind = wave / NTL, ti = wave % NTL, mt = ti == 0 ? 0 : 1, nt = ti == 2 ? 1 : 0;
            const int ar = 32 * mt + l31, br = 32 * nt + l31;
            const LAS float* Ai = kind == 0 ? Ki : Qi;
            f32x16 acc;
#pragma unroll
            for (int r = 0; r < 16; ++r) acc[r] = 0.f;
#pragma unroll
            for (int ks = 0; ks < 8; ++ks) {
                const int k = 16 * ks + 8 * hh;
                f32x4 a0 = {0.f, 0.f, 0.f, 0.f}, a1 = a0, b0 = a0, b1 = a0;
                if (ar < C) { a0 = *(const LAS f32x4*)(Ai + ar * IMG_STRIDE + k); a1 = *(const LAS f32x4*)(Ai + ar * IMG_STRIDE + k + 4); }
                if (br < C) { b0 = *(const LAS f32x4*)(Ki + br * IMG_STRIDE + k); b1 = *(const LAS f32x4*)(Ki + br * IMG_STRIDE + k + 4); }
                acc = MFMA32(pack8(a0[0], a0[1], a0[2], a0[3], a1[0], a1[1], a1[2], a1[3]), pack8(b0[0], b0[1], b0[2], b0[3], b1[0], b1[1], b1[2], b1[3]), acc);
            }
            LAS float* M = kind == 0 ? AM : QKM;
            const int j = 32 * nt + l31; const float gj = gcv[j];
#pragma unroll
            for (int r = 0; r < 16; ++r) { const int i = 32 * mt + crow(r, hh);
                const bool keep = (kind == 0 ? i > j : i >= j) && i < C;
                float v = 0.f;
                if (keep) v = acc[r] * __expf(gcv[i] - gj) * (kind == 0 ? betav[i] : 1.f);
                M[i * MAT_STRIDE + j] = v; }
        } else if (C == 64) {
            LAS float* M = wave == 6 ? AM : QKM;
#pragma unroll
            for (int r = 0; r < 16; ++r) M[crow(r, hh) * MAT_STRIDE + 32 + l31] = 0.f;
        }
    }
    {
        constexpr int F_KT = 2 * MT * 8 + MT * KS;
        const float gl = gcv[C - 1];
        for (int p = tid; p < 4 * KS * 64; p += 512) {
            const int g = p >> 6, l = p & 63, lh = l >> 5, ll = l & 31, mt4 = g / KS, ks = g % KS, d = 32 * mt4 + ll, k0 = 32 * (ks >> 1) + 16 * (ks & 1) + 4 * lh;
            float e[8];
#pragma unroll
            for (int j = 0; j < 8; ++j) { const int t = k0 + (j & 3) + 8 * (j >> 2); e[j] = t < C ? Ki[t * IMG_STRIDE + d] * __expf(gl - gcv[t]) : 0.f; }
            st_frag(frag, F_KT + g, l, pack8(e[0], e[1], e[2], e[3], e[4], e[5], e[6], e[7]));
        }
    }
    lds_barrier();
    if (wave < 4) {
        const bool isw = wave >= 2; const int c = tid & 127;
        LAS float* img = (isw ? Ki : Vi) + c;
#pragma unroll 16
        for (int t = 0; t < C; ++t) img[t * IMG_STRIDE] *= betav[t] * (isw ? egv[t] : 1.f);
        constexpr int BS = C == 64 ? 16 : 8, NBK = C / BS;
        for (int blk = 0; blk < NBK; ++blk) {
            const int r0 = blk * BS;
            float x[BS];
#pragma unroll
            for (int i = 0; i < BS; ++i) x[i] = img[(r0 + i) * IMG_STRIDE];
#pragma unroll
            for (int i = 1; i < BS; ++i) {
                float a0 = 0.f, a1 = 0.f, a2 = 0.f, a3 = 0.f;
#pragma unroll
                for (int q = 0; q < (i + 3) / 4; ++q) {
                    const f32x4 a = *(const LAS f32x4*)(AM + (r0 + i) * MAT_STRIDE + r0 + 4 * q);
                    a0 += a[0] * x[4 * q];
                    if (4 * q + 1 < i) a1 += a[1] * x[4 * q + 1];
                    if (4 * q + 2 < i) a2 += a[2] * x[4 * q + 2];
                    if (4 * q + 3 < i) a3 += a[3] * x[4 * q + 3];
                }
                x[i] -= (a0 + a1) + (a2 + a3);
            }
#pragma unroll
            for (int i = 0; i < BS; ++i) img[(r0 + i) * IMG_STRIDE] = x[i];
#pragma unroll 4
            for (int r = r0 + BS; r < C; ++r) {
                float a0 = 0.f, a1 = 0.f, a2 = 0.f, a3 = 0.f;
#pragma unroll
                for (int q = 0; q < BS / 4; ++q) {
                    const f32x4 a = *(const LAS f32x4*)(AM + r * MAT_STRIDE + r0 + 4 * q);
                    a0 += a[0] * x[4 * q]; a1 += a[1] * x[4 * q + 1]; a2 += a[2] * x[4 * q + 2]; a3 += a[3] * x[4 * q + 3];
                }
                img[r * IMG_STRIDE] -= (a0 + a1) + (a2 + a3);
            }
        }
    } else {
        constexpr int F_QD = MT * 8, F_QK = 2 * MT * 8, NFH = MT * 8 + MT * KS;
        for (int p = tid - 256; p < NFH * 64; p += 256) {
            const int fi = p >> 6, l = p & 63, lh = l >> 5, ll = l & 31;
            bfx8 o; int f;
            if (fi < MT * 8) {
                const int mt = fi >> 3, ks = fi & 7, t = 32 * mt + ll, k0 = 32 * (ks >> 1) + 16 * (ks & 1) + 4 * lh;
                f32x4 a0 = {0.f, 0.f, 0.f, 0.f}, a1 = a0;
                if (t < C) { const float sc = egv[t]; a0 = *(const LAS f32x4*)(Qi + t * IMG_STRIDE + k0) * sc; a1 = *(const LAS f32x4*)(Qi + t * IMG_STRIDE + k0 + 8) * sc; }
                o = pack8(a0[0], a0[1], a0[2], a0[3], a1[0], a1[1], a1[2], a1[3]); f = F_QD + fi;
            } else {
                const int g = fi - MT * 8, mt = g / KS, ks = g % KS, i = 32 * mt + ll, k0 = 32 * (ks >> 1) + 16 * (ks & 1) + 4 * lh;
                const f32x4 a0 = *(const LAS f32x4*)(QKM + i * MAT_STRIDE + k0), a1 = *(const LAS f32x4*)(QKM + i * MAT_STRIDE + k0 + 8);
                o = pack8(a0[0], a0[1], a0[2], a0[3], a1[0], a1[1], a1[2], a1[3]); f = F_QK + g;
            }
            st_frag(frag, f, l, o);
        }
    }
    lds_barrier();
    {
        constexpr int F_U = 2 * MT * 8 + MT * KS + 4 * KS, NF6 = MT * 8 + 4 * MT * 2;
        for (int p = tid; p < NF6 * 64; p += 512) {
            const int fi = p >> 6, l = p & 63, lh = l >> 5, ll = l & 31;
            bfx8 o; int f;
            if (fi < MT * 8) {
                const int mt = fi >> 3, ks = fi & 7, t = 32 * mt + ll, k0 = 32 * (ks >> 1) + 16 * (ks & 1) + 4 * lh;
                f32x4 a0 = {0.f, 0.f, 0.f, 0.f}, a1 = a0;
                if (t < C) { a0 = -*(const LAS f32x4*)(Ki + t * IMG_STRIDE + k0); a1 = -*(const LAS f32x4*)(Ki + t * IMG_STRIDE + k0 + 8); }
                o = pack8(a0[0], a0[1], a0[2], a0[3], a1[0], a1[1], a1[2], a1[3]); f = fi;
            } else {
                const int g = fi - MT * 8, half = g & 1, sm = g >> 1, mt = sm % MT, s = sm / MT, dv = 32 * s + ll;
                float e[8];
#pragma unroll
                for (int j = 0; j < 8; ++j) { const int t = 32 * mt + crow(8 * half + j, lh); e[j] = t < C ? Vi[t * IMG_STRIDE + dv] : 0.f; }
                o = pack8(e[0], e[1], e[2], e[3], e[4], e[5], e[6], e[7]); f = F_U + g;
            }
            st_frag(frag, f, l, o);
        }
        if (tid == 0) *glast = egv[C - 1];
    }
    lds_barrier();
}

__device__ __forceinline__ void dn_stream(const Frame& F, int b, int h, const unsigned char* frag_lo, const unsigned char* frag_hi, int split,
                                          const float* glast, bf16* proj, const float* dn_norm_w, float* out) {
    const int lane = F.lane, wave = F.wave, hh = lane >> 5, l31 = lane & 31;
    constexpr int NC = 32;
    const int it0 = (b * 4 + h) * 32;
#define DN_ITEM_PTR(c) (((it0 + (c)) < split) ? frag_lo + (size_t)(it0 + (c)) * DN_FRAG_P : frag_hi + (size_t)(it0 + (c) - split) * DN_FRAG_P)
    if (wave < 4) {
        const int s = wave;
        f32x16 S[4];
#pragma unroll
        for (int t = 0; t < 4; ++t)
#pragma unroll
            for (int r = 0; r < 16; ++r) S[t][r] = 0.f;
        v4u un[4]; float decn;
        { const unsigned char* ub = DN_ITEM_PTR(0) + (size_t)(56 + s * 4) * 1024 + lane * 16;
#pragma unroll
          for (int i = 0; i < 4; ++i) un[i] = *(const v4u*)(ub + i * 1024);
          decn = glast[it0]; }
        for (int c = 0; c < NC; ++c) {
            v4u uc[4]; float dec = decn;
#pragma unroll
            for (int i = 0; i < 4; ++i) uc[i] = un[i];
            lds_barrier();
            if (c + 1 < NC) {
                const unsigned char* ub = DN_ITEM_PTR(c + 1) + (size_t)(56 + s * 4) * 1024 + lane * 16;
#pragma unroll
                for (int i = 0; i < 4; ++i) un[i] = *(const v4u*)(ub + i * 1024);
                decn = glast[it0 + c + 1];
            }
            const LAS unsigned char* slot = F.lds + (c & 1) * SLOT_BYTES + lane * 16;
            LAS unsigned char* ob = F.lds + OBUF_OFF + (c & 1) * OBUF_BYTES;
            f32x16 accV[2], accO[2];
            { float t8[8];
              bf8_to_f32(uc[0], t8);
#pragma unroll
              for (int e = 0; e < 8; ++e) accV[0][e] = t8[e];
              bf8_to_f32(uc[1], t8);
#pragma unroll
              for (int e = 0; e < 8; ++e) accV[0][8 + e] = t8[e];
              bf8_to_f32(uc[2], t8);
#pragma unroll
              for (int e = 0; e < 8; ++e) accV[1][e] = t8[e];
              bf8_to_f32(uc[3], t8);
#pragma unroll
              for (int e = 0; e < 8; ++e) accV[1][8 + e] = t8[e]; }
#pragma unroll
            for (int mt = 0; mt < 2; ++mt)
#pragma unroll
                for (int r = 0; r < 16; ++r) accO[mt][r] = 0.f;
#pragma unroll
            for (int ks = 0; ks < 8; ++ks) {
                const bfx8 sb = (ks & 1) ? PACK_STEP(S[ks >> 1], 1) : PACK_STEP(S[ks >> 1], 0);
#pragma unroll
                for (int mt = 0; mt < 2; ++mt) {
                    accV[mt] = MFMA32(*(const LAS bfx8*)(slot + (mt * 8 + ks) * 1024), sb, accV[mt]);
                    accO[mt] = MFMA32(*(const LAS bfx8*)(slot + (16 + mt * 8 + ks) * 1024), sb, accO[mt]);
                }
                if (ks & 1) asm volatile("" ::: "memory");
            }
            bfx8 vb[4];
            vb[0] = PACK_STEP(accV[0], 0); vb[1] = PACK_STEP(accV[0], 1); vb[2] = PACK_STEP(accV[1], 0); vb[3] = PACK_STEP(accV[1], 1);
#pragma unroll
            for (int ks = 0; ks < 4; ++ks)
#pragma unroll
                for (int mt = 0; mt < 2; ++mt) accO[mt] = MFMA32(*(const LAS bfx8*)(slot + (32 + mt * 4 + ks) * 1024), vb[ks], accO[mt]);
#pragma unroll
            for (int t = 0; t < 4; ++t) {
                S[t] = S[t] * dec;
#pragma unroll
                for (int ks = 0; ks < 4; ++ks) S[t] = MFMA32(*(const LAS bfx8*)(slot + (40 + t * 4 + ks) * 1024), vb[ks], S[t]);
            }
#pragma unroll
            for (int mt = 0; mt < 2; ++mt)
#pragma unroll
                for (int r = 0; r < 16; ++r) *(LAS bf16*)(ob + (32 * mt + crow(r, hh)) * OBUF_STRIDE + (32 * s + l31) * 2) = f2bf(accO[mt][r]);
        }
        lds_barrier();
        float* so = out + O_DN_P + (size_t)(b * 4 + h) * 16384;
#pragma unroll
        for (int t = 0; t < 4; ++t)
#pragma unroll
            for (int r = 0; r < 16; ++r) so[(unsigned)((32 * t + crow(r, hh)) * 128 + 32 * s + l31)] = S[t][r];
    } else {
        const int hw = wave - 4, part = lane >> 4, tok = 16 * hw + (lane & 15);
        float nw[32];
#pragma unroll
        for (int e = 0; e < 32; ++e) nw[e] = dn_norm_w[part * 32 + e];
        { const unsigned char* src = DN_ITEM_PTR(0);
#pragma unroll
          for (int i = 0; i < 14; ++i) { const int f = hw + 4 * i;
              __builtin_amdgcn_global_load_lds((const unsigned*)(src + (size_t)f * 1024 + lane * 16), (LAS unsigned*)(F.lds + f * 1024), 16, 0, 0); } }
        VM_WAIT();
        v4u gz[4], gn[4];
#pragma unroll
        for (int q = 0; q < 4; ++q) gz[q] = gn[q] = (v4u){0u, 0u, 0u, 0u};
        for (int c = 0; c <= NC; ++c) {
            lds_barrier();
#pragma unroll
            for (int q = 0; q < 4; ++q) { gz[q] = gn[q]; asm volatile("" : "+v"(gz[q])); }
            if (c + 1 < NC) {
                const unsigned char* src = DN_ITEM_PTR(c + 1); LAS unsigned char* dst = F.lds + ((c + 1) & 1) * SLOT_BYTES;
#pragma unroll
                for (int i = 0; i < 14; ++i) { const int f = hw + 4 * i;
                    __builtin_amdgcn_global_load_lds((const unsigned*)(src + (size_t)f * 1024 + lane * 16), (LAS unsigned*)(dst + f * 1024), 16, 0, 0); }
            }
            if (c < NC) {
                const bf16* gpn = proj + ((size_t)b * SEQ + (size_t)c * 64 + tok) * NPROJ + 3072 + h * 128 + part * 32;
#pragma unroll
                for (int q = 0; q < 4; ++q) gn[q] = *(const v4u*)(gpn + 8 * q);
            }
            if (c >= 1) {
                const int cc = c - 1;
                const LAS unsigned char* ob = F.lds + OBUF_OFF + (cc & 1) * OBUF_BYTES + tok * OBUF_STRIDE + part * 64;
                float o[32];
#pragma unroll
                for (int q = 0; q < 4; ++q) bf8_to_f32(*(const LAS v4u*)(ob + q * 16), o + 8 * q);
                float vs = 0.f;
#pragma unroll
                for (int e = 0; e < 32; ++e) vs += o[e] * o[e];
                vs += __shfl_xor(vs, 16); vs += __shfl_xor(vs, 32);
                const float rstd = rsqrtf(vs * (1.f / 128.f) + EPS);
                bf16* gp = proj + ((size_t)b * SEQ + (size_t)cc * 64 + tok) * NPROJ + h * 128 + part * 32;
#pragma unroll
                for (int q = 0; q < 4; ++q) {
                    float g[8]; bf8_to_f32(gz[q], g);
                    float y[8];
#pragma unroll
                    for (int e = 0; e < 8; ++e) y[e] = o[8 * q + e] * rstd * nw[8 * q + e] * silu_f(g[e]);
                    v4u w; w.x = pk2(y[0], y[1]); w.y = pk2(y[2], y[3]); w.z = pk2(y[4], y[5]); w.w = pk2(y[6], y[7]);
                    *(v4u*)(gp + 8 * q) = w;
                }
            }
            VM_WAIT();
        }
    }
#undef DN_ITEM_PTR
}

__device__ __forceinline__ void dn_sample_item(const Frame& F, bool active, int b, int h, const unsigned char* frag, float dec, bf16* proj, const float* dn_norm_w, const float* st_dn, float* out) {
    int lane = F.lane; asm volatile("" : "+v"(lane));
    const int wave = F.wave, s = wave & 3, team = wave >> 2, hh = lane >> 5, l31 = lane & 31;
    LAS float* xch = (LAS float*)(F.lds) + team * 64;
    f32x16 S[4]; f32x16 accO;
    if (active) {
        const float* sp = st_dn + (size_t)(b * 4 + h) * 16384;
#pragma unroll
        for (int t = 0; t < 4; ++t)
#pragma unroll
            for (int r = 0; r < 16; ++r) S[t][r] = sp[(unsigned)((32 * t + crow(r, hh)) * 128 + 32 * s + l31)];
        const unsigned char* fb = frag + lane * 16;
        f32x16 accV;
        { const v4u u0 = *(const v4u*)(fb + (21 + s * 2) * 1024), u1 = *(const v4u*)(fb + (22 + s * 2) * 1024); float t8[8];
          bf8_to_f32(u0, t8);
#pragma unroll
          for (int e = 0; e < 8; ++e) accV[e] = t8[e];
          bf8_to_f32(u1, t8);
#pragma unroll
          for (int e = 0; e < 8; ++e) accV[8 + e] = t8[e]; }
#pragma unroll
        for (int r = 0; r < 16; ++r) accO[r] = 0.f;
#pragma unroll
        for (int ks = 0; ks < 8; ++ks) {
            const bfx8 sb = (ks & 1) ? PACK_STEP(S[ks >> 1], 1) : PACK_STEP(S[ks >> 1], 0);
            accV = MFMA32(*(const bfx8*)(fb + ks * 1024), sb, accV);
            accO = MFMA32(*(const bfx8*)(fb + (8 + ks) * 1024), sb, accO);
        }
        const bfx8 vb = PACK_STEP(accV, 0);
        accO = MFMA32(*(const bfx8*)(fb + 16 * 1024), vb, accO);
#pragma unroll
        for (int t = 0; t < 4; ++t) { S[t] = S[t] * dec; S[t] = MFMA32(*(const bfx8*)(fb + (17 + t) * 1024), vb, S[t]); }
#pragma unroll
        for (int r = 0; r < 4; ++r) {
            float sq = accO[r] * accO[r];
#pragma unroll
            for (int o = 1; o < 32; o <<= 1) sq += __shfl_xor(sq, o);
            if (l31 == 0) xch[(4 * hh + r) * 4 + s] = sq;
        }
    }
    __syncthreads();
    if (active) {
#pragma unroll
        for (int r = 0; r < 4; ++r) {
            const int tok = 4 * hh + r;
            const float sq = (xch[tok * 4] + xch[tok * 4 + 1]) + (xch[tok * 4 + 2] + xch[tok * 4 + 3]);
            bf16* gp = proj + ((size_t)TP + (size_t)b * DSEQ + tok) * NPROJ + 3072 + h * 128 + 32 * s + l31;
            const float z = bf2f(*gp);
            *(gp - 3072) = f2bf(accO[r] * rsqrtf(sq * (1.f / 128.f) + EPS) * dn_norm_w[32 * s + l31] * silu_f(z));
        }
        float* so = out + O_DN_S + (size_t)(b * 4 + h) * 16384;
#pragma unroll
        for (int t = 0; t < 4; ++t)
#pragma unroll
            for (int r = 0; r < 16; ++r) so[(unsigned)((32 * t + crow(r, hh)) * 128 + 32 * s + l31)] = S[t][r];
    }
    __syncthreads();
}
constexpr int N_PHASES = 10;
#ifndef DN_CHUNKED
#define DN_CHUNKED 0
#endif
__global__ void __launch_bounds__(NWAVES * 64, 2) mk_fwd(Args args) {
    extern __shared__ __attribute__((aligned(16))) unsigned char lds[];
    Frame F;
    F.lds = (LAS unsigned char*)lds;
    F.MISC = (volatile LAS unsigned*)(F.lds + MISC_OFF);
    F.tid = threadIdx.x; F.lane = F.tid & 63; F.wave = __builtin_amdgcn_readfirstlane(F.tid >> 6);
    F.G = gridDim.x;
    { const int bx = blockIdx.x; const int vcu = (F.G % 8 == 0) ? (bx % 8) * (F.G / 8) + bx / 8 : bx; F.gw = vcu * NWAVES + F.wave; F.NGW = F.G * NWAVES; }
    F.ctl = (gu32*)(args.dws + WS_CTL);
    for (int u = F.tid; u < (LDS_BYTES - LDSCTL_OFF) / 4; u += NWAVES * 64) ((LAS unsigned*)(F.lds + LDSCTL_OFF))[u] = 0u;
    __syncthreads();
    XcdBarrier bar = xcd_barrier_post((unsigned*)(F.ctl + CW_BAR) + args.li * XCD_BAR_WORDS, F.MISC + 8);
    const int lo = args.ph_lo, hi = args.ph_hi;
#define IN(k) (lo <= (k) && (k) < hi)
#define SEAM(k) do { if (IN(k) && IN((k) + 1)) xcd_barrier(bar); } while (0)
#define out (args.dout)
#define hf (args.dout + O_Y)
#define ws (args.dws)
#define nbuf ((bf16*)(args.dws + WS_NBUF))
#define big ((bf16*)(args.dws + WS_BIG))
#define act ((bf16*)(args.dws + WS_ACT))
#define Wt_in ((bf16*)(args.dws + WS_WIN))
#define Wt_out ((bf16*)(args.dws + WS_WOUT))
#define Wt_up ((bf16*)(args.dws + WS_WUP))
#define Wt_down ((bf16*)(args.dws + WS_WDOWN))
#define Wt_gate ((bf16*)(args.dws + WS_WGATE))
#define Wt_ple ((bf16*)(args.dws + WS_WPLE))
#define gb ((float*)(args.dws + WS_GB))
#define trig ((float2*)(args.dws + WS_TRIG))
#define pe ((bf16*)(args.dws + WS_PE))
#define pb ((bf16*)(args.dws + WS_PB))
#define fr_ret_p ((unsigned char*)(args.dout + O_Y))
#define fr_ret_s (fr_ret_p + (size_t)1024 * RET_FRAG_P)
    constexpr int DN_SPLIT = 480;
#define fr_dn_lo (args.dws + WS_NBUF)
#define fr_dn_hi (args.dws + WS_FRHI)
#define fr_dn_s (fr_dn_hi + (size_t)(1024 - DN_SPLIT) * DN_FRAG_P)
#define glast_p ((float*)(args.dws + WS_GLAST))
#define glast_s (glast_p + 1024)
#define ssqa ((float*)(args.dws + WS_SSQA))
#define ssqb ((float*)(args.dws + WS_SSQB))
#define RTBL ((LAS float*)(F.lds + RING_BYTES))
#define usb ((bf16*)(args.dws + WS_US))
#define ubb ((float*)(args.dws + WS_UB))
    using pg8::Gemm; using pg8::StaticOrder; using pg8::EpiStore; using pg8::EpiResid; using pg8::EpiPle; using pg8::EpiResidN; using pg8::EpiScaleStore; using pg8::EpiPleN; using pg8::EpiFfnAct;
    const int bx = blockIdx.x;

    if (IN(0)) {
        trig_phase(F, trig);
        LAS float* scr = (LAS float*)(F.lds + RING_OFF + F.wave * 16384);
        constexpr int I_IN = 16 * 128, I_OUT = 16 * 32, I_UP = 16 * 176, I_DOWN = 44 * 32, I_GATE = 16 * 32, I_PLEI = 4 * 32;
        constexpr int NITEMS = I_IN + I_OUT + I_UP + I_DOWN + I_GATE + I_PLEI;
        for (int rp_ = 0; rp_ < ((args.pad & 1) ? 2 : 1); ++rp_)
        for (int it = F.gw; it < NITEMS; it += F.NGW) {
            int r = it;
            if (r < I_IN) { const int kb = r / 128, nb = r % 128; transpose_item(args.in[I_WIN], 4104, proj_orig_col(32 * nb), D, Wt_in, 32 * nb, 64 * kb, scr, F.lane, nullptr); continue; } r -= I_IN;
            if (r < I_OUT) { const int kb = r / 32, nb = r % 32; transpose_item(args.in[I_WOUT], D, 32 * nb, D, Wt_out, 32 * nb, 64 * kb, scr, F.lane, nullptr); continue; } r -= I_OUT;
            if (r < I_UP) { const int kb = r / 176, nb = r % 176; transpose_item(args.in[I_WUP], NUP, up_orig_col(32 * nb), D, Wt_up, 32 * nb, 64 * kb, scr, F.lane, args.in[I_FFN_NW]); continue; } r -= I_UP;
            if (r < I_DOWN) { const int kb = r / 32, nb = r % 32; transpose_item(args.in[I_WDOWN], D, 32 * nb, DFF, Wt_down, 32 * nb, 64 * kb, scr, F.lane, nullptr); continue; } r -= I_DOWN;
            if (r < I_GATE) { const int kb = r / 32, nb = r % 32; transpose_item(args.in[I_WGATE], D, 32 * nb, D, Wt_gate, 32 * nb, 64 * kb, scr, F.lane, args.in[I_PLE_NW]); continue; } r -= I_GATE;
            { const int kb = r / 32, nb = r % 32; transpose_item(args.in[I_WPLE], D, 32 * nb, PLE, Wt_ple, 32 * nb, 64 * kb, scr, F.lane, nullptr); }
        }
        __syncthreads();
        for (int rp_ = 0; rp_ < ((args.pad & 2) ? 2 : 1); ++rp_)
        rows_norm_phase<0>(F, args.in[I_XP], args.in[I_XS], args.in[I_ATTN_NW], nbuf, args.in[I_WIN], args.in[I_ALOG], args.in[I_DTB], gb, (LAS float*)(F.lds + RING_OFF));
    }
    SEAM(0);
    if (IN(1)) {
        Gemm g{nbuf, Wt_in, T, NPROJ, D, D, D}; StaticOrder S; S.init(T, NPROJ, F.G, bx);
        EpiStore E{big, NPROJ};
        pg8::gemm_phase<EpiStore, StaticOrder, true, true>(F.lds + RING_OFF, g, S, E);
    }
    SEAM(1);
    if (IN(2)) {
        for (int rp_ = 0; rp_ < ((args.pad & 4) ? 2 : 1); ++rp_)
        for (int it = bx; it < 1024; it += F.G) { const int bh = it >> 5, c = it & 31;
            dn_prep_item<64>(F, true, bh >> 2, bh & 3, c, big, gb, args.in[I_DN_CONVW], args.in[I_ST_CONV],
                             it < DN_SPLIT ? fr_dn_lo + (size_t)it * DN_FRAG_P : fr_dn_hi + (size_t)(it - DN_SPLIT) * DN_FRAG_P, glast_p + it, out); }
        for (int rp_ = 0; rp_ < ((args.pad & 8) ? 2 : 1); ++rp_)
        for (int it = bx; it < 1024; it += F.G) { const int bh = it >> 5, c = it & 31; ret_prep_item<64>(F, true, bh >> 2, bh & 3, c, big, trig, fr_ret_p + (size_t)it * RET_FRAG_P); }
        for (int rp_ = 0; rp_ < ((args.pad & 16) ? 2 : 1); ++rp_)
        for (int it = bx; it < 512; it += F.G) dn_prep_item<8>(F, false, it >> 2, it & 3, 0, big, gb, args.in[I_DN_CONVW], args.in[I_ST_CONV], fr_dn_s + (size_t)it * DN_FRAG_S, glast_s + it, out);
        for (int rp_ = 0; rp_ < ((args.pad & 32) ? 2 : 1); ++rp_)
        for (int it = bx; it < 512; it += F.G) ret_prep_item<8>(F, false, it >> 2, it & 3, 0, big, trig, fr_ret_s + (size_t)it * RET_FRAG_S);
    }
    SEAM(2);
    if (IN(3)) {
        if (bx < 32) dn_stream(F, bx >> 2, bx & 3, fr_dn_lo, fr_dn_hi, DN_SPLIT, glast_p, big, args.in[I_DN_NW], out);
        else if (bx < 64) ret_stream(F, (bx - 32) >> 2, bx & 3, fr_ret_p + (size_t)(bx - 32) * 32 * RET_FRAG_P, big, args.in[I_RET_NW], out);
        else {
            const int tm = (bx - 64) * 2 + (F.wave >> 2);
#pragma unroll 1
            for (int k = 0; k < 3; ++k) {
                const int idx = tm + 384 * k;
                if (idx < 512) dn_sample_item(F, true, idx >> 2, idx & 3, fr_dn_s + (size_t)idx * DN_FRAG_S, glast_s[idx], big, args.in[I_DN_NW], args.in[I_ST_DN], out);
                else { const int it = idx - 512; const bool active = it < 512;
                    ret_sample_item(F, active, it >> 2, it & 3, fr_ret_s + (size_t)(active ? it : 0) * RET_FRAG_S, big, args.in[I_RET_NW], args.in[I_ST_RET], out); }
            }
        }
    }
    SEAM(3);
    if (IN(4)) {
        Gemm g{big, Wt_out, T, D, D, NPROJ, D}; StaticOrder S; S.init(T, D, F.G, bx);
        EpiResidN E{hf, args.in[I_XP], args.in[I_XS], nbuf, ssqa};
        pg8::gemm_phase<EpiResidN, StaticOrder, true, true>(F.lds + RING_OFF, g, S, E);
        const float* pp = args.in[I_PP]; const float* ps = args.in[I_PS];
        const size_t n4 = (size_t)T * PLE / 4, np4 = (size_t)TP * PLE / 4;
        for (size_t i = (size_t)bx * 512 + F.tid; i < n4; i += (size_t)F.G * 512) {
            const f32x4 v = i < np4 ? ((const f32x4*)pp)[i] : ((const f32x4*)ps)[i - np4];
            uint2 o; o.x = pk2(v[0], v[1]); o.y = pk2(v[2], v[3]); ((uint2*)pb)[i] = o;
        }
    }
    SEAM(4);
    if (IN(5)) {
        Gemm g{nbuf, Wt_up, T, NUP, D, D, D}; StaticOrder S; S.init(T, NUP, F.G, bx);
        build_rstd_tables(F, S, ssqa, 0, RTBL);
        EpiFfnAct E{act, usb, ubb, args.in[I_FFN_CW], args.in[I_FFN_CB], RTBL};
        pg8::gemm_phase<EpiFfnAct, StaticOrder, true, true>(F.lds + RING_OFF, g, S, E);
    }
    SEAM(5);
    if (IN(6)) {
        ffn_fixup_phase(F, ubb, args.in[I_FFN_CW], args.in[I_FFN_CB], act, out);
        act_phase(F, usb, TP, TS, args.in[I_FFN_CW], args.in[I_FFN_CB], args.in[I_ST_FFN], act, out);
        Gemm g{pb, Wt_ple, T, D, PLE, PLE, PLE}; StaticOrder S; S.init(T, D, F.G, bx);
        EpiStore E{pe, D};
        pg8::gemm_phase<EpiStore, StaticOrder, true, true>(F.lds + RING_OFF, g, S, E);
    }
    SEAM(6);
    if (IN(7)) {
        Gemm g{act, Wt_down, T, D, DFF, DFF, DFF}; StaticOrder S; S.init(T, D, F.G, bx);
        EpiResidN E{hf, nullptr, nullptr, nbuf, ssqb};
        pg8::gemm_phase<EpiResidN, StaticOrder, true, true>(F.lds + RING_OFF, g, S, E);
    }
    SEAM(7);
    if (IN(8)) {
        Gemm g{nbuf, Wt_gate, T, D, D, D, D}; StaticOrder S; S.init(T, D, F.G, bx);
        build_rstd_tables(F, S, ssqb, 0, RTBL);
        EpiPleN E{hf, pe, RTBL, ssqa};
        pg8::gemm_phase<EpiPleN, StaticOrder, true, true>(F.lds + RING_OFF, g, S, E);
    }
    SEAM(8);
    if (IN(9)) final_norm_phase2(F, hf, ssqa, args.in[I_FINAL_NW]);
#undef IN
#undef SEAM
#undef out
#undef hf
#undef ws
#undef nbuf
#undef big
#undef act
#undef Wt_in
#undef Wt_out
#undef Wt_up
#undef Wt_down
#undef Wt_gate
#undef Wt_ple
#undef gb
#undef trig
#undef pe
#undef pb
#undef fr_ret_p
#undef fr_ret_s
#undef fr_dn_lo
#undef fr_dn_hi
#undef fr_dn_s
#undef glast_p
#undef glast_s
#undef ssqa
#undef ssqb
#undef RTBL
#undef usb
#undef ubb
}

extern "C" void kernel_launch(void* const* d_in, const int* in_sizes, int n_in, void* d_out, int out_size, void* d_ws, size_t ws_size, hipStream_t stream) {
    static int grid = 0;
    if (grid == 0) {
        int dev = 0, cus = 0;
        if (n_in != 25 || ws_size < WS_END) { fprintf(stderr, "kernel_launch: unexpected n_in %d / ws_size %zu\n", n_in, ws_size); grid = -1; return; }
        if (hipGetDevice(&dev) != hipSuccess || hipDeviceGetAttribute(&cus, hipDeviceAttributeMultiprocessorCount, dev) != hipSuccess) { grid = -1; return; }
        if (hipFuncSetAttribute((const void*)mk_fwd, hipFuncAttributeMaxDynamicSharedMemorySize, LDS_BYTES) != hipSuccess) { fprintf(stderr, "kernel_launch: hipFuncSetAttribute failed\n"); grid = -1; return; }
        (void)hipGetLastError();
        grid = cus;
    }
    if (grid < 0) return;
    (void)hipMemsetAsync((char*)d_ws + WS_CTL, 0, CTL_ZERO_BYTES, stream);
    Args a{};
    for (int i = 0; i < 25; ++i) a.in[i] = (const float*)d_in[i];
    a.dout = (float*)d_out; a.dws = (unsigned char*)d_ws;
#ifndef PROBE_PAD
#define PROBE_PAD 0
#endif
    a.pad = PROBE_PAD;
    a.ph_lo = 0; a.ph_hi = N_PHASES; a.li = 0;
    hipLaunchKernelGGL(mk_fwd, dim3(grid), dim3(NWAVES * 64), LDS_BYTES, stream, a);
}
```

```cpp
#include <hip/hip_runtime.h>
#include <cstdio>
#include <cstdint>

typedef unsigned short bf16;
constexpr int TP = 16384, TS = 1024, T = TP + TS;
constexpr int D = 1024, NPROJ = 4096, DFF = 2816, NUP = 5632, PLE = 256;
constexpr int SEQ = 2048, DSEQ = 8, NB = 8, NSB = 128;
constexpr float EPS = 1e-6f;

constexpr size_t O_Y = 0, O_DNCONV_P = 17825792, O_DN_P = 17862656, O_RET_P = 18386944, O_FFN_P = 18911232,
                 O_DNCONV_S = 19001344, O_DN_S = 19591168, O_RET_S = 27979776, O_FFN_S = 36368384;

__device__ __forceinline__ float bf2f(bf16 v) { return __uint_as_float(((unsigned)v) << 16); }
__device__ __forceinline__ bf16 f2bf(float f) { unsigned u = __float_as_uint(f); return (bf16)((u + 0x7fffu + ((u >> 16) & 1u)) >> 16); }
__device__ __forceinline__ float sigmoid_f(float x) { return __builtin_amdgcn_rcpf(1.f + __builtin_amdgcn_exp2f(-1.4426950408889634f * x)); }
__device__ __forceinline__ float silu_f(float x) { return x * sigmoid_f(x); }
__device__ __forceinline__ float wave_sum(float v) {
#pragma unroll
    for (int o = 1; o < 64; o <<= 1) v += __shfl_xor(v, o);
    return v;
}
__host__ __device__ __forceinline__ int proj_orig_col(int n) {
    if (n < 1536) return n;
    if (n < 3072) return 2056 + (n - 1536);
    if (n < 3584) return 1536 + (n - 3072);
    return 3592 + (n - 3584);
}
__host__ __device__ __forceinline__ int up_orig_col(int n) { const int t = n >> 8, half = (n >> 7) & 1, j = n & 127; return half * DFF + 128 * t + j; }

namespace pg8 {
#define PG8_LAS __attribute__((address_space(3)))
typedef unsigned short bf16_t;
typedef short bf16x8 __attribute__((ext_vector_type(8)));
typedef float f32x4 __attribute__((ext_vector_type(4)));
typedef unsigned u32x4 __attribute__((ext_vector_type(4)));
constexpr int BM = 256, BK = 64, HALF = 128, HTB = HALF * BK * 2  , STAGE_BYTES = 8 * HTB, NXCD = 8, WGM = 8;

__host__ __device__ __forceinline__ int lds_byte(int r, int c) { const int st = (r >> 4) * 2 + (c >> 5), rr = r & 15, cc = c & 31, ob = rr * 64 + cc * 2; return st * 1024 + (ob ^ (((ob >> 9) & 1) << 5)); }
__host__ __device__ __forceinline__ void stage_rc(int b, int& R, int& C) { const int st = b / 1024, sb = b % 1024, swz = sb ^ (((sb >> 9) & 1) << 5); R = (st >> 1) * 16 + swz / 64; C = (st & 1) * 32 + (swz % 64) / 2; }
__host__ __device__ __forceinline__ int perm32(int rho) { const int n = rho >> 4, i = rho & 15; return 8 * (i >> 2) + 4 * n + (i & 3); }

struct Unit { int pm, pn; };
struct Gemm { const bf16_t* A; const bf16_t* Bt; int M, N, K, lda, ldb; };

struct StaticOrder {
    int nM, nN, nwg, G, c;
    __host__ __device__ void init(int M, int N, int G_, int c_) { nM = M / BM; nN = N / BM; nwg = nM * nN; G = G_; c = c_; }
    __host__ __device__ bool next(int i, Unit& u) const {
        const long L = (long)i * G + c; if (L >= nwg) return false;
        int wgid = (int)L; { const int q = nwg / NXCD, r = nwg % NXCD, xcd = wgid % NXCD, off = wgid / NXCD; wgid = (xcd < r ? xcd * (q + 1) : r * (q + 1) + (xcd - r) * q) + off; }
        const int nig = WGM * nN, gid = wgid / nig, fm = gid * WGM, gsz = (nM - fm) < WGM ? (nM - fm) : WGM;
        u.pm = fm + ((wgid % nig) % gsz); u.pn = (wgid % nig) / gsz; return true;
    }
    __device__ __forceinline__ void a_ready(const Unit&) const {}
    __device__ __forceinline__ void done(const Unit&) const {}
};

__device__ __forceinline__ unsigned cvt_pk_bf16(float lo, float hi) { unsigned r; asm volatile("v_cvt_pk_bf16_f32 %0, %1, %2" : "=v"(r) : "v"(lo), "v"(hi)); return r; }

struct EpiStore {
    static constexpr bool PERM = true, AFTER_DRAIN = false;
    bf16_t* O; int ldc;
    __device__ __forceinline__ void operator()(const f32x4 (&acc)[2][2][4][2], const Unit& u, int wr, int wc, int fr, int fq, int ui) const {
        const int row0 = u.pm * BM + wr * 64 + fr, col0 = u.pn * BM + wc * 32 + 8 * fq;
#pragma unroll
        for (int ai = 0; ai < 2; ++ai)
#pragma unroll
            for (int m = 0; m < 4; ++m) { bf16_t* rowp = O + (size_t)(row0 + ai * HALF + m * 16) * ldc + col0;
#pragma unroll
                for (int bj = 0; bj < 2; ++bj) { const f32x4 v0 = acc[ai][bj][m][0], v1 = acc[ai][bj][m][1];
                    u32x4 w; w.x = cvt_pk_bf16(v0[0], v0[1]); w.y = cvt_pk_bf16(v0[2], v0[3]); w.z = cvt_pk_bf16(v1[0], v1[1]); w.w = cvt_pk_bf16(v1[2], v1[3]);
                    *(u32x4*)(rowp + bj * HALF) = w; } }
    }
};
struct EpiResid {
    static constexpr bool PERM = true, AFTER_DRAIN = false;
    float* hf; const float* xp; const float* xs;
    __device__ __forceinline__ void operator()(const f32x4 (&acc)[2][2][4][2], const Unit& u, int wr, int wc, int fr, int fq, int ui) const {
        const int row0 = u.pm * BM + wr * 64 + fr, col0 = u.pn * BM + wc * 32 + 8 * fq;
#pragma unroll
        for (int ai = 0; ai < 2; ++ai)
#pragma unroll
            for (int m = 0; m < 4; ++m) { const int row = row0 + ai * HALF + m * 16;
                const float* bp = xs ? (row < 16384 ? xp + (size_t)row * 1024 : xs + (size_t)(row - 16384) * 1024) : hf + (size_t)row * 1024;
                float* op = hf + (size_t)row * 1024;
#pragma unroll
                for (int bj = 0; bj < 2; ++bj) { const int c = col0 + bj * HALF;
                    const f32x4 b0 = *(const f32x4*)(bp + c), b1 = *(const f32x4*)(bp + c + 4);
                    *(f32x4*)(op + c) = b0 + acc[ai][bj][m][0]; *(f32x4*)(op + c + 4) = b1 + acc[ai][bj][m][1]; } }
    }
};
struct EpiPle {
    static constexpr bool PERM = true, AFTER_DRAIN = false;
    float* hf; const bf16_t* pe;
    __device__ __forceinline__ void operator()(const f32x4 (&acc)[2][2][4][2], const Unit& u, int wr, int wc, int fr, int fq, int ui) const {
        const int row0 = u.pm * BM + wr * 64 + fr, col0 = u.pn * BM + wc * 32 + 8 * fq;
#pragma unroll
        for (int ai = 0; ai < 2; ++ai)
#pragma unroll
            for (int m = 0; m < 4; ++m) { const int row = row0 + ai * HALF + m * 16; float* op = hf + (size_t)row * 1024;
#pragma unroll
                for (int bj = 0; bj < 2; ++bj) { const int c = col0 + bj * HALF;
                    const u32x4 pw = *(const u32x4*)(pe + (size_t)row * 1024 + c);
                    const f32x4 h0 = *(const f32x4*)(op + c), h1 = *(const f32x4*)(op + c + 4);
                    const f32x4 a0 = acc[ai][bj][m][0], a1 = acc[ai][bj][m][1];
                    f32x4 p0, p1;
                    p0[0] = __uint_as_float(pw.x << 16); p0[1] = __uint_as_float(pw.x & 0xffff0000u); p0[2] = __uint_as_float(pw.y << 16); p0[3] = __uint_as_float(pw.y & 0xffff0000u);
                    p1[0] = __uint_as_float(pw.z << 16); p1[1] = __uint_as_float(pw.z & 0xffff0000u); p1[2] = __uint_as_float(pw.w << 16); p1[3] = __uint_as_float(pw.w & 0xffff0000u);
                    f32x4 o0, o1;
#pragma unroll
                    for (int e = 0; e < 4; ++e) { o0[e] = h0[e] + p0[e] * __builtin_amdgcn_rcpf(1.f + __builtin_amdgcn_exp2f(-1.4426950408889634f * a0[e])); o1[e] = h1[e] + p1[e] * __builtin_amdgcn_rcpf(1.f + __builtin_amdgcn_exp2f(-1.4426950408889634f * a1[e])); }
                    *(f32x4*)(op + c) = o0; *(f32x4*)(op + c + 4) = o1; } }
    }
};


struct EpiResidN {
    static constexpr bool PERM = true, AFTER_DRAIN = false;
    float* hf; const float* xp; const float* xs; bf16_t* hb; float* ssq;
    __device__ __forceinline__ void operator()(const f32x4 (&acc)[2][2][4][2], const Unit& u, int wr, int wc, int fr, int fq, int ui) const {
        const int row0 = u.pm * BM + wr * 64 + fr, col0 = u.pn * BM + wc * 32 + 8 * fq;
#pragma unroll
        for (int ai = 0; ai < 2; ++ai)
#pragma unroll
            for (int m = 0; m < 4; ++m) { const int row = row0 + ai * HALF + m * 16;
                const float* bp = xs ? (row < 16384 ? xp + (size_t)row * 1024 : xs + (size_t)(row - 16384) * 1024) : hf + (size_t)row * 1024;
                float* op = hf + (size_t)row * 1024; bf16_t* ob = hb + (size_t)row * 1024; float s = 0.f;
#pragma unroll
                for (int bj = 0; bj < 2; ++bj) { const int c = col0 + bj * HALF;
                    const f32x4 v0 = *(const f32x4*)(bp + c) + acc[ai][bj][m][0], v1 = *(const f32x4*)(bp + c + 4) + acc[ai][bj][m][1];
                    *(f32x4*)(op + c) = v0; *(f32x4*)(op + c + 4) = v1;
                    s += (v0[0] * v0[0] + v0[1] * v0[1]) + (v0[2] * v0[2] + v0[3] * v0[3]) + (v1[0] * v1[0] + v1[1] * v1[1]) + (v1[2] * v1[2] + v1[3] * v1[3]);
                    u32x4 w; w.x = cvt_pk_bf16(v0[0], v0[1]); w.y = cvt_pk_bf16(v0[2], v0[3]); w.z = cvt_pk_bf16(v1[0], v1[1]); w.w = cvt_pk_bf16(v1[2], v1[3]);
                    *(u32x4*)(ob + c) = w; }
                s += __shfl_xor(s, 16); s += __shfl_xor(s, 32);
                if (fq == 0) ssq[(size_t)row * 16 + u.pn * 4 + wc] = s; }
    }
};
struct EpiScaleStore {
    static constexpr bool PERM = true, AFTER_DRAIN = false;
    bf16_t* O; int ldc; const PG8_LAS float* tbl;
    __device__ __forceinline__ void operator()(const f32x4 (&acc)[2][2][4][2], const Unit& u, int wr, int wc, int fr, int fq, int ui) const {
        const int row0 = u.pm * BM + wr * 64 + fr, col0 = u.pn * BM + wc * 32 + 8 * fq;
#pragma unroll
        for (int ai = 0; ai < 2; ++ai)
#pragma unroll
            for (int m = 0; m < 4; ++m) { bf16_t* rowp = O + (size_t)(row0 + ai * HALF + m * 16) * ldc + col0;
                const float rs = tbl[ui * 256 + ai * HALF + wr * 64 + m * 16 + fr];
#pragma unroll
                for (int bj = 0; bj < 2; ++bj) { const f32x4 v0 = acc[ai][bj][m][0] * rs, v1 = acc[ai][bj][m][1] * rs;
                    u32x4 w; w.x = cvt_pk_bf16(v0[0], v0[1]); w.y = cvt_pk_bf16(v0[2], v0[3]); w.z = cvt_pk_bf16(v1[0], v1[1]); w.w = cvt_pk_bf16(v1[2], v1[3]);
                    *(u32x4*)(rowp + bj * HALF) = w; } }
    }
};
struct EpiPleN {
    static constexpr bool PERM = true, AFTER_DRAIN = false;
    float* hf; const bf16_t* pe; const PG8_LAS float* tbl; float* ssq;
    __device__ __forceinline__ void operator()(const f32x4 (&acc)[2][2][4][2], const Unit& u, int wr, int wc, int fr, int fq, int ui) const {
        const int row0 = u.pm * BM + wr * 64 + fr, col0 = u.pn * BM + wc * 32 + 8 * fq;
#pragma unroll
        for (int ai = 0; ai < 2; ++ai)
#pragma unroll
            for (int m = 0; m < 4; ++m) { const int row = row0 + ai * HALF + m * 16; float* op = hf + (size_t)row * 1024; float s = 0.f;
                const float rs = tbl[ui * 256 + ai * HALF + wr * 64 + m * 16 + fr];
#pragma unroll
                for (int bj = 0; bj < 2; ++bj) { const int c = col0 + bj * HALF;
                    const u32x4 pw = *(const u32x4*)(pe + (size_t)row * 1024 + c);
                    const f32x4 h0 = *(const f32x4*)(op + c), h1 = *(const f32x4*)(op + c + 4);
                    const f32x4 a0 = acc[ai][bj][m][0] * rs, a1 = acc[ai][bj][m][1] * rs;
                    f32x4 p0, p1;
                    p0[0] = __uint_as_float(pw.x << 16); p0[1] = __uint_as_float(pw.x & 0xffff0000u); p0[2] = __uint_as_float(pw.y << 16); p0[3] = __uint_as_float(pw.y & 0xffff0000u);
                    p1[0] = __uint_as_float(pw.z << 16); p1[1] = __uint_as_float(pw.z & 0xffff0000u); p1[2] = __uint_as_float(pw.w << 16); p1[3] = __uint_as_float(pw.w & 0xffff0000u);
                    f32x4 o0, o1;
#pragma unroll
                    for (int e = 0; e < 4; ++e) { o0[e] = h0[e] + p0[e] * __builtin_amdgcn_rcpf(1.f + __builtin_amdgcn_exp2f(-1.4426950408889634f * a0[e])); o1[e] = h1[e] + p1[e] * __builtin_amdgcn_rcpf(1.f + __builtin_amdgcn_exp2f(-1.4426950408889634f * a1[e])); }
                    *(f32x4*)(op + c) = o0; *(f32x4*)(op + c + 4) = o1;
                    s += (o0[0] * o0[0] + o0[1] * o0[1]) + (o0[2] * o0[2] + o0[3] * o0[3]) + (o1[0] * o1[0] + o1[1] * o1[1]) + (o1[2] * o1[2] + o1[3] * o1[3]); }
                s += __shfl_xor(s, 16); s += __shfl_xor(s, 32);
                if (fq == 0) ssq[(size_t)row * 16 + u.pn * 4 + wc] = s; }
    }
};


template <int N> __device__ __forceinline__ float dpp_row_prev(float cur, float prevreg) {
    const int w = __builtin_amdgcn_update_dpp(0, __float_as_int(prevreg), 0x100 + (16 - N), 0xf, 0xf, false);
    return __int_as_float(__builtin_amdgcn_update_dpp(w, __float_as_int(cur), 0x110 + N, 0xf, 0xf, false));
}
struct EpiFfnAct {
    static constexpr bool PERM = true, AFTER_DRAIN = false;
    bf16_t* act; bf16_t* us; float* ub; const float* cw; const float* cb; const PG8_LAS float* tbl;
    __device__ __forceinline__ void operator()(const f32x4 (&acc)[2][2][4][2], const Unit& u, int wr, int wc, int fr, int fq, int ui) const {
        if (u.pm >= 64) {
            const int row0 = (u.pm - 64) * BM + wr * 64 + fr, col0 = u.pn * BM + wc * 32 + 8 * fq;
#pragma unroll
            for (int ai = 0; ai < 2; ++ai)
#pragma unroll
                for (int m = 0; m < 4; ++m) { bf16_t* rowp = us + (size_t)(row0 + ai * HALF + m * 16) * 5632 + col0;
                    const float rs = tbl[ui * 256 + ai * HALF + wr * 64 + m * 16 + fr];
#pragma unroll
                    for (int bj = 0; bj < 2; ++bj) { const f32x4 v0 = acc[ai][bj][m][0] * rs, v1 = acc[ai][bj][m][1] * rs;
                        u32x4 w; w.x = cvt_pk_bf16(v0[0], v0[1]); w.y = cvt_pk_bf16(v0[2], v0[3]); w.z = cvt_pk_bf16(v1[0], v1[1]); w.w = cvt_pk_bf16(v1[2], v1[3]);
                        *(u32x4*)(rowp + bj * HALF) = w; } }
            return;
        }
        const int ch0 = 128 * u.pn + 32 * wc + 8 * fq, colg = 256 * u.pn + 32 * wc + 8 * fq;
        typedef float f32x2 __attribute__((ext_vector_type(2)));
#pragma unroll
        for (int np = 0; np < 4; ++np) {
            const int n = np >> 1, e0 = 2 * (np & 1), ch = ch0 + 4 * n + e0;
            const f32x2 wg0 = *(const f32x2*)(cw + ch), wg1 = *(const f32x2*)(cw + 5632 + ch), wg2 = *(const f32x2*)(cw + 2 * 5632 + ch), bg = *(const f32x2*)(cb + ch);
            const f32x2 wv0 = *(const f32x2*)(cw + 2816 + ch), wv1 = *(const f32x2*)(cw + 5632 + 2816 + ch), wv2 = *(const f32x2*)(cw + 2 * 5632 + 2816 + ch), bv = *(const f32x2*)(cb + 2816 + ch);
#pragma unroll
            for (int ai = 0; ai < 2; ++ai) {
                const int G = 4 * u.pm + 2 * ai + wr;
                f32x2 pg = {0.f, 0.f}, pv = pg;
#pragma unroll
                for (int m = 0; m < 4; ++m) {
                    const float rs = tbl[ui * 256 + ai * HALF + wr * 64 + m * 16 + fr];
                    f32x2 xg, xv, a;
                    xg[0] = acc[ai][0][m][n][e0] * rs; xg[1] = acc[ai][0][m][n][e0 + 1] * rs; xv[0] = acc[ai][1][m][n][e0] * rs; xv[1] = acc[ai][1][m][n][e0 + 1] * rs;
#pragma unroll
                    for (int e = 0; e < 2; ++e) {
                        const float g1 = dpp_row_prev<1>(xg[e], pg[e]), g2 = dpp_row_prev<2>(xg[e], pg[e]);
                        const float v1 = dpp_row_prev<1>(xv[e], pv[e]), v2 = dpp_row_prev<2>(xv[e], pv[e]);
                        const float yg = wg0[e] * g2 + wg1[e] * g1 + wg2[e] * xg[e] + bg[e];
                        const float yv = wv0[e] * v2 + wv1[e] * v1 + wv2[e] * xv[e] + bv[e];
                        a[e] = yg * __builtin_amdgcn_rcpf(1.f + __builtin_amdgcn_exp2f(-1.4426950408889634f * yg)) * yv;
                    }
                    const int q = 16 * m + fr;
                    if (q >= 2) *(unsigned*)(act + (size_t)(64 * G + q) * 2816 + ch) = cvt_pk_bf16(a[0], a[1]);
                    if ((m == 0 && fr < 2) || (m == 3 && fr >= 14)) { const int slot = m == 0 ? fr : fr - 12;
                        float* bp = ub + ((size_t)G * 4 + slot) * 5632 + colg + 4 * n + e0; *(f32x2*)bp = xg; *(f32x2*)(bp + 128) = xv; }
                    pg = xg; pv = xv;
                }
            }
            asm volatile("" ::: "memory");
        }
    }
};


template <class Epi, class Sched, bool ALIGN_EPI = false, bool SP2 = false>
__device__ __forceinline__ void gemm_phase(PG8_LAS unsigned char* lds, const Gemm g, const Sched& S, const Epi& E) {
    const int tid = threadIdx.x, wid = __builtin_amdgcn_readfirstlane(tid >> 6), lane = tid & 63, wr = wid >> 2, wc = wid & 3, fr = lane & 15, fq = lane >> 4;
    const int K = g.K, nt = K / BK;
    unsigned voffA[2], voffB[2];
#pragma unroll
    for (int i = 0; i < 2; ++i) { int R, C; stage_rc(tid * 16 + i * 8192, R, C); const int Rb = Epi::PERM ? ((R & ~31) + perm32(R & 31)) : R;
        voffA[i] = (unsigned)(R * g.lda + C) * 2u; voffB[i] = (unsigned)(Rb * g.ldb + C) * 2u; }
    const size_t kstep = (size_t)(BK * 2);
    const size_t hstepA = (size_t)HALF * g.lda * 2, hstepB = (size_t)HALF * g.ldb * 2;
    const size_t tstepA = 2 * hstepA, tstepB = 2 * hstepB;
    const unsigned ldsw = (unsigned)wid * 1024u;
    const int aoff = lds_byte(wr * 64 + fr, fq * 8), boff = lds_byte(wc * 32 + fr, fq * 8);
#define PG8_SA(b, h) (((b) * 2 + (h)) * HTB)
#define PG8_SB(b, h) ((4 + (b) * 2 + (h)) * HTB)
#define PG8_STAGE(bufoff, gbase, voff) do { _Pragma("unroll") for (int _i = 0; _i < 2; ++_i) \
        __builtin_amdgcn_global_load_lds((const unsigned*)((const char*)(gbase) + (voff)[_i]), (PG8_LAS unsigned*)(lds + (bufoff) + ldsw + _i * 8192), 16, 0, 0); } while (0)
#define PG8_LDA(dst, b, h) do { _Pragma("unroll") for (int m = 0; m < 4; ++m) _Pragma("unroll") for (int k = 0; k < 2; ++k) dst[m][k] = *(const PG8_LAS bf16x8*)(lds + PG8_SA(b, h) + aoff + m * 2048 + k * 1024); } while (0)
#define PG8_LDB(dst, b, h) do { _Pragma("unroll") for (int n = 0; n < 2; ++n) _Pragma("unroll") for (int k = 0; k < 2; ++k) dst[n][k] = *(const PG8_LAS bf16x8*)(lds + PG8_SB(b, h) + boff + n * 2048 + k * 1024); } while (0)
#define PG8_MMA(ai, bj, At, Bt) do { __builtin_amdgcn_s_setprio(1); _Pragma("unroll") for (int m = 0; m < 4; ++m) _Pragma("unroll") for (int n = 0; n < 2; ++n) _Pragma("unroll") for (int k = 0; k < 2; ++k) \
        acc[ai][bj][m][n] = __builtin_amdgcn_mfma_f32_16x16x32_bf16(Bt[n][k], At[m][k], acc[ai][bj][m][n], 0, 0, 0); __builtin_amdgcn_s_setprio(0); } while (0)
#define PG8_WAIT_V(n) asm volatile("s_waitcnt vmcnt(" #n ")" ::: "memory")
#define PG8_WAIT_L(n) asm volatile("s_waitcnt lgkmcnt(" #n ")" ::: "memory")
#define PG8_BAR __builtin_amdgcn_s_barrier()
#define PG8_SCHED __builtin_amdgcn_sched_barrier(0)
    Unit cur, nxt; int ui = 0;
    if (!S.next(0, cur)) return;
    f32x4 acc[2][2][4][2];
#pragma unroll
    for (int a = 0; a < 2; ++a)
#pragma unroll
        for (int b = 0; b < 2; ++b)
#pragma unroll
            for (int m = 0; m < 4; ++m)
#pragma unroll
                for (int n = 0; n < 2; ++n) acc[a][b][m][n] = (f32x4){0.f, 0.f, 0.f, 0.f};
    bf16x8 At[4][2], B0[2][2], B1[2][2];
    const char* cA = (const char*)g.A + (size_t)cur.pm * tstepA; const char* cB = (const char*)g.Bt + (size_t)cur.pn * tstepB;
    S.a_ready(cur);
    if constexpr (SP2) {
        PG8_STAGE(PG8_SB(0, 0), cB, voffB); PG8_STAGE(PG8_SB(0, 1), cB + hstepB, voffB); PG8_STAGE(PG8_SA(0, 0), cA, voffA); PG8_STAGE(PG8_SA(0, 1), cA + hstepA, voffA);
        if (wr == 1) PG8_BAR;
        PG8_WAIT_V(2); PG8_BAR;
        PG8_STAGE(PG8_SB(1, 0), cB + kstep, voffB); PG8_STAGE(PG8_SA(1, 0), cA + kstep, voffA); PG8_STAGE(PG8_SB(1, 1), cB + hstepB + kstep, voffB);
        PG8_WAIT_V(6); PG8_BAR;
    } else {
        PG8_STAGE(PG8_SB(0, 0), cB, voffB); PG8_STAGE(PG8_SA(0, 0), cA, voffA); PG8_STAGE(PG8_SB(0, 1), cB + hstepB, voffB); PG8_STAGE(PG8_SA(0, 1), cA + hstepA, voffA);
        if (wr == 1) PG8_BAR;
        PG8_WAIT_V(4); PG8_BAR;
        PG8_STAGE(PG8_SB(1, 0), cB + kstep, voffB); PG8_STAGE(PG8_SA(1, 0), cA + kstep, voffA); PG8_STAGE(PG8_SB(1, 1), cB + hstepB + kstep, voffB);
        PG8_WAIT_V(6); PG8_BAR;
    }
    for (;;) {
        const bool has_next = S.next(ui + 1, nxt);
        const char* nA = has_next ? (const char*)g.A + (size_t)nxt.pm * tstepA : cA; const char* nB = has_next ? (const char*)g.Bt + (size_t)nxt.pn * tstepB : cB;
        for (int t = 0; t < nt; t += 2) {
            const bool last = (t == nt - 2);
            const char* a1 = cA + (size_t)(t + 1) * kstep;
            const char* a2 = last ? nA : cA + (size_t)(t + 2) * kstep; const char* b2 = last ? nB : cB + (size_t)(t + 2) * kstep;
            const char* a3 = a2 + kstep; const char* b3 = b2 + kstep;
            if (last && has_next) S.a_ready(nxt);
            if constexpr (SP2) {
            PG8_LDB(B0, 0, 0); PG8_LDB(B1, 0, 1); PG8_SCHED; PG8_LDA(At, 0, 0); PG8_STAGE(PG8_SA(1, 1), a1 + hstepA, voffA);
            PG8_WAIT_V(8); PG8_WAIT_L(0); PG8_BAR; PG8_MMA(0, 0, At, B0); PG8_MMA(0, 1, At, B1); PG8_BAR; PG8_SCHED;
            PG8_LDA(At, 0, 1); PG8_STAGE(PG8_SB(0, 0), b2, voffB); PG8_STAGE(PG8_SB(0, 1), b2 + hstepB, voffB); PG8_STAGE(PG8_SA(0, 0), a2, voffA);
            PG8_WAIT_V(8); PG8_WAIT_L(0); PG8_BAR; PG8_MMA(1, 0, At, B0); PG8_MMA(1, 1, At, B1); PG8_BAR; PG8_SCHED;
            PG8_LDB(B0, 1, 0); PG8_LDB(B1, 1, 1); PG8_SCHED; PG8_LDA(At, 1, 0); PG8_STAGE(PG8_SA(0, 1), a2 + hstepA, voffA);
            PG8_WAIT_V(8); PG8_WAIT_L(0); PG8_BAR; PG8_MMA(0, 0, At, B0); PG8_MMA(0, 1, At, B1); PG8_BAR; PG8_SCHED;
            PG8_LDA(At, 1, 1); PG8_STAGE(PG8_SB(1, 0), b3, voffB); PG8_STAGE(PG8_SB(1, 1), b3 + hstepB, voffB); PG8_STAGE(PG8_SA(1, 0), a3, voffA);
            PG8_WAIT_V(8); PG8_WAIT_L(0); PG8_BAR; PG8_MMA(1, 0, At, B0); PG8_MMA(1, 1, At, B1); PG8_BAR; PG8_SCHED;
            } else {
            PG8_LDB(B0, 0, 0); PG8_SCHED; PG8_LDA(At, 0, 0); PG8_STAGE(PG8_SA(1, 1), a1 + hstepA, voffA);
            PG8_WAIT_L(8); PG8_BAR; PG8_WAIT_L(0); PG8_MMA(0, 0, At, B0); PG8_BAR; PG8_SCHED;
            PG8_LDB(B1, 0, 1); PG8_STAGE(PG8_SB(0, 0), b2, voffB);
            PG8_BAR; PG8_WAIT_L(0); PG8_MMA(0, 1, At, B1); PG8_BAR;
            PG8_LDA(At, 0, 1); PG8_STAGE(PG8_SA(0, 0), a2, voffA);
            PG8_BAR; PG8_WAIT_L(0); PG8_MMA(1, 0, At, B0); PG8_BAR; PG8_SCHED;
            PG8_STAGE(PG8_SB(0, 1), b2 + hstepB, voffB);
            PG8_WAIT_V(6); PG8_BAR; PG8_MMA(1, 1, At, B1); PG8_BAR;
            PG8_LDB(B0, 1, 0); PG8_SCHED; PG8_LDA(At, 1, 0); PG8_STAGE(PG8_SA(0, 1), a2 + hstepA, voffA);
            PG8_WAIT_L(8); PG8_BAR; PG8_WAIT_L(0); PG8_MMA(0, 0, At, B0); PG8_BAR; PG8_SCHED;
            PG8_LDB(B1, 1, 1); PG8_STAGE(PG8_SB(1, 0), b3, voffB);
            PG8_BAR; PG8_WAIT_L(0); PG8_MMA(0, 1, At, B1); PG8_BAR;
            PG8_LDA(At, 1, 1); PG8_STAGE(PG8_SA(1, 0), a3, voffA);
            PG8_BAR; PG8_WAIT_L(0); PG8_MMA(1, 0, At, B0); PG8_BAR; PG8_SCHED;
            PG8_STAGE(PG8_SB(1, 1), b3 + hstepB, voffB);
            PG8_WAIT_V(6); PG8_BAR; PG8_MMA(1, 1, At, B1); PG8_BAR;
            }
        }
        if constexpr (ALIGN_EPI) { if (wr == 0) PG8_BAR; }
        if constexpr (!Epi::AFTER_DRAIN) { E(acc, cur, wr, wc, fr, fq, ui); S.done(cur); }
        if (!has_next) break;
#pragma unroll
        for (int a = 0; a < 2; ++a)
#pragma unroll
            for (int b = 0; b < 2; ++b)
#pragma unroll
                for (int m = 0; m < 4; ++m)
#pragma unroll
                    for (int n = 0; n < 2; ++n) acc[a][b][m][n] = (f32x4){0.f, 0.f, 0.f, 0.f};
        cur = nxt; cA = nA; cB = nB; ++ui;
        if constexpr (ALIGN_EPI) { if (wr == 1) PG8_BAR; }
    }
    PG8_WAIT_V(0);
    if constexpr (!ALIGN_EPI) { if (wr == 0) PG8_BAR; }
    PG8_BAR;
    if constexpr (Epi::AFTER_DRAIN) { E.fused(acc, cur, wr, wc, fr, fq, lds, wid, lane); S.done(cur); }
#undef PG8_SA
#undef PG8_SB
#undef PG8_STAGE
#undef PG8_LDA
#undef PG8_LDB
#undef PG8_MMA
#undef PG8_WAIT_V
#undef PG8_WAIT_L
#undef PG8_BAR
#undef PG8_SCHED
}
}
constexpr int NWAVES = 8;
constexpr size_t MiB = 1u << 20;
constexpr size_t WS_CTL = 0, CTL_ZERO_BYTES = 1 * MiB;
constexpr size_t WS_TRIG = 1 * MiB, WS_GB = 2 * MiB + 256 * 1024;
constexpr size_t WS_WUP = 3 * MiB, WS_WDOWN = 14 * MiB, WS_WGATE = 19 * MiB + 512 * 1024, WS_WPLE = 21 * MiB + 512 * 1024;
constexpr size_t WS_NBUF = 22 * MiB;
constexpr size_t WS_BIG = 56 * MiB;
constexpr size_t WS_ACT = WS_BIG;
constexpr size_t WS_US = 155 * MiB, WS_UB = 167 * MiB;
constexpr size_t WS_WIN = 192 * MiB, WS_WOUT = 200 * MiB;
constexpr size_t WS_PB = 202 * MiB, WS_PE = 211 * MiB;
constexpr size_t WS_FRHI = 202 * MiB, WS_GLAST = 2 * MiB + 896 * 1024;
constexpr size_t WS_SSQA = 250 * MiB, WS_SSQB = 252 * MiB;
constexpr size_t WS_END = 256 * MiB;
static_assert(WS_ACT + (size_t)T * DFF * 2 <= WS_US && WS_BIG + (size_t)T * NPROJ * 2 <= WS_WIN && WS_US + (size_t)TS * NUP * 2 <= WS_UB && WS_UB + (size_t)256 * 4 * NUP * 4 <= WS_WIN, "d_ws map");
constexpr int CW_BAR = 4096;
constexpr int RING_OFF = 0, RING_BYTES = 131072;
constexpr int LDS_BYTES = 163840;
constexpr int LDSCTL_OFF = LDS_BYTES - 1024, MISC_OFF = LDSCTL_OFF + 320;
#define GAS __attribute__((address_space(1)))
#define LAS __attribute__((address_space(3)))
typedef unsigned v4u __attribute__((ext_vector_type(4)));
typedef float f32x4 __attribute__((ext_vector_type(4)));
typedef short bf16x8 __attribute__((ext_vector_type(8)));
typedef GAS unsigned gu32;
typedef GAS unsigned long long gu64;
#define RLX_AGENT __ATOMIC_RELAXED, __HIP_MEMORY_SCOPE_AGENT
#define LDS_WAIT() asm volatile("s_waitcnt lgkmcnt(0)" ::: "memory")
#define VM_WAIT() asm volatile("s_waitcnt vmcnt(0)" ::: "memory")
__device__ __forceinline__ unsigned long long rt() { return __builtin_amdgcn_s_memrealtime(); }
__device__ __forceinline__ unsigned pk2(float lo, float hi) { typedef float f2_ __attribute__((ext_vector_type(2))); typedef __bf16 b2_ __attribute__((ext_vector_type(2))); const f2_ v = {lo, hi}; return __builtin_bit_cast(unsigned, __builtin_convertvector(v, b2_)); }

#define XB_TMO      128
#define XB_XCNT(j)  (256  + 64 * (j))
#define XB_XSUB(j)  (1280 + 64 * (j))
#define XB_XGEN(j)  (2304 + 64 * (j))
#define XB_TOP      3328
#define XB_TOPGEN   3392
#define XCD_BAR_WORDS 3456
#define XB_SPIN_CAP (1u << 18)

__device__ __forceinline__ unsigned xb_ld(unsigned* p)              { return __hip_atomic_load(p, __ATOMIC_RELAXED, __HIP_MEMORY_SCOPE_AGENT); }
__device__ __forceinline__ unsigned xb_add(unsigned* p, unsigned v) { return __hip_atomic_fetch_add(p, v, __ATOMIC_RELAXED, __HIP_MEMORY_SCOPE_AGENT); }
__device__ __forceinline__ unsigned xb_xcc_id() { return (unsigned)__builtin_amdgcn_s_getreg((3 << 11) | 20) & 0xFu; }
#define XB_SPIN(cond, bar) do { unsigned _sp = 0; while (cond) { __builtin_amdgcn_s_sleep(1); \
    if ((++_sp & 255u) == 0u) { if (xb_ld(&(bar)[XB_TMO])) break; if (_sp > XB_SPIN_CAP) { atomicAdd(&(bar)[XB_TMO], 1u); break; } } } } while (0)

struct XcdBarrier {
    unsigned* bar; unsigned x;
    volatile LAS unsigned* st;
};

__device__ __forceinline__ XcdBarrier xcd_barrier_post(unsigned* bar, volatile LAS unsigned* st) {
    XcdBarrier b; b.bar = bar; b.x = xb_xcc_id(); b.st = st;
    if (threadIdx.x == 0) (void)xb_add(&bar[XB_XCNT(b.x)], 1u);
    return b;
}
__device__ __forceinline__ void xcd_barrier_complete(unsigned* bar, unsigned x, unsigned& nloc, unsigned& nx) {
    const unsigned G = gridDim.x * gridDim.y * gridDim.z;
    unsigned sum, cnt, mine, sp = 0u;
    for (;;) {
        sum = 0u; cnt = 0u; mine = 0u;
#pragma unroll
        for (unsigned j = 0; j < 16; ++j) { const unsigned c = xb_ld(&bar[XB_XCNT(j)]); sum += c; cnt += (c > 0u) ? 1u : 0u; mine = (j == x) ? c : mine; }
        if (sum == G) break;
        __builtin_amdgcn_s_sleep(1);
        if ((++sp & 255u) == 0u) { if (xb_ld(&bar[XB_TMO])) break; if (sp > XB_SPIN_CAP) { atomicAdd(&bar[XB_TMO], 1u); break; } }
    }
    nloc = mine > 0u ? mine : 1u; nx = cnt > 0u ? cnt : 1u;
}

__device__ __forceinline__ void xcd_barrier(const XcdBarrier& b) {
    asm volatile("s_waitcnt vmcnt(0)" ::: "memory");
    __syncthreads();
    if (threadIdx.x == 0) {
        unsigned* bar = b.bar;
        __builtin_amdgcn_s_waitcnt(0);
        unsigned nloc = b.st[0], nx = b.st[1];
        if (nloc == 0u) { xcd_barrier_complete(bar, b.x, nloc, nx); b.st[0] = nloc; b.st[1] = nx; }
        const unsigned old = xb_add(&bar[XB_XSUB(b.x)], 1u);
        const unsigned gen = old / nloc;
        if (old + 1u == (gen + 1u) * nloc) {
            __builtin_amdgcn_fence(__ATOMIC_RELEASE, "agent");
            asm volatile("s_waitcnt vmcnt(0)" ::: "memory");
            const unsigned og = xb_add(&bar[XB_TOP], 1u);
            const unsigned tg = og / nx;
            if (og + 1u == (tg + 1u) * nx) xb_add(&bar[XB_TOPGEN], 1u);
            else XB_SPIN(xb_ld(&bar[XB_TOPGEN]) == tg, bar);
            __builtin_amdgcn_fence(__ATOMIC_ACQUIRE, "agent");
            xb_add(&bar[XB_XGEN(b.x)], 1u);
            asm volatile("s_waitcnt vmcnt(0)" ::: "memory");
        } else {
            XB_SPIN(xb_ld(&bar[XB_XGEN(b.x)]) == gen, bar);
            __builtin_amdgcn_fence(__ATOMIC_ACQUIRE, "agent");
            asm volatile("s_waitcnt vmcnt(0)" ::: "memory");
        }
    }
    __syncthreads();
}

struct Args { const float* in[25]; float* dout; unsigned char* dws; int ph_lo, ph_hi, li, pad; };
enum InIdx { I_XP = 0, I_XS, I_PP, I_PS, I_ST_CONV, I_ST_DN, I_ST_RET, I_ST_FFN, I_ATTN_NW, I_WIN, I_DN_CONVW, I_ALOG, I_DTB, I_DN_NW, I_RET_NW,
             I_WOUT, I_FFN_NW, I_WUP, I_FFN_CW, I_FFN_CB, I_WDOWN, I_PLE_NW, I_WGATE, I_WPLE, I_FINAL_NW };
struct Frame {
    LAS unsigned char* lds; volatile LAS unsigned* MISC; gu32* ctl;
    int tid, lane, wave, G, gw, NGW;
};

__device__ __forceinline__ void transpose_item(const float* W, int ldw, int oc0, int K, bf16* WT, int n0, int k0, LAS float* scr, int lane, const float* kscale) {
#pragma unroll
    for (int i = 0; i < 32; ++i) { const int kk = 2 * i + (lane >> 5); float v = W[(size_t)(k0 + kk) * ldw + oc0 + (lane & 31)]; if (kscale) v *= kscale[k0 + kk]; scr[kk * 33 + (lane & 31)] = v; }
    LDS_WAIT(); asm volatile("" ::: "memory");
    const int c = lane & 7;
#pragma unroll
    for (int j = 0; j < 4; ++j) { const int n = (lane >> 3) + 8 * j; const LAS float* s = scr + (8 * c) * 33 + n;
        v4u o; o.x = pk2(s[0 * 33], s[1 * 33]); o.y = pk2(s[2 * 33], s[3 * 33]); o.z = pk2(s[4 * 33], s[5 * 33]); o.w = pk2(s[6 * 33], s[7 * 33]);
        *(GAS v4u*)(WT + (size_t)(n0 + n) * K + k0 + 8 * c) = o; }
    LDS_WAIT(); asm volatile("" ::: "memory");
}
template <int MODE>
__device__ __forceinline__ void rows_norm_phase(const Frame& F, const float* xp, const float* xs, const float* w, bf16* outb,
                                                const float* w_in, const float* A_log, const float* dt_bias, float* gb, LAS float* wsT) {
    const int lane = F.lane;
    if (MODE == 0) {
        for (int i = F.tid; i < 8192; i += 512) { const int k = i >> 3, c = i & 7; wsT[c * 1024 + k] = w_in[(size_t)k * 4104 + 2048 + c]; }
        __syncthreads();
    }
    f32x4 ww[4];
#pragma unroll
    for (int j = 0; j < 4; ++j) ww[j] = *(const f32x4*)(w + 4 * lane + 256 * j);
    int row = F.gw;
    f32x4 nx[4];
    if (row < T) { const float* x = (MODE == 0) ? (row < TP ? xp + (size_t)row * D : xs + (size_t)(row - TP) * D) : xp + (size_t)row * D;
#pragma unroll
        for (int j = 0; j < 4; ++j) nx[j] = *(const f32x4*)(x + 4 * lane + 256 * j); }
    for (; row < T; row += F.NGW) {
        f32x4 v[4];
#pragma unroll
        for (int j = 0; j < 4; ++j) v[j] = nx[j];
        const int nrow = row + F.NGW;
        if (nrow < T) { const float* x = (MODE == 0) ? (nrow < TP ? xp + (size_t)nrow * D : xs + (size_t)(nrow - TP) * D) : xp + (size_t)nrow * D;
#pragma unroll
            for (int j = 0; j < 4; ++j) nx[j] = *(const f32x4*)(x + 4 * lane + 256 * j); }
        float s = 0.f;
#pragma unroll
        for (int j = 0; j < 4; ++j) s += (v[j][0] * v[j][0] + v[j][1] * v[j][1]) + (v[j][2] * v[j][2] + v[j][3] * v[j][3]);
        s = wave_sum(s);
        const float rstd = rsqrtf(s * (1.f / D) + EPS);
#pragma unroll
        for (int j = 0; j < 4; ++j) {
            v[j] = v[j] * ww[j] * rstd;
            uint2 o; o.x = pk2(v[j][0], v[j][1]); o.y = pk2(v[j][2], v[j][3]);
            *(uint2*)(outb + (size_t)row * D + 4 * lane + 256 * j) = o;
        }
        if (MODE == 0) {
            float acc[8];
#pragma unroll
            for (int c = 0; c < 8; ++c) { float a = 0.f;
#pragma unroll
                for (int j = 0; j < 4; ++j) { const f32x4 wv = *(const LAS f32x4*)(wsT + c * 1024 + 4 * lane + 256 * j); a += (v[j][0] * wv[0] + v[j][1] * wv[1]) + (v[j][2] * wv[2] + v[j][3] * wv[3]); }
                acc[c] = wave_sum(a); }
            float r = 0.f;
#pragma unroll
            for (int c = 0; c < 8; ++c) r = (lane == c) ? acc[c] : r;
            if (lane < 4) gb[(size_t)row * 8 + lane] = sigmoid_f(r);
            else if (lane < 8) { const int h = lane - 4; const float xx = r + dt_bias[h]; const float sp = (xx > 20.f) ? xx : log1pf(__expf(xx)); gb[(size_t)row * 8 + lane] = -__expf(A_log[h]) * sp; }
        }
    }
}
__device__ __forceinline__ void trig_phase(const Frame& F, float2* trig) {
    for (int idx = blockIdx.x * 512 + F.tid; idx < 2056 * 64; idx += F.G * 512) {
        const int pi = idx >> 6, i = idx & 63;
        const int pos = pi < 2048 ? pi : 16384 + (pi - 2048);
        const float invf = (float)exp2(-(double)i * (2.0 / 128.0) * 13.287712379549449);
        const double a = (double)pos * (double)invf;
        const double rev = a * 0.15915494309189535;
        const double fr = rev - rint(rev);
        trig[idx] = make_float2(__builtin_amdgcn_cosf((float)fr), __builtin_amdgcn_sinf((float)fr));
    }
}
__device__ __forceinline__ void final_norm_phase(const Frame& F, float* h, const float* w) {
    const int lane = F.lane;
    for (int row = F.gw; row < T; row += F.NGW) {
        float* x = h + (size_t)row * D; f32x4 v[4]; float s = 0.f;
#pragma unroll
        for (int j = 0; j < 4; ++j) { v[j] = *(const f32x4*)(x + 4 * lane + 256 * j); s += v[j][0] * v[j][0] + v[j][1] * v[j][1] + v[j][2] * v[j][2] + v[j][3] * v[j][3]; }
        s = wave_sum(s); const float rstd = rsqrtf(s * (1.f / D) + EPS);
#pragma unroll
        for (int j = 0; j < 4; ++j) { const f32x4 ww = *(const f32x4*)(w + 4 * lane + 256 * j); *(f32x4*)(x + 4 * lane + 256 * j) = v[j] * ww * rstd; }
    }
}
__device__ __forceinline__ void bf8_to_f32(const v4u w, float* o) {
    o[0] = __uint_as_float(w.x << 16); o[1] = __uint_as_float(w.x & 0xffff0000u); o[2] = __uint_as_float(w.y << 16); o[3] = __uint_as_float(w.y & 0xffff0000u);
    o[4] = __uint_as_float(w.z << 16); o[5] = __uint_as_float(w.z & 0xffff0000u); o[6] = __uint_as_float(w.w << 16); o[7] = __uint_as_float(w.w & 0xffff0000u);
}
__device__ __forceinline__ void act_phase(const Frame& F, const bf16* u, int row0, int nrows, const float* cw, const float* cb, const float* st_ffn, bf16* act, float* out) {
    const int total = nrows * 352;
    for (int i = blockIdx.x * 512 + F.tid; i < total; i += F.G * 512) {
        const int lr = i / 352, g8 = i - lr * 352, ch = 8 * g8, row = row0 + lr;
        const bool prompt = row < TP; const int b = prompt ? row / SEQ : (row - TP) / DSEQ; const int pos = prompt ? row % SEQ : (row - TP) % DSEQ; const int L = prompt ? SEQ : DSEQ;
        const int ng = (ch >> 7) * 256 + (ch & 127), nv = ng + 128;
        float xg[3][8], xv[3][8];
#pragma unroll
        for (int r = 0; r < 3; ++r) {
            const int p = pos - 2 + r;
            if (p >= 0) { bf8_to_f32(*(const v4u*)(u + (size_t)(lr - 2 + r) * NUP + ng), xg[r]); bf8_to_f32(*(const v4u*)(u + (size_t)(lr - 2 + r) * NUP + nv), xv[r]); }
            else if (prompt) {
#pragma unroll
                for (int e = 0; e < 8; ++e) { xg[r][e] = 0.f; xv[r][e] = 0.f; }
            } else { const float* sp = st_ffn + ((size_t)b * 2 + (p + 2)) * NUP + ch;
#pragma unroll
                for (int e = 0; e < 8; ++e) { xg[r][e] = sp[e]; xv[r][e] = sp[DFF + e]; } }
        }
        float o[8];
#pragma unroll
        for (int e = 0; e < 8; ++e) {
            const int c = ch + e;
            const float ug = cw[c] * xg[0][e] + cw[NUP + c] * xg[1][e] + cw[2 * NUP + c] * xg[2][e] + cb[c];
            const float uv = cw[DFF + c] * xv[0][e] + cw[NUP + DFF + c] * xv[1][e] + cw[2 * NUP + DFF + c] * xv[2][e] + cb[DFF + c];
            o[e] = silu_f(ug) * uv;
        }
        v4u w; w.x = pk2(o[0], o[1]); w.y = pk2(o[2], o[3]); w.z = pk2(o[4], o[5]); w.w = pk2(o[6], o[7]);
        *(v4u*)(act + (size_t)row * DFF + ch) = w;
        if (pos >= L - 2) { float* op = out + (prompt ? O_FFN_P : O_FFN_S) + ((size_t)b * 2 + (pos - (L - 2))) * NUP + ch;
#pragma unroll
            for (int e = 0; e < 8; ++e) { op[e] = xg[2][e]; op[DFF + e] = xv[2][e]; } }
    }
}

__device__ __forceinline__ float grp_sum128(float v, LAS float* red, int w2, int lane) {
    v = wave_sum(v); __syncthreads(); if (lane == 0) red[w2] = v; __syncthreads(); return red[0] + red[1];
}
__device__ __forceinline__ void dn_item(LAS float* gl, int j, int w2, int lane, bool prompt, int b, int h, bf16* proj, const float* gb, const float* conv_w, const float* dn_norm_w,
                                        const float* st_conv, const float* st_dn, float* out) {
    LAS float* qs = gl; LAS float* ks = gl + 128; LAS float* red = gl + 256;
    const int L = prompt ? SEQ : DSEQ; const size_t row0 = prompt ? (size_t)b * SEQ : (size_t)TP + (size_t)b * DSEQ;
    float S[128];
#pragma unroll
    for (int d = 0; d < 128; ++d) S[d] = prompt ? 0.f : st_dn[((size_t)(b * 4 + h) * 128 + d) * 128 + j];
    const int cq = h * 128 + j, ck = 512 + h * 128 + j, cv = 1024 + h * 128 + j;
    float wq[4], wk[4], wv[4], xq[3], xk[3], xv[3];
#pragma unroll
    for (int i = 0; i < 4; ++i) { wq[i] = conv_w[i * 1536 + cq]; wk[i] = conv_w[i * 1536 + ck]; wv[i] = conv_w[i * 1536 + cv]; }
#pragma unroll
    for (int i = 0; i < 3; ++i) {
        xq[i] = prompt ? 0.f : st_conv[((size_t)b * 3 + i) * 1536 + cq];
        xk[i] = prompt ? 0.f : st_conv[((size_t)b * 3 + i) * 1536 + ck];
        xv[i] = prompt ? 0.f : st_conv[((size_t)b * 3 + i) * 1536 + cv];
    }
    const float nw = dn_norm_w[j];
    for (int t = 0; t < L; ++t) {
        const size_t row = row0 + t; bf16* pr = proj + row * NPROJ;
        const float pq = bf2f(pr[cq]), pk = bf2f(pr[ck]), pv = bf2f(pr[cv]);
        const float q0 = silu_f(wq[0] * xq[0] + wq[1] * xq[1] + wq[2] * xq[2] + wq[3] * pq);
        const float k0 = silu_f(wk[0] * xk[0] + wk[1] * xk[1] + wk[2] * xk[2] + wk[3] * pk);
        const float v0 = silu_f(wv[0] * xv[0] + wv[1] * xv[1] + wv[2] * xv[2] + wv[3] * pv);
        xq[0] = xq[1]; xq[1] = xq[2]; xq[2] = pq; xk[0] = xk[1]; xk[1] = xk[2]; xk[2] = pk; xv[0] = xv[1]; xv[1] = xv[2]; xv[2] = pv;
        const float sq = grp_sum128(q0 * q0, red, w2, lane), sk = grp_sum128(k0 * k0, red, w2, lane);
        qs[j] = q0 * rsqrtf(sq + EPS) * 0.08838834764831845f; ks[j] = k0 * rsqrtf(sk + EPS);
        __syncthreads();
        const float beta = gb[row * 8 + h], a = __expf(gb[row * 8 + 4 + h]);
        float kS = 0.f;
#pragma unroll
        for (int d = 0; d < 128; ++d) kS += ks[d] * S[d];
        const float delta = beta * (v0 - a * kS);
        float o = 0.f;
#pragma unroll
        for (int d = 0; d < 128; ++d) { S[d] = a * S[d] + ks[d] * delta; o += S[d] * qs[d]; }
        const float so = grp_sum128(o * o, red, w2, lane);
        const float z = bf2f(pr[3072 + h * 128 + j]);
        pr[3072 + h * 128 + j] = f2bf(o * rsqrtf(so * (1.f / 128.f) + EPS) * nw * silu_f(z));
    }
    float* so_ = out + (prompt ? O_DN_P : O_DN_S) + (size_t)(b * 4 + h) * 16384;
#pragma unroll
    for (int d = 0; d < 128; ++d) so_[d * 128 + j] = S[d];
    float* co = out + (prompt ? O_DNCONV_P : O_DNCONV_S) + (size_t)b * 3 * 1536;
#pragma unroll
    for (int i = 0; i < 3; ++i) { co[i * 1536 + cq] = xq[i]; co[i * 1536 + ck] = xk[i]; co[i * 1536 + cv] = xv[i]; }
}
__device__ __forceinline__ void ret_item(LAS float* gl, int j, int w2, int lane, bool prompt, int b, int h, bf16* proj, const float2* trig, const float* ret_norm_w, const float* st_ret, float* out) {
    LAS float* qs = gl; LAS float* ks = gl + 128; LAS float* red = gl + 256;
    const int L = prompt ? SEQ : DSEQ; const size_t row0 = prompt ? (size_t)b * SEQ : (size_t)TP + (size_t)b * DSEQ;
    float R[128];
#pragma unroll
    for (int d = 0; d < 128; ++d) R[d] = prompt ? 0.f : st_ret[((size_t)(b * 4 + h) * 128 + d) * 128 + j];
    const float gamma = 1.f - exp2f(-5.f - (float)h);
    const float nw = ret_norm_w[h * 128 + j];
    const int cq = 1536 + h * 128 + j, ck = 2048 + h * 128 + j, cv = 2560 + h * 128 + j, cg = 3584 + h * 128 + j;
    for (int t = 0; t < L; ++t) {
        const size_t row = row0 + t; bf16* pr = proj + row * NPROJ;
        const float q = bf2f(pr[cq]), k = bf2f(pr[ck]), v = bf2f(pr[cv]);
        __syncthreads();
        qs[j] = q; ks[j] = k;
        __syncthreads();
        const float2 cs = trig[(size_t)((prompt ? 0 : 2048) + t) * 64 + (j >> 1)];
        const float qp = qs[j ^ 1], kp = ks[j ^ 1];
        const float qr = (j & 1) ? (qp * cs.y + q * cs.x) : (q * cs.x - qp * cs.y);
        const float kr = ((j & 1) ? (kp * cs.y + k * cs.x) : (k * cs.x - kp * cs.y)) * 0.08838834764831845f;
        __syncthreads();
        qs[j] = qr; ks[j] = kr;
        __syncthreads();
        float o = 0.f;
#pragma unroll
        for (int d = 0; d < 128; ++d) { R[d] = gamma * R[d] + ks[d] * v; o += qs[d] * R[d]; }
        const float mu = grp_sum128(o, red, w2, lane) * (1.f / 128.f);
        const float dlt = o - mu;
        const float var = grp_sum128(dlt * dlt, red, w2, lane) * (1.f / 128.f);
        const float g = bf2f(pr[cg]);
        pr[cg] = f2bf(dlt * rsqrtf(var + EPS) * nw * silu_f(g));
    }
    float* so_ = out + (prompt ? O_RET_P : O_RET_S) + (size_t)(b * 4 + h) * 16384;
#pragma unroll
    for (int d = 0; d < 128; ++d) so_[d * 128 + j] = R[d];
}

__device__ __forceinline__ float grp_sum256(float v, LAS float* red, int w4, int lane) {
    v = wave_sum(v); __syncthreads(); if (lane == 0) red[w4] = v; __syncthreads(); return (red[0] + red[1]) + (red[2] + red[3]);
}
__device__ __forceinline__ void dn_item2(LAS float* gl, int t256, int w4, int lane, bool prompt, int b, int h, bf16* proj, const float* gb, const float* conv_w, const float* dn_norm_w,
                                         const float* st_conv, const float* st_dn, float* out) {
    LAS float* qs = gl; LAS float* ks = gl + 128; LAS float* red = gl + 256;
    const int j = t256 >> 1, half = t256 & 1, d0 = 64 * half; const float once = half ? 0.f : 1.f;
    const int L = prompt ? SEQ : DSEQ; const size_t row0 = prompt ? (size_t)b * SEQ : (size_t)TP + (size_t)b * DSEQ;
    float S[64];
#pragma unroll
    for (int d = 0; d < 64; ++d) S[d] = prompt ? 0.f : st_dn[((size_t)(b * 4 + h) * 128 + d0 + d) * 128 + j];
    const int cq = h * 128 + j, ck = 512 + h * 128 + j, cv = 1024 + h * 128 + j;
    float wq[4], wk[4], wv[4], xq[3], xk[3], xv[3];
#pragma unroll
    for (int i = 0; i < 4; ++i) { wq[i] = conv_w[i * 1536 + cq]; wk[i] = conv_w[i * 1536 + ck]; wv[i] = conv_w[i * 1536 + cv]; }
#pragma unroll
    for (int i = 0; i < 3; ++i) {
        xq[i] = prompt ? 0.f : st_conv[((size_t)b * 3 + i) * 1536 + cq];
        xk[i] = prompt ? 0.f : st_conv[((size_t)b * 3 + i) * 1536 + ck];
        xv[i] = prompt ? 0.f : st_conv[((size_t)b * 3 + i) * 1536 + cv];
    }
    const float nw = dn_norm_w[j];
    for (int t = 0; t < L; ++t) {
        const size_t row = row0 + t; bf16* pr = proj + row * NPROJ;
        const float pq = bf2f(pr[cq]), pk = bf2f(pr[ck]), pv = bf2f(pr[cv]);
        const float q0 = silu_f(wq[0] * xq[0] + wq[1] * xq[1] + wq[2] * xq[2] + wq[3] * pq);
        const float k0 = silu_f(wk[0] * xk[0] + wk[1] * xk[1] + wk[2] * xk[2] + wk[3] * pk);
        const float v0 = silu_f(wv[0] * xv[0] + wv[1] * xv[1] + wv[2] * xv[2] + wv[3] * pv);
        xq[0] = xq[1]; xq[1] = xq[2]; xq[2] = pq; xk[0] = xk[1]; xk[1] = xk[2]; xk[2] = pk; xv[0] = xv[1]; xv[1] = xv[2]; xv[2] = pv;
        const float sq = grp_sum256(q0 * q0 * once, red, w4, lane), sk = grp_sum256(k0 * k0 * once, red, w4, lane);
        if (!half) { qs[j] = q0 * rsqrtf(sq + EPS) * 0.08838834764831845f; ks[j] = k0 * rsqrtf(sk + EPS); }
        __syncthreads();
        const float beta = gb[row * 8 + h], a = __expf(gb[row * 8 + 4 + h]);
        float kS = 0.f;
#pragma unroll
        for (int d = 0; d < 64; ++d) kS += ks[d0 + d] * S[d];
        kS += __shfl_xor(kS, 1);
        const float delta = beta * (v0 - a * kS);
        float o = 0.f;
#pragma unroll
        for (int d = 0; d < 64; ++d) { S[d] = a * S[d] + ks[d0 + d] * delta; o += S[d] * qs[d0 + d]; }
        o += __shfl_xor(o, 1);
        const float so = grp_sum256(o * o * once, red, w4, lane);
        if (!half) { const float z = bf2f(pr[3072 + h * 128 + j]); pr[3072 + h * 128 + j] = f2bf(o * rsqrtf(so * (1.f / 128.f) + EPS) * nw * silu_f(z)); }
    }
    float* so_ = out + (prompt ? O_DN_P : O_DN_S) + (size_t)(b * 4 + h) * 16384;
#pragma unroll
    for (int d = 0; d < 64; ++d) so_[(d0 + d) * 128 + j] = S[d];
    if (!half) { float* co = out + (prompt ? O_DNCONV_P : O_DNCONV_S) + (size_t)b * 3 * 1536;
#pragma unroll
        for (int i = 0; i < 3; ++i) { co[i * 1536 + cq] = xq[i]; co[i * 1536 + ck] = xk[i]; co[i * 1536 + cv] = xv[i]; } }
}
__device__ __forceinline__ void ret_item2(LAS float* gl, int t256, int w4, int lane, bool prompt, int b, int h, bf16* proj, const float2* trig, const float* ret_norm_w, const float* st_ret, float* out) {
    LAS float* qs = gl; LAS float* ks = gl + 128; LAS float* red = gl + 256;
    const int j = t256 >> 1, half = t256 & 1, d0 = 64 * half; const float once = half ? 0.f : 1.f;
    const int L = prompt ? SEQ : DSEQ; const size_t row0 = prompt ? (size_t)b * SEQ : (size_t)TP + (size_t)b * DSEQ;
    float R[64];
#pragma unroll
    for (int d = 0; d < 64; ++d) R[d] = prompt ? 0.f : st_ret[((size_t)(b * 4 + h) * 128 + d0 + d) * 128 + j];
    const float gamma = 1.f - exp2f(-5.f - (float)h);
    const float nw = ret_norm_w[h * 128 + j];
    const int cq = 1536 + h * 128 + j, ck = 2048 + h * 128 + j, cv = 2560 + h * 128 + j, cg = 3584 + h * 128 + j;
    for (int t = 0; t < L; ++t) {
        const size_t row = row0 + t; bf16* pr = proj + row * NPROJ;
        const float q = bf2f(pr[cq]), k = bf2f(pr[ck]), v = bf2f(pr[cv]);
        __syncthreads();
        if (!half) { qs[j] = q; ks[j] = k; }
        __syncthreads();
        const float2 cs = trig[(size_t)((prompt ? 0 : 2048) + t) * 64 + (j >> 1)];
        const float qp = qs[j ^ 1], kp = ks[j ^ 1];
        const float qr = (j & 1) ? (qp * cs.y + q * cs.x) : (q * cs.x - qp * cs.y);
        const float kr = ((j & 1) ? (kp * cs.y + k * cs.x) : (k * cs.x - kp * cs.y)) * 0.08838834764831845f;
        __syncthreads();
        if (!half) { qs[j] = qr; ks[j] = kr; }
        __syncthreads();
        float o = 0.f;
#pragma unroll
        for (int d = 0; d < 64; ++d) { R[d] = gamma * R[d] + ks[d0 + d] * v; o += qs[d0 + d] * R[d]; }
        o += __shfl_xor(o, 1);
        const float mu = grp_sum256(o * once, red, w4, lane) * (1.f / 128.f);
        const float dlt = o - mu;
        const float var = grp_sum256(dlt * dlt * once, red, w4, lane) * (1.f / 128.f);
        if (!half) { const float g = bf2f(pr[cg]); pr[cg] = f2bf(dlt * rsqrtf(var + EPS) * nw * silu_f(g)); }
    }
    float* so_ = out + (prompt ? O_RET_P : O_RET_S) + (size_t)(b * 4 + h) * 16384;
#pragma unroll
    for (int d = 0; d < 64; ++d) so_[(d0 + d) * 128 + j] = R[d];
}


template <class Sched>
__device__ __forceinline__ void build_rstd_tables(const Frame& F, const Sched& S, const float* ssq, int rowbase, LAS float* tbl) {
    pg8::Unit u;
    for (int i = 0; S.next(i, u); ++i) {
        const int r = F.tid >> 1, hsel = F.tid & 1;
        const float* p = ssq + ((size_t)(rowbase + u.pm * 256 + r)) * 16 + hsel * 8;
        const f32x4 a = *(const f32x4*)p, b = *(const f32x4*)(p + 4);
        float s = ((a[0] + a[1]) + (a[2] + a[3])) + ((b[0] + b[1]) + (b[2] + b[3]));
        s += __shfl_xor(s, 1);
        if (!hsel) tbl[i * 256 + r] = rsqrtf(s * (1.f / 1024.f) + EPS);
    }
    __syncthreads();
}
__device__ __forceinline__ void final_norm_phase2(const Frame& F, float* h, const float* ssq, const float* w) {
    const int lane = F.lane;
    for (int row = F.gw; row < T; row += F.NGW) {
        float* x = h + (size_t)row * D;
        float s = lane < 16 ? ssq[(size_t)row * 16 + lane] : 0.f;
        s = wave_sum(s); const float rstd = rsqrtf(s * (1.f / D) + EPS);
#pragma unroll
        for (int j = 0; j < 4; ++j) { const f32x4 v = *(const f32x4*)(x + 4 * lane + 256 * j); const f32x4 ww = *(const f32x4*)(w + 4 * lane + 256 * j); *(f32x4*)(x + 4 * lane + 256 * j) = v * ww * rstd; }
    }
}

__device__ __forceinline__ void ffn_fixup_phase(const Frame& F, const float* ub, const float* cw, const float* cb, bf16* act, float* out) {
    const int total = 256 * 2 * 352;
    for (int i = blockIdx.x * 512 + F.tid; i < total; i += F.G * 512) {
        const int g8 = i % 352, gq = i / 352, q = gq & 1, G = gq >> 1, ch = 8 * g8, ng = (ch >> 7) * 256 + (ch & 127);
        const bool first = (G & 31) == 0;
        const float* cur = ub + ((size_t)G * 4 + q) * 5632 + ng;
        const float* p1 = q ? ub + ((size_t)G * 4) * 5632 + ng : ub + ((size_t)(G - 1) * 4 + 3) * 5632 + ng;
        const float* p2 = q ? ub + ((size_t)(G - 1) * 4 + 3) * 5632 + ng : ub + ((size_t)(G - 1) * 4 + 2) * 5632 + ng;
        const bool z1 = first && q == 0, z2 = first;
        float o[8];
#pragma unroll
        for (int hsel = 0; hsel < 2; ++hsel) {
            const f32x4 xg = *(const f32x4*)(cur + 4 * hsel), xv = *(const f32x4*)(cur + 128 + 4 * hsel);
            f32x4 g1 = {0.f, 0.f, 0.f, 0.f}, g2 = g1, v1 = g1, v2 = g1;
            if (!z1) { g1 = *(const f32x4*)(p1 + 4 * hsel); v1 = *(const f32x4*)(p1 + 128 + 4 * hsel); }
            if (!z2) { g2 = *(const f32x4*)(p2 + 4 * hsel); v2 = *(const f32x4*)(p2 + 128 + 4 * hsel); }
#pragma unroll
            for (int e = 0; e < 4; ++e) { const int c = ch + 4 * hsel + e;
                const float yg = cw[c] * g2[e] + cw[NUP + c] * g1[e] + cw[2 * NUP + c] * xg[e] + cb[c];
                const float yv = cw[DFF + c] * v2[e] + cw[NUP + DFF + c] * v1[e] + cw[2 * NUP + DFF + c] * xv[e] + cb[DFF + c];
                o[4 * hsel + e] = silu_f(yg) * yv; }
        }
        v4u w; w.x = pk2(o[0], o[1]); w.y = pk2(o[2], o[3]); w.z = pk2(o[4], o[5]); w.w = pk2(o[6], o[7]);
        *(v4u*)(act + (size_t)(64 * G + q) * DFF + ch) = w;
        if ((G & 31) == 31) {
            const float* s = ub + ((size_t)G * 4 + 2 + q) * 5632 + ng; float* op = out + O_FFN_P + ((size_t)(G >> 5) * 2 + q) * NUP + ch;
            *(f32x4*)op = *(const f32x4*)s; *(f32x4*)(op + 4) = *(const f32x4*)(s + 4); *(f32x4*)(op + DFF) = *(const f32x4*)(s + 128); *(f32x4*)(op + DFF + 4) = *(const f32x4*)(s + 132);
        }
    }
}

typedef __bf16 bfx8 __attribute__((ext_vector_type(8)));
typedef float f32x16 __attribute__((ext_vector_type(16)));
typedef float f32x8 __attribute__((ext_vector_type(8)));
#define MFMA32(a, b, c) __builtin_amdgcn_mfma_f32_32x32x16_bf16((a), (b), (c), 0, 0, 0)
__device__ __forceinline__ int crow(int reg, int h) { return (reg & 3) + 8 * (reg >> 2) + 4 * h; }
__device__ __forceinline__ bfx8 pack8(float a0, float a1, float a2, float a3, float a4, float a5, float a6, float a7) {
    const f32x8 v = {a0, a1, a2, a3, a4, a5, a6, a7}; return __builtin_convertvector(v, bfx8);
}
#define PACK_STEP(x, s) pack8((x)[8 * (s)], (x)[8 * (s) + 1], (x)[8 * (s) + 2], (x)[8 * (s) + 3], (x)[8 * (s) + 4], (x)[8 * (s) + 5], (x)[8 * (s) + 6], (x)[8 * (s) + 7])
__device__ __forceinline__ void st_frag(unsigned char* fragblk, int f, int l, bfx8 v) { *(bfx8*)(fragblk + (size_t)f * 1024 + l * 16) = v; }
__device__ __forceinline__ void lds_barrier() { asm volatile("s_waitcnt lgkmcnt(0)" ::: "memory"); __builtin_amdgcn_s_barrier(); asm volatile("" ::: "memory"); }
__device__ __forceinline__ float shfl_xor_l(float v, int o, int lane) { return __int_as_float(__builtin_amdgcn_ds_bpermute((lane ^ o) << 2, __float_as_int(v))); }
constexpr int IMG_STRIDE = 132;
constexpr int IMG_BYTES = 64 * IMG_STRIDE * 4;
constexpr int MAT_STRIDE = 68;
constexpr int MAT_BYTES = 64 * MAT_STRIDE * 4;
constexpr int RET_FRAG_P = 56 * 1024, RET_FRAG_S = 17 * 1024;
constexpr int SLOT_BYTES = 56 * 1024, OBUF_OFF = 2 * SLOT_BYTES, OBUF_STRIDE = 272, OBUF_BYTES = 64 * OBUF_STRIDE;

template <int C>
__device__ __forceinline__ void ret_prep_item(const Frame& F, bool prompt, int b, int h, int chunk, const bf16* proj, const float2* trig, unsigned char* frag) {
    constexpr int MT = C == 64 ? 2 : 1, KS = C == 64 ? 4 : 1;
    LAS float* Qi = (LAS float*)(F.lds); LAS float* Ki = (LAS float*)(F.lds + IMG_BYTES); LAS float* Vi = (LAS float*)(F.lds + 2 * IMG_BYTES);
    LAS float* QKM = (LAS float*)(F.lds + 3 * IMG_BYTES);
    const int tid = F.tid, lane = F.lane, wave = F.wave, hh = lane >> 5, l31 = lane & 31;
    const size_t row0 = prompt ? (size_t)b * SEQ + (size_t)chunk * 64 : (size_t)TP + (size_t)b * DSEQ;
    const int pos0 = prompt ? chunk * 64 : 2048;
    const float lg2 = log2f(1.f - exp2f(-5.f - (float)h));
    for (int w = tid; w < C * 32; w += 512) {
        const int t = w >> 5, c4 = (w & 31) * 4;
        const bf16* pr = proj + (row0 + t) * NPROJ + 1536 + h * 128 + c4;
        const uint2 q2 = *(const uint2*)pr, k2 = *(const uint2*)(pr + 512), v2 = *(const uint2*)(pr + 1024);
        const f32x4 tr = *(const f32x4*)(&trig[(size_t)(pos0 + t) * 64 + (c4 >> 1)]);
        const float q0 = __uint_as_float(q2.x << 16), q1 = __uint_as_float(q2.x & 0xffff0000u), q2_ = __uint_as_float(q2.y << 16), q3 = __uint_as_float(q2.y & 0xffff0000u);
        const float k0 = __uint_as_float(k2.x << 16), k1 = __uint_as_float(k2.x & 0xffff0000u), k2_ = __uint_as_float(k2.y << 16), k3 = __uint_as_float(k2.y & 0xffff0000u);
        const float sc = 0.08838834764831845f;
        f32x4 qo, ko, vo;
        qo[0] = q0 * tr[0] - q1 * tr[1]; qo[1] = q0 * tr[1] + q1 * tr[0]; qo[2] = q2_ * tr[2] - q3 * tr[3]; qo[3] = q2_ * tr[3] + q3 * tr[2];
        ko[0] = (k0 * tr[0] - k1 * tr[1]) * sc; ko[1] = (k0 * tr[1] + k1 * tr[0]) * sc; ko[2] = (k2_ * tr[2] - k3 * tr[3]) * sc; ko[3] = (k2_ * tr[3] + k3 * tr[2]) * sc;
        vo[0] = __uint_as_float(v2.x << 16); vo[1] = __uint_as_float(v2.x & 0xffff0000u); vo[2] = __uint_as_float(v2.y << 16); vo[3] = __uint_as_float(v2.y & 0xffff0000u);
        *(LAS f32x4*)(Qi + t * IMG_STRIDE + c4) = qo; *(LAS f32x4*)(Ki + t * IMG_STRIDE + c4) = ko; *(LAS f32x4*)(Vi + t * IMG_STRIDE + c4) = vo;
    }
    lds_barrier();
    if (wave < (C == 64 ? 3 : 1)) {
        const int mt = wave == 0 ? 0 : 1, nt = wave == 2 ? 1 : 0;
        const int ar = 32 * mt + l31, br = 32 * nt + l31;
        f32x16 acc;
#pragma unroll
        for (int r = 0; r < 16; ++r) acc[r] = 0.f;
#pragma unroll
        for (int ks = 0; ks < 8; ++ks) {
            const int k = 16 * ks + 8 * hh;
            f32x4 a0 = {0.f, 0.f, 0.f, 0.f}, a1 = a0, b0 = a0, b1 = a0;
            if (ar < C) { a0 = *(const LAS f32x4*)(Qi + ar * IMG_STRIDE + k); a1 = *(const LAS f32x4*)(Qi + ar * IMG_STRIDE + k + 4); }
            if (br < C) { b0 = *(const LAS f32x4*)(Ki + br * IMG_STRIDE + k); b1 = *(const LAS f32x4*)(Ki + br * IMG_STRIDE + k + 4); }
            acc = MFMA32(pack8(a0[0], a0[1], a0[2], a0[3], a1[0], a1[1], a1[2], a1[3]), pack8(b0[0], b0[1], b0[2], b0[3], b1[0], b1[1], b1[2], b1[3]), acc);
        }
#pragma unroll
        for (int r = 0; r < 16; ++r) { const int i = 32 * mt + crow(r, hh), j = 32 * nt + l31;
            QKM[i * MAT_STRIDE + j] = (i >= j && i < C) ? acc[r] * exp2f((float)(i - j) * lg2) : 0.f; }
    }
    if (C == 64 && wave == 3) {
#pragma unroll
        for (int r = 0; r < 16; ++r) QKM[crow(r, hh) * MAT_STRIDE + 32 + l31] = 0.f;
    }
    lds_barrier();
    constexpr int NF = MT * 8 + MT * KS + 4 * KS + 4 * KS;
    for (int p = tid; p < NF * 64; p += 512) {
        const int f = p >> 6, l = p & 63, lh = l >> 5, ll = l & 31;
        bfx8 o;
        if (f < MT * 8) {
            const int mt = f >> 3, ks = f & 7, t = 32 * mt + ll, k0 = 32 * (ks >> 1) + 16 * (ks & 1) + 4 * lh;
            f32x4 a0 = {0.f, 0.f, 0.f, 0.f}, a1 = a0;
            if (t < C) { const float sc = exp2f((float)(t + 1) * lg2); a0 = *(const LAS f32x4*)(Qi + t * IMG_STRIDE + k0) * sc; a1 = *(const LAS f32x4*)(Qi + t * IMG_STRIDE + k0 + 8) * sc; }
            o = pack8(a0[0], a0[1], a0[2], a0[3], a1[0], a1[1], a1[2], a1[3]);
        } else if (f < MT * 8 + MT * KS) {
            const int g = f - MT * 8, mt = g / KS, ks = g % KS, i = 32 * mt + ll, k0 = 16 * ks + 8 * lh;
            const f32x4 a0 = *(const LAS f32x4*)(QKM + i * MAT_STRIDE + k0), a1 = *(const LAS f32x4*)(QKM + i * MAT_STRIDE + k0 + 4);
            o = pack8(a0[0], a0[1], a0[2], a0[3], a1[0], a1[1], a1[2], a1[3]);
        } else if (f < MT * 8 + MT * KS + 4 * KS) {
            const int g = f - MT * 8 - MT * KS, mt4 = g / KS, ks = g % KS, d = 32 * mt4 + ll, t0 = 16 * ks + 8 * lh;
            float e[8];
#pragma unroll
            for (int j = 0; j < 8; ++j) { const int t = t0 + j; e[j] = t < C ? Ki[t * IMG_STRIDE + d] * exp2f((float)(C - 1 - t) * lg2) : 0.f; }
            o = pack8(e[0], e[1], e[2], e[3], e[4], e[5], e[6], e[7]);
        } else {
            const int g = f - MT * 8 - MT * KS - 4 * KS, s = g / KS, ks = g % KS, dv = 32 * s + ll, t0 = 16 * ks + 8 * lh;
            float e[8];
#pragma unroll
            for (int j = 0; j < 8; ++j) { const int t = t0 + j; e[j] = t < C ? Vi[t * IMG_STRIDE + dv] : 0.f; }
            o = pack8(e[0], e[1], e[2], e[3], e[4], e[5], e[6], e[7]);
        }
        st_frag(frag, f, l, o);
    }
    lds_barrier();
}

__device__ __forceinline__ void ret_stream(const Frame& F, int b, int h, const unsigned char* frag0, bf16* proj, const float* ret_norm_w, float* out) {
    const int lane = F.lane, wave = F.wave, hh = lane >> 5, l31 = lane & 31;
    constexpr int NC = 32;
    const float cd = exp2f(64.f * log2f(1.f - exp2f(-5.f - (float)h)));
    if (wave < 4) {
        const int s = wave;
        f32x16 R[4];
#pragma unroll
        for (int t = 0; t < 4; ++t)
#pragma unroll
            for (int r = 0; r < 16; ++r) R[t][r] = 0.f;
        for (int c = 0; c < NC; ++c) {
            lds_barrier();
            const LAS unsigned char* slot = F.lds + (c & 1) * SLOT_BYTES + lane * 16;
            LAS unsigned char* ob = F.lds + OBUF_OFF + (c & 1) * OBUF_BYTES;
            f32x16 accO[2];
#pragma unroll
            for (int mt = 0; mt < 2; ++mt)
#pragma unroll
                for (int r = 0; r < 16; ++r) accO[mt][r] = 0.f;
#pragma unroll
            for (int ks = 0; ks < 8; ++ks) {
                const bfx8 rb = (ks & 1) ? PACK_STEP(R[ks >> 1], 1) : PACK_STEP(R[ks >> 1], 0);
#pragma unroll
                for (int mt = 0; mt < 2; ++mt) accO[mt] = MFMA32(*(const LAS bfx8*)(slot + (mt * 8 + ks) * 1024), rb, accO[mt]);
            }
            bfx8 vt[4];
#pragma unroll
            for (int ks = 0; ks < 4; ++ks) vt[ks] = *(const LAS bfx8*)(slot + (40 + s * 4 + ks) * 1024);
#pragma unroll
            for (int ks = 0; ks < 4; ++ks)
#pragma unroll
                for (int mt = 0; mt < 2; ++mt) accO[mt] = MFMA32(*(const LAS bfx8*)(slot + (16 + mt * 4 + ks) * 1024), vt[ks], accO[mt]);
#pragma unroll
            for (int t = 0; t < 4; ++t) {
                R[t] = R[t] * cd;
#pragma unroll
                for (int ks = 0; ks < 4; ++ks) R[t] = MFMA32(*(const LAS bfx8*)(slot + (24 + t * 4 + ks) * 1024), vt[ks], R[t]);
            }
#pragma unroll
            for (int mt = 0; mt < 2; ++mt)
#pragma unroll
                for (int r = 0; r < 16; ++r) *(LAS bf16*)(ob + (32 * mt + crow(r, hh)) * OBUF_STRIDE + (32 * s + l31) * 2) = f2bf(accO[mt][r]);
        }
        lds_barrier();
        float* so = out + O_RET_P + (size_t)(b * 4 + h) * 16384;
#pragma unroll
        for (int t = 0; t < 4; ++t)
#pragma unroll
            for (int r = 0; r < 16; ++r) so[(unsigned)((32 * t + crow(r, hh)) * 128 + 32 * s + l31)] = R[t][r];
    } else {
        const int hw = wave - 4, part = lane >> 4, tok = 16 * hw + (lane & 15);
        float nw[32];
#pragma unroll
        for (int e = 0; e < 32; ++e) nw[e] = ret_norm_w[h * 128 + part * 32 + e];
        { const unsigned char* src = frag0;
#pragma unroll
          for (int i = 0; i < 14; ++i) { const int f = hw + 4 * i;
              __builtin_amdgcn_global_load_lds((const unsigned*)(src + (size_t)f * 1024 + lane * 16), (LAS unsigned*)(F.lds + f * 1024), 16, 0, 0); } }
        VM_WAIT();
        v4u gz[4], gn[4];
#pragma unroll
        for (int q = 0; q < 4; ++q) gz[q] = gn[q] = (v4u){0u, 0u, 0u, 0u};
        for (int c = 0; c <= NC; ++c) {
            lds_barrier();
#pragma unroll
            for (int q = 0; q < 4; ++q) { gz[q] = gn[q]; asm volatile("" : "+v"(gz[q])); }
            if (c + 1 < NC) {
                const unsigned char* src = frag0 + (size_t)(c + 1) * RET_FRAG_P; LAS unsigned char* dst = F.lds + ((c + 1) & 1) * SLOT_BYTES;
#pragma unroll
                for (int i = 0; i < 14; ++i) { const int f = hw + 4 * i;
                    __builtin_amdgcn_global_load_lds((const unsigned*)(src + (size_t)f * 1024 + lane * 16), (LAS unsigned*)(dst + f * 1024), 16, 0, 0); }
            }
            if (c < NC) {
                const bf16* gpn = proj + ((size_t)b * SEQ + (size_t)c * 64 + tok) * NPROJ + 3584 + h * 128 + part * 32;
#pragma unroll
                for (int q = 0; q < 4; ++q) gn[q] = *(const v4u*)(gpn + 8 * q);
            }
            if (c >= 1) {
                const int cc = c - 1;
                const LAS unsigned char* ob = F.lds + OBUF_OFF + (cc & 1) * OBUF_BYTES + tok * OBUF_STRIDE + part * 64;
                float o[32];
#pragma unroll
                for (int q = 0; q < 4; ++q) bf8_to_f32(*(const LAS v4u*)(ob + q * 16), o + 8 * q);
                float sm = 0.f;
#pragma unroll
                for (int e = 0; e < 32; ++e) sm += o[e];
                sm += __shfl_xor(sm, 16); sm += __shfl_xor(sm, 32);
                const float mu = sm * (1.f / 128.f); float vs = 0.f;
#pragma unroll
                for (int e = 0; e < 32; ++e) { o[e] -= mu; vs += o[e] * o[e]; }
                vs += __shfl_xor(vs, 16); vs += __shfl_xor(vs, 32);
                const float rstd = rsqrtf(vs * (1.f / 128.f) + EPS);
                bf16* gp = proj + ((size_t)b * SEQ + (size_t)cc * 64 + tok) * NPROJ + 512 + h * 128 + part * 32;
#pragma unroll
                for (int q = 0; q < 4; ++q) {
                    float g[8]; bf8_to_f32(gz[q], g);
                    float y[8];
#pragma unroll
                    for (int e = 0; e < 8; ++e) y[e] = o[8 * q + e] * rstd * nw[8 * q + e] * silu_f(g[e]);
                    v4u w; w.x = pk2(y[0], y[1]); w.y = pk2(y[2], y[3]); w.z = pk2(y[4], y[5]); w.w = pk2(y[6], y[7]);
                    *(v4u*)(gp + 8 * q) = w;
                }
            }
            VM_WAIT();
        }
    }
}

__device__ __forceinline__ void ret_sample_item(const Frame& F, bool active, int b, int h, const unsigned char* frag, bf16* proj, const float* ret_norm_w, const float* st_ret, float* out) {
    int lane = F.lane; asm volatile("" : "+v"(lane));
    const int wave = F.wave, s = wave & 3, team = wave >> 2, hh = lane >> 5, l31 = lane & 31;
    LAS float* xch = (LAS float*)(F.lds) + team * 64;
    f32x16 R[4]; f32x16 accO;
    if (active) {
        const float* sp = st_ret + (size_t)(b * 4 + h) * 16384;
#pragma unroll
        for (int t = 0; t < 4; ++t)
#pragma unroll
            for (int r = 0; r < 16; ++r) R[t][r] = sp[(unsigned)((32 * t + crow(r, hh)) * 128 + 32 * s + l31)];
        const unsigned char* fb = frag + lane * 16;
#pragma unroll
        for (int r = 0; r < 16; ++r) accO[r] = 0.f;
#pragma unroll
        for (int ks = 0; ks < 8; ++ks) {
            const bfx8 rb = (ks & 1) ? PACK_STEP(R[ks >> 1], 1) : PACK_STEP(R[ks >> 1], 0);
            accO = MFMA32(*(const bfx8*)(fb + ks * 1024), rb, accO);
        }
        const bfx8 vt = *(const bfx8*)(fb + (13 + s) * 1024);
        accO = MFMA32(*(const bfx8*)(fb + 8 * 1024), vt, accO);
        const float cd = exp2f(8.f * log2f(1.f - exp2f(-5.f - (float)h)));
#pragma unroll
        for (int t = 0; t < 4; ++t) { R[t] = R[t] * cd; R[t] = MFMA32(*(const bfx8*)(fb + (9 + t) * 1024), vt, R[t]); }
#pragma unroll
        for (int r = 0; r < 4; ++r) {
            float sm = accO[r], sq = accO[r] * accO[r];
#pragma unroll
            for (int o = 1; o < 32; o <<= 1) { sm += shfl_xor_l(sm, o, lane); sq += shfl_xor_l(sq, o, lane); }
            if (l31 == 0) { xch[((4 * hh + r) * 4 + s) * 2] = sm; xch[((4 * hh + r) * 4 + s) * 2 + 1] = sq; }
        }
    }
    __syncthreads();
    if (active) {
#pragma unroll
        for (int r = 0; r < 4; ++r) {
            const int tok = 4 * hh + r; float sm = 0.f, sq = 0.f;
#pragma unroll
            for (int q = 0; q < 4; ++q) { sm += xch[(tok * 4 + q) * 2]; sq += xch[(tok * 4 + q) * 2 + 1]; }
            const float mu = sm * (1.f / 128.f), var = fmaxf(sq * (1.f / 128.f) - mu * mu, 0.f);
            bf16* gp = proj + ((size_t)TP + (size_t)b * DSEQ + tok) * NPROJ + 3584 + h * 128 + 32 * s + l31;
            const float g = bf2f(*gp);
            *(gp - 3072) = f2bf((accO[r] - mu) * rsqrtf(var + EPS) * ret_norm_w[h * 128 + 32 * s + l31] * silu_f(g));
        }
        float* so = out + O_RET_S + (size_t)(b * 4 + h) * 16384;
#pragma unroll
        for (int t = 0; t < 4; ++t)
#pragma unroll
            for (int r = 0; r < 16; ++r) so[(unsigned)((32 * t + crow(r, hh)) * 128 + 32 * s + l31)] = R[t][r];
    }
    __syncthreads();
}

constexpr int DN_FRAG_P = 72 * 1024, DN_FRAG_S = 29 * 1024;
constexpr int VEC_OFF = 3 * IMG_BYTES + 2 * MAT_BYTES;
template <int C>
__device__ __forceinline__ void dn_prep_item(const Frame& F, bool prompt, int b, int h, int chunk, const bf16* proj, const float* gb, const float* conv_w, const float* st_conv,
                                             unsigned char* frag, float* glast, float* out) {
    constexpr int MT = C == 64 ? 2 : 1, KS = C == 64 ? 4 : 1, TQ = C == 64 ? 16 : 8, NQ = C / TQ;
    LAS float* Qi = (LAS float*)(F.lds); LAS float* Ki = (LAS float*)(F.lds + IMG_BYTES); LAS float* Vi = (LAS float*)(F.lds + 2 * IMG_BYTES);
    LAS float* AM = (LAS float*)(F.lds + 3 * IMG_BYTES); LAS float* QKM = (LAS float*)(F.lds + 3 * IMG_BYTES + MAT_BYTES);
    LAS float* gcv = (LAS float*)(F.lds + VEC_OFF); LAS float* betav = gcv + 64; LAS float* egv = gcv + 128;
    int tid = F.tid; asm volatile("" : "+v"(tid));
    const int lane = tid & 63, wave = F.wave, hh = lane >> 5, l31 = lane & 31;
    const size_t row0 = prompt ? (size_t)b * SEQ + (size_t)chunk * 64 : (size_t)TP + (size_t)b * DSEQ;
    if (tid < 96 * NQ) {
        const int cgi = tid % 96, tq = tid / 96, which = cgi >> 5, c4 = (cgi & 31) * 4, col = which * 512 + h * 128 + c4, t0 = tq * TQ;
        f32x4 w[4];
#pragma unroll
        for (int j = 0; j < 4; ++j) w[j] = *(const f32x4*)(conv_w + j * 1536 + col);
        f32x4 x0, x1, x2;
        if (t0 == 0 && chunk == 0) {
            if (prompt) { x0 = (f32x4){0.f, 0.f, 0.f, 0.f}; x1 = x0; x2 = x0; }
            else { const float* sp = st_conv + (size_t)b * 3 * 1536 + col; x0 = *(const f32x4*)sp; x1 = *(const f32x4*)(sp + 1536); x2 = *(const f32x4*)(sp + 2 * 1536); }
        } else {
            const bf16* pp = proj + (row0 + t0 - 3) * NPROJ + col;
            const uint2 a = *(const uint2*)pp, bq = *(const uint2*)(pp + NPROJ), cq = *(const uint2*)(pp + 2 * NPROJ);
            x0 = (f32x4){__uint_as_float(a.x << 16), __uint_as_float(a.x & 0xffff0000u), __uint_as_float(a.y << 16), __uint_as_float(a.y & 0xffff0000u)};
            x1 = (f32x4){__uint_as_float(bq.x << 16), __uint_as_float(bq.x & 0xffff0000u), __uint_as_float(bq.y << 16), __uint_as_float(bq.y & 0xffff0000u)};
            x2 = (f32x4){__uint_as_float(cq.x << 16), __uint_as_float(cq.x & 0xffff0000u), __uint_as_float(cq.y << 16), __uint_as_float(cq.y & 0xffff0000u)};
        }
        LAS float* img = (which == 0 ? Qi : (which == 1 ? Ki : Vi));
        uint2 raw[TQ];
#pragma unroll
        for (int i = 0; i < TQ; ++i) raw[i] = *(const uint2*)(proj + (row0 + t0 + i) * NPROJ + col);
#pragma unroll
        for (int i = 0; i < TQ; ++i) {
            const uint2 a = raw[i];
            const f32x4 x3 = {__uint_as_float(a.x << 16), __uint_as_float(a.x & 0xffff0000u), __uint_as_float(a.y << 16), __uint_as_float(a.y & 0xffff0000u)};
            const f32x4 y = w[0] * x0 + w[1] * x1 + w[2] * x2 + w[3] * x3;
            f32x4 o;
#pragma unroll
            for (int e = 0; e < 4; ++e) o[e] = silu_f(y[e]);
            *(LAS f32x4*)(img + (t0 + i) * IMG_STRIDE + c4) = o;
            x0 = x1; x1 = x2; x2 = x3;
        }
        if ((prompt && chunk == 31 && tq == NQ - 1) || !prompt) {
            float* co = out + (prompt ? O_DNCONV_P : O_DNCONV_S) + (size_t)b * 3 * 1536 + col;
            *(f32x4*)co = x0; *(f32x4*)(co + 1536) = x1; *(f32x4*)(co + 2 * 1536) = x2;
        }
    }
    lds_barrier();
    if (tid < C * 8) {
        const int tok = tid >> 3, part = tid & 7;
        LAS float* qp = Qi + tok * IMG_STRIDE + part * 16; LAS float* kp = Ki + tok * IMG_STRIDE + part * 16;
        f32x4 q[4], k[4]; float sq = 0.f, sk = 0.f;
#pragma unroll
        for (int i = 0; i < 4; ++i) { q[i] = *(LAS f32x4*)(qp + 4 * i); k[i] = *(LAS f32x4*)(kp + 4 * i);
            sq += q[i][0] * q[i][0] + q[i][1] * q[i][1] + q[i][2] * q[i][2] + q[i][3] * q[i][3]; sk += k[i][0] * k[i][0] + k[i][1] * k[i][1] + k[i][2] * k[i][2] + k[i][3] * k[i][3]; }
        sq += __shfl_xor(sq, 1); sq += __shfl_xor(sq, 2); sq += __shfl_xor(sq, 4);
        sk += __shfl_xor(sk, 1); sk += __shfl_xor(sk, 2); sk += __shfl_xor(sk, 4);
        const float rq = rsqrtf(sq + EPS) * 0.08838834764831845f, rk = rsqrtf(sk + EPS);
#pragma unroll
        for (int i = 0; i < 4; ++i) { *(LAS f32x4*)(qp + 4 * i) = q[i] * rq; *(LAS f32x4*)(kp + 4 * i) = k[i] * rk; }
    }
    if (wave == 7) {
        float g = lane < C ? gb[(row0 + lane) * 8 + 4 + h] : 0.f;
#pragma unroll
        for (int o = 1; o < 64; o <<= 1) { const float t = __shfl_up(g, o); if (lane >= o) g += t; }
        if (lane < C) { gcv[lane] = g; egv[lane] = __expf(g); betav[lane] = gb[(row0 + lane) * 8 + h]; }
        else { gcv[lane] = 0.f; egv[lane] = 0.f; betav[lane] = 0.f; }
    }
    lds_barrier();
    {
        constexpr int NTL = C == 64 ? 3 : 1;
        if (wave < 2 * NTL) {
            const int kind = wave / NTL, ti = wave % NTL, mt = ti == 0 ? 0 : 1, nt = ti == 2 ? 1 : 0;
            const int ar = 32 * mt + l31, br = 32 * nt + l31;
            const LAS float* Ai = kind == 0 ? Ki : Qi;
            f32x16 acc;
#pragma unroll
            for (int r = 0; r < 16; ++r) acc[r] = 0.f;
#pragma unroll
            for (int ks = 0; ks < 8; ++ks) {
                const int k = 16 * ks + 8 * hh;
                f32x4 a0 = {0.f, 0.f, 0.f, 0.f}, a1 = a0, b0 = a0, b1 = a0;
                if (ar < C) { a0 = *(const LAS f32x4*)(Ai + ar * IMG_STRIDE + k); a1 = *(const LAS f32x4*)(Ai + ar * IMG_STRIDE + k + 4); }
                if (br < C) { b0 = *(const LAS f32x4*)(Ki + br * IMG_STRIDE + k); b1 = *(const LAS f32x4*)(Ki + br * IMG_STRIDE + k + 4); }
                acc = MFMA32(pack8(a0[0], a0[1], a0[2], a0[3], a1[0], a1[1], a1[2], a1[3]), pack8(b0[0], b0[1], b0[2], b0[3], b1[0], b1[1], b1[2], b1[3]), acc);
            }
            LAS float* M = kind == 0 ? AM : QKM;
            const int j = 32 * nt + l31; const float gj = gcv[j];
#pragma unroll
            for (int r = 0; r < 16; ++r) { const int i = 32 * mt + crow(r, hh);
                const bool keep = (kind == 0 ? i > j : i >= j) && i < C;
                float v = 0.f;
                if (keep) v = acc[r] * __expf(gcv[i] - gj) * (kind == 0 ? betav[i] : 1.f);
                M[i * MAT_STRIDE + j] = v; }
        } else if (C == 64) {
            LAS float* M = wave == 6 ? AM : QKM;
#pragma unroll
            for (int r = 0; r < 16; ++r) M[crow(r, hh) * MAT_STRIDE + 32 + l31] = 0.f;
        }
    }
    {
        constexpr int F_KT = 2 * MT * 8 + MT * KS;
        const float gl = gcv[C - 1];
        for (int p = tid; p < 4 * KS * 64; p += 512) {
            const int g = p >> 6, l = p & 63, lh = l >> 5, ll = l & 31, mt4 = g / KS, ks = g % KS, d = 32 * mt4 + ll, k0 = 32 * (ks >> 1) + 16 * (ks & 1) + 4 * lh;
            float e[8];
#pragma unroll
            for (int j = 0; j < 8; ++j) { const int t = k0 + (j & 3) + 8 * (j >> 2); e[j] = t < C ? Ki[t * IMG_STRIDE + d] * __expf(gl - gcv[t]) : 0.f; }
            st_frag(frag, F_KT + g, l, pack8(e[0], e[1], e[2], e[3], e[4], e[5], e[6], e[7]));
        }
    }
    lds_barrier();
    constexpr int BS = C == 64 ? 16 : 8, NBK = C / BS;
    LAS float* DB = (LAS float*)(F.lds + VEC_OFF + 768);
    LAS float* GB = (LAS float*)(F.lds + VEC_OFF + 768 + 4096);
    LAS float* NM = QKM;
    {
        constexpr int F_QD = MT * 8, F_QK = 2 * MT * 8, NFH = MT * 8 + MT * KS;
        for (int p = tid; p < NFH * 64; p += 512) {
            const int fi = p >> 6, l = p & 63, lh = l >> 5, ll = l & 31;
            bfx8 o; int f;
            if (fi < MT * 8) {
                const int mt = fi >> 3, ks = fi & 7, t = 32 * mt + ll, k0 = 32 * (ks >> 1) + 16 * (ks & 1) + 4 * lh;
                f32x4 a0 = {0.f, 0.f, 0.f, 0.f}, a1 = a0;
                if (t < C) { const float sc = egv[t]; a0 = *(const LAS f32x4*)(Qi + t * IMG_STRIDE + k0) * sc; a1 = *(const LAS f32x4*)(Qi + t * IMG_STRIDE + k0 + 8) * sc; }
                o = pack8(a0[0], a0[1], a0[2], a0[3], a1[0], a1[1], a1[2], a1[3]); f = F_QD + fi;
            } else {
                const int gq = fi - MT * 8, mt = gq / KS, ks = gq % KS, i = 32 * mt + ll, k0 = 32 * (ks >> 1) + 16 * (ks & 1) + 4 * lh;
                const f32x4 a0 = *(const LAS f32x4*)(QKM + i * MAT_STRIDE + k0), a1 = *(const LAS f32x4*)(QKM + i * MAT_STRIDE + k0 + 8);
                o = pack8(a0[0], a0[1], a0[2], a0[3], a1[0], a1[1], a1[2], a1[3]); f = F_QK + gq;
            }
            st_frag(frag, f, l, o);
        }
        if (wave == 0) {
            const int blk = (lane / BS) < NBK ? (lane / BS) : (NBK - 1), c = lane % BS, r0 = blk * BS;
            float y[BS];
#pragma unroll
            for (int r = 0; r < BS; ++r) {
                float a0 = (r == c) ? 1.f : 0.f, a1 = 0.f, a2 = 0.f, a3 = 0.f;
#pragma unroll
                for (int q = 0; q < (r + 3) / 4; ++q) {
                    const f32x4 av = *(const LAS f32x4*)(AM + (r0 + r) * MAT_STRIDE + r0 + 4 * q);
                    a0 -= av[0] * y[4 * q];
                    if (4 * q + 1 < r) a1 -= av[1] * y[4 * q + 1];
                    if (4 * q + 2 < r) a2 -= av[2] * y[4 * q + 2];
                    if (4 * q + 3 < r) a3 -= av[3] * y[4 * q + 3];
                }
                y[r] = (a0 + a1) + (a2 + a3);
            }
#pragma unroll
            for (int r = 0; r < BS; ++r) if (lane < NBK * BS) DB[(blk * BS + r) * 16 + c] = y[r];
        }
    }
    lds_barrier();
    if (C == 64) {
        for (int idx = tid; idx < 1536; idx += 512) {
            int i, r, c; if (idx < 256) { i = 1; r = idx >> 4; c = idx & 15; } else if (idx < 768) { const int j = idx - 256; i = 2; r = j >> 5; c = j & 31; } else { const int j = idx - 768; i = 3; r = j / 48; c = j - r * 48; }
            float s = 0.f;
#pragma unroll
            for (int m = 0; m < 16; ++m) s -= DB[(i * 16 + r) * 16 + m] * AM[(16 * i + m) * MAT_STRIDE + c];
            GB[(16 * i + r) * MAT_STRIDE + c] = s;
        }
    }
    for (int e = tid; e < 64 * 64; e += 512) {
        const int i = e >> 6, j = e & 63, bi = i / BS, bj = j / BS;
        if (i < C && j < C) { if (bi == bj) NM[i * MAT_STRIDE + j] = DB[i * 16 + (j - bj * BS)] - (i == j ? 1.f : 0.f); else if (bi < bj) NM[i * MAT_STRIDE + j] = 0.f; }
        else if (i < 32 && j < 16) NM[i * MAT_STRIDE + j] = 0.f;
    }
    lds_barrier();
    if (C == 64) {
        for (int idx = tid; idx < 768; idx += 512) {
            const int i = (idx >> 8) + 1, r = (idx >> 4) & 15, c = idx & 15; float s = 0.f;
#pragma unroll
            for (int m = 0; m < 16; ++m) s += GB[(16 * i + r) * MAT_STRIDE + 16 * (i - 1) + m] * DB[((i - 1) * 16 + m) * 16 + c];
            NM[(16 * i + r) * MAT_STRIDE + 16 * (i - 1) + c] = s;
        }
        lds_barrier();
        {
            const int i = (tid >> 8) + 2, r = (tid >> 4) & 15, c = tid & 15; float s = 0.f;
#pragma unroll
            for (int m = 0; m < 16; ++m) s += GB[(16 * i + r) * MAT_STRIDE + 16 * (i - 2) + m] * DB[((i - 2) * 16 + m) * 16 + c]
                                            + GB[(16 * i + r) * MAT_STRIDE + 16 * (i - 1) + m] * NM[(16 * (i - 1) + m) * MAT_STRIDE + 16 * (i - 2) + c];
            NM[(16 * i + r) * MAT_STRIDE + 16 * (i - 2) + c] = s;
        }
        lds_barrier();
        if (tid < 256) {
            const int r = tid >> 4, c = tid & 15; float s = 0.f;
#pragma unroll
            for (int m = 0; m < 16; ++m) s += GB[(48 + r) * MAT_STRIDE + m] * DB[m * 16 + c] + GB[(48 + r) * MAT_STRIDE + 16 + m] * NM[(16 + m) * MAT_STRIDE + c]
                                            + GB[(48 + r) * MAT_STRIDE + 32 + m] * NM[(32 + m) * MAT_STRIDE + c];
            NM[(48 + r) * MAT_STRIDE + c] = s;
        }
        lds_barrier();
    }
    {
        const bool isw = wave >= 4; const int colb = 32 * (wave & 3) + l31;
        const LAS float* img = (isw ? Ki : Vi) + colb;
        f32x16 acc[MT];
#pragma unroll
        for (int mt = 0; mt < MT; ++mt)
#pragma unroll
            for (int r = 0; r < 16; ++r) { const int t = 32 * mt + crow(r, hh); acc[mt][r] = t < C ? img[t * IMG_STRIDE] * betav[t] * (isw ? egv[t] : 1.f) : 0.f; }
#pragma unroll
        for (int ks = 0; ks < KS; ++ks) {
            float e[8];
#pragma unroll
            for (int j = 0; j < 8; ++j) { const int t = 16 * ks + 8 * hh + j; e[j] = t < C ? img[t * IMG_STRIDE] * betav[t] * (isw ? egv[t] : 1.f) : 0.f; }
            const bfx8 bf = pack8(e[0], e[1], e[2], e[3], e[4], e[5], e[6], e[7]);
#pragma unroll
            for (int mt = 0; mt < MT; ++mt) {
                const LAS float* np = NM + (32 * mt + l31) * MAT_STRIDE + 16 * ks + 8 * hh;
                const f32x4 a0 = *(const LAS f32x4*)np, a1 = *(const LAS f32x4*)(np + 4);
                acc[mt] = MFMA32(pack8(a0[0], a0[1], a0[2], a0[3], a1[0], a1[1], a1[2], a1[3]), bf, acc[mt]);
            }
        }
        if (!isw) {
            constexpr int F_U = 2 * MT * 8 + MT * KS + 4 * KS;
#pragma unroll
            for (int mt = 0; mt < MT; ++mt) {
                st_frag(frag, F_U + (wave * MT + mt) * 2, lane, PACK_STEP(acc[mt], 0));
                st_frag(frag, F_U + (wave * MT + mt) * 2 + 1, lane, PACK_STEP(acc[mt], 1));
            }
        } else {
            LAS float* kw = Ki + colb;
#pragma unroll
            for (int mt = 0; mt < MT; ++mt)
#pragma unroll
                for (int r = 0; r < 16; ++r) { const int t = 32 * mt + crow(r, hh); if (t < C) kw[t * IMG_STRIDE] = -acc[mt][r]; }
        }
    }
    lds_barrier();
    {
        for (int p = tid; p < MT * 8 * 64; p += 512) {
            const int fi = p >> 6, l = p & 63, lh = l >> 5, ll = l & 31;
            const int mt = fi >> 3, ks = fi & 7, t = 32 * mt + ll, k0 = 32 * (ks >> 1) + 16 * (ks & 1) + 4 * lh;
            f32x4 a0 = {0.f, 0.f, 0.f, 0.f}, a1 = a0;
            if (t < C) { a0 = *(const LAS f32x4*)(Ki + t * IMG_STRIDE + k0); a1 = *(const LAS f32x4*)(Ki + t * IMG_STRIDE + k0 + 8); }
            st_frag(frag, fi, l, pack8(a0[0], a0[1], a0[2], a0[3], a1[0], a1[1], a1[2], a1[3]));
        }
        if (tid == 0) *glast = egv[C - 1];
    }
    lds_barrier();
}

__device__ __forceinline__ void dn_stream(const Frame& F, int b, int h, const unsigned char* frag_lo, const unsigned char* frag_hi, int split,
                                          const float* glast, bf16* proj, const float* dn_norm_w, float* out) {
    const int lane = F.lane, wave = F.wave, hh = lane >> 5, l31 = lane & 31;
    constexpr int NC = 32;
    const int it0 = (b * 4 + h) * 32;
#define DN_ITEM_PTR(c) (((it0 + (c)) < split) ? frag_lo + (size_t)(it0 + (c)) * DN_FRAG_P : frag_hi + (size_t)(it0 + (c) - split) * DN_FRAG_P)
    if (wave < 4) {
        const int s = wave;
        f32x16 S[4];
#pragma unroll
        for (int t = 0; t < 4; ++t)
#pragma unroll
            for (int r = 0; r < 16; ++r) S[t][r] = 0.f;
        v4u un[4]; float decn;
        { const unsigned char* ub = DN_ITEM_PTR(0) + (size_t)(56 + s * 4) * 1024 + lane * 16;
#pragma unroll
          for (int i = 0; i < 4; ++i) un[i] = *(const v4u*)(ub + i * 1024);
          decn = glast[it0]; }
        for (int c = 0; c < NC; ++c) {
            v4u uc[4]; float dec = decn;
#pragma unroll
            for (int i = 0; i < 4; ++i) uc[i] = un[i];
            lds_barrier();
            if (c + 1 < NC) {
                const unsigned char* ub = DN_ITEM_PTR(c + 1) + (size_t)(56 + s * 4) * 1024 + lane * 16;
#pragma unroll
                for (int i = 0; i < 4; ++i) un[i] = *(const v4u*)(ub + i * 1024);
                decn = glast[it0 + c + 1];
            }
            const LAS unsigned char* slot = F.lds + (c & 1) * SLOT_BYTES + lane * 16;
            LAS unsigned char* ob = F.lds + OBUF_OFF + (c & 1) * OBUF_BYTES;
            f32x16 accV[2], accO[2];
            { float t8[8];
              bf8_to_f32(uc[0], t8);
#pragma unroll
              for (int e = 0; e < 8; ++e) accV[0][e] = t8[e];
              bf8_to_f32(uc[1], t8);
#pragma unroll
              for (int e = 0; e < 8; ++e) accV[0][8 + e] = t8[e];
              bf8_to_f32(uc[2], t8);
#pragma unroll
              for (int e = 0; e < 8; ++e) accV[1][e] = t8[e];
              bf8_to_f32(uc[3], t8);
#pragma unroll
              for (int e = 0; e < 8; ++e) accV[1][8 + e] = t8[e]; }
#pragma unroll
            for (int mt = 0; mt < 2; ++mt)
#pragma unroll
                for (int r = 0; r < 16; ++r) accO[mt][r] = 0.f;
#pragma unroll
            for (int ks = 0; ks < 8; ++ks) {
                const bfx8 sb = (ks & 1) ? PACK_STEP(S[ks >> 1], 1) : PACK_STEP(S[ks >> 1], 0);
#pragma unroll
                for (int mt = 0; mt < 2; ++mt) {
                    accV[mt] = MFMA32(*(const LAS bfx8*)(slot + (mt * 8 + ks) * 1024), sb, accV[mt]);
                    accO[mt] = MFMA32(*(const LAS bfx8*)(slot + (16 + mt * 8 + ks) * 1024), sb, accO[mt]);
                }
                if (ks & 1) asm volatile("" ::: "memory");
            }
            bfx8 vb[4];
            vb[0] = PACK_STEP(accV[0], 0); vb[1] = PACK_STEP(accV[0], 1); vb[2] = PACK_STEP(accV[1], 0); vb[3] = PACK_STEP(accV[1], 1);
#pragma unroll
            for (int ks = 0; ks < 4; ++ks)
#pragma unroll
                for (int mt = 0; mt < 2; ++mt) accO[mt] = MFMA32(*(const LAS bfx8*)(slot + (32 + mt * 4 + ks) * 1024), vb[ks], accO[mt]);
#pragma unroll
            for (int t = 0; t < 4; ++t) {
                S[t] = S[t] * dec;
#pragma unroll
                for (int ks = 0; ks < 4; ++ks) S[t] = MFMA32(*(const LAS bfx8*)(slot + (40 + t * 4 + ks) * 1024), vb[ks], S[t]);
            }
#pragma unroll
            for (int mt = 0; mt < 2; ++mt)
#pragma unroll
                for (int r = 0; r < 16; ++r) *(LAS bf16*)(ob + (32 * mt + crow(r, hh)) * OBUF_STRIDE + (32 * s + l31) * 2) = f2bf(accO[mt][r]);
        }
        lds_barrier();
        float* so = out + O_DN_P + (size_t)(b * 4 + h) * 16384;
#pragma unroll
        for (int t = 0; t < 4; ++t)
#pragma unroll
            for (int r = 0; r < 16; ++r) so[(unsigned)((32 * t + crow(r, hh)) * 128 + 32 * s + l31)] = S[t][r];
    } else {
        const int hw = wave - 4, part = lane >> 4, tok = 16 * hw + (lane & 15);
        float nw[32];
#pragma unroll
        for (int e = 0; e < 32; ++e) nw[e] = dn_norm_w[part * 32 + e];
        { const unsigned char* src = DN_ITEM_PTR(0);
#pragma unroll
          for (int i = 0; i < 14; ++i) { const int f = hw + 4 * i;
              __builtin_amdgcn_global_load_lds((const unsigned*)(src + (size_t)f * 1024 + lane * 16), (LAS unsigned*)(F.lds + f * 1024), 16, 0, 0); } }
        VM_WAIT();
        v4u gz[4], gn[4];
#pragma unroll
        for (int q = 0; q < 4; ++q) gz[q] = gn[q] = (v4u){0u, 0u, 0u, 0u};
        for (int c = 0; c <= NC; ++c) {
            lds_barrier();
#pragma unroll
            for (int q = 0; q < 4; ++q) { gz[q] = gn[q]; asm volatile("" : "+v"(gz[q])); }
            if (c + 1 < NC) {
                const unsigned char* src = DN_ITEM_PTR(c + 1); LAS unsigned char* dst = F.lds + ((c + 1) & 1) * SLOT_BYTES;
#pragma unroll
                for (int i = 0; i < 14; ++i) { const int f = hw + 4 * i;
                    __builtin_amdgcn_global_load_lds((const unsigned*)(src + (size_t)f * 1024 + lane * 16), (LAS unsigned*)(dst + f * 1024), 16, 0, 0); }
            }
            if (c < NC) {
                const bf16* gpn = proj + ((size_t)b * SEQ + (size_t)c * 64 + tok) * NPROJ + 3072 + h * 128 + part * 32;
#pragma unroll
                for (int q = 0; q < 4; ++q) gn[q] = *(const v4u*)(gpn + 8 * q);
            }
            if (c >= 1) {
                const int cc = c - 1;
                const LAS unsigned char* ob = F.lds + OBUF_OFF + (cc & 1) * OBUF_BYTES + tok * OBUF_STRIDE + part * 64;
                float o[32];
#pragma unroll
                for (int q = 0; q < 4; ++q) bf8_to_f32(*(const LAS v4u*)(ob + q * 16), o + 8 * q);
                float vs = 0.f;
#pragma unroll
                for (int e = 0; e < 32; ++e) vs += o[e] * o[e];
                vs += __shfl_xor(vs, 16); vs += __shfl_xor(vs, 32);
                const float rstd = rsqrtf(vs * (1.f / 128.f) + EPS);
                bf16* gp = proj + ((size_t)b * SEQ + (size_t)cc * 64 + tok) * NPROJ + h * 128 + part * 32;
#pragma unroll
                for (int q = 0; q < 4; ++q) {
                    float g[8]; bf8_to_f32(gz[q], g);
                    float y[8];
#pragma unroll
                    for (int e = 0; e < 8; ++e) y[e] = o[8 * q + e] * rstd * nw[8 * q + e] * silu_f(g[e]);
                    v4u w; w.x = pk2(y[0], y[1]); w.y = pk2(y[2], y[3]); w.z = pk2(y[4], y[5]); w.w = pk2(y[6], y[7]);
                    *(v4u*)(gp + 8 * q) = w;
                }
            }
            VM_WAIT();
        }
    }
#undef DN_ITEM_PTR
}

__device__ __forceinline__ void dn_sample_item(const Frame& F, bool active, int b, int h, const unsigned char* frag, float dec, bf16* proj, const float* dn_norm_w, const float* st_dn, float* out) {
    int lane = F.lane; asm volatile("" : "+v"(lane));
    const int wave = F.wave, s = wave & 3, team = wave >> 2, hh = lane >> 5, l31 = lane & 31;
    LAS float* xch = (LAS float*)(F.lds) + team * 64;
    f32x16 S[4]; f32x16 accO;
    if (active) {
        const float* sp = st_dn + (size_t)(b * 4 + h) * 16384;
#pragma unroll
        for (int t = 0; t < 4; ++t)
#pragma unroll
            for (int r = 0; r < 16; ++r) S[t][r] = sp[(unsigned)((32 * t + crow(r, hh)) * 128 + 32 * s + l31)];
        const unsigned char* fb = frag + lane * 16;
        f32x16 accV;
        { const v4u u0 = *(const v4u*)(fb + (21 + s * 2) * 1024), u1 = *(const v4u*)(fb + (22 + s * 2) * 1024); float t8[8];
          bf8_to_f32(u0, t8);
#pragma unroll
          for (int e = 0; e < 8; ++e) accV[e] = t8[e];
          bf8_to_f32(u1, t8);
#pragma unroll
          for (int e = 0; e < 8; ++e) accV[8 + e] = t8[e]; }
#pragma unroll
        for (int r = 0; r < 16; ++r) accO[r] = 0.f;
#pragma unroll
        for (int ks = 0; ks < 8; ++ks) {
            const bfx8 sb = (ks & 1) ? PACK_STEP(S[ks >> 1], 1) : PACK_STEP(S[ks >> 1], 0);
            accV = MFMA32(*(const bfx8*)(fb + ks * 1024), sb, accV);
            accO = MFMA32(*(const bfx8*)(fb + (8 + ks) * 1024), sb, accO);
        }
        const bfx8 vb = PACK_STEP(accV, 0);
        accO = MFMA32(*(const bfx8*)(fb + 16 * 1024), vb, accO);
#pragma unroll
        for (int t = 0; t < 4; ++t) { S[t] = S[t] * dec; S[t] = MFMA32(*(const bfx8*)(fb + (17 + t) * 1024), vb, S[t]); }
#pragma unroll
        for (int r = 0; r < 4; ++r) {
            float sq = accO[r] * accO[r];
#pragma unroll
            for (int o = 1; o < 32; o <<= 1) sq += shfl_xor_l(sq, o, lane);
            if (l31 == 0) xch[(4 * hh + r) * 4 + s] = sq;
        }
    }
    __syncthreads();
    if (active) {
#pragma unroll
        for (int r = 0; r < 4; ++r) {
            const int tok = 4 * hh + r;
            const float sq = (xch[tok * 4] + xch[tok * 4 + 1]) + (xch[tok * 4 + 2] + xch[tok * 4 + 3]);
            bf16* gp = proj + ((size_t)TP + (size_t)b * DSEQ + tok) * NPROJ + 3072 + h * 128 + 32 * s + l31;
            const float z = bf2f(*gp);
            *(gp - 3072) = f2bf(accO[r] * rsqrtf(sq * (1.f / 128.f) + EPS) * dn_norm_w[32 * s + l31] * silu_f(z));
        }
        float* so = out + O_DN_S + (size_t)(b * 4 + h) * 16384;
#pragma unroll
        for (int t = 0; t < 4; ++t)
#pragma unroll
            for (int r = 0; r < 16; ++r) so[(unsigned)((32 * t + crow(r, hh)) * 128 + 32 * s + l31)] = S[t][r];
    }
    __syncthreads();
}

constexpr int TAIL_STRIDE = 68;
template <class Epi>
__device__ __forceinline__ void tail_gemm(const Frame& F, const bf16* A, int lda, const bf16* Bt, int ldb, int K, int ntn, int ntiles, const Epi& E) {
    const int lane = F.lane, wave = F.wave, hh = lane >> 5, l31 = lane & 31;
    const int kw = K >> 3, nks = kw >> 4;
    LAS float* part = (LAS float*)(F.lds);
    for (int tile = blockIdx.x; tile < ntiles; tile += gridDim.x) {
        const int rg = tile / ntn, cg = tile - rg * ntn;
        f32x16 acc[2][2];
#pragma unroll
        for (int i = 0; i < 2; ++i)
#pragma unroll
            for (int j = 0; j < 2; ++j)
#pragma unroll
                for (int r = 0; r < 16; ++r) acc[i][j][r] = 0.f;
        const bf16* ap = A + (size_t)(rg * 64 + l31) * lda + wave * kw + 8 * hh;
        const bf16* bp = Bt + (size_t)(cg * 64 + l31) * ldb + wave * kw + 8 * hh;
        for (int ks0 = 0; ks0 < nks; ks0 += 4) {
            bfx8 a[4][2], b[4][2];
#pragma unroll
            for (int i = 0; i < 4; ++i) if (ks0 + i < nks) {
                a[i][0] = *(const bfx8*)(ap + (ks0 + i) * 16); a[i][1] = *(const bfx8*)(ap + (size_t)32 * lda + (ks0 + i) * 16);
                b[i][0] = *(const bfx8*)(bp + (ks0 + i) * 16); b[i][1] = *(const bfx8*)(bp + (size_t)32 * ldb + (ks0 + i) * 16); }
#pragma unroll
            for (int i = 0; i < 4; ++i) if (ks0 + i < nks) {
#pragma unroll
                for (int rt = 0; rt < 2; ++rt)
#pragma unroll
                    for (int ct = 0; ct < 2; ++ct) acc[rt][ct] = MFMA32(a[i][rt], b[i][ct], acc[rt][ct]); }
        }
        LAS float* pw = part + wave * 64 * TAIL_STRIDE;
#pragma unroll
        for (int rt = 0; rt < 2; ++rt)
#pragma unroll
            for (int ct = 0; ct < 2; ++ct)
#pragma unroll
                for (int r = 0; r < 16; ++r) pw[(rt * 32 + crow(r, hh)) * TAIL_STRIDE + ct * 32 + l31] = acc[rt][ct][r];
        lds_barrier();
        const int row = F.tid >> 3, c0 = (F.tid & 7) * 8;
        f32x4 v0 = {0.f, 0.f, 0.f, 0.f}, v1 = v0;
#pragma unroll
        for (int w = 0; w < 8; ++w) { const LAS float* p = part + (w * 64 + row) * TAIL_STRIDE + c0; v0 += *(const LAS f32x4*)p; v1 += *(const LAS f32x4*)(p + 4); }
        E(F, rg * 64 + row, cg * 64 + c0, v0, v1);
        lds_barrier();
    }
}
struct TailStore { bf16* O; int ldc;
    __device__ __forceinline__ void operator()(const Frame& F, int row, int col, f32x4 v0, f32x4 v1) const {
        v4u w; w.x = pk2(v0[0], v0[1]); w.y = pk2(v0[2], v0[3]); w.z = pk2(v1[0], v1[1]); w.w = pk2(v1[2], v1[3]);
        *(v4u*)(O + (size_t)row * ldc + col) = w; } };
struct TailResidN { float* hf; const float* base; bf16* hb; float* ssq;
    __device__ __forceinline__ void operator()(const Frame& F, int row, int col, f32x4 v0, f32x4 v1) const {
        const float* bp = (base ? base : hf) + (size_t)row * 1024 + col;
        v0 += *(const f32x4*)bp; v1 += *(const f32x4*)(bp + 4);
        float* op = hf + (size_t)row * 1024 + col; *(f32x4*)op = v0; *(f32x4*)(op + 4) = v1;
        v4u w; w.x = pk2(v0[0], v0[1]); w.y = pk2(v0[2], v0[3]); w.z = pk2(v1[0], v1[1]); w.w = pk2(v1[2], v1[3]);
        *(v4u*)(hb + (size_t)row * 1024 + col) = w;
        float s = ((v0[0] * v0[0] + v0[1] * v0[1]) + (v0[2] * v0[2] + v0[3] * v0[3])) + ((v1[0] * v1[0] + v1[1] * v1[1]) + (v1[2] * v1[2] + v1[3] * v1[3]));
        s += __shfl_xor(s, 1); s += __shfl_xor(s, 2); s += __shfl_xor(s, 4);
        if ((F.lane & 7) == 0) ssq[(size_t)row * 16 + (col >> 6)] = s; } };
struct TailPle { float* hf; const bf16* pe; const float* ssq_in; float* ssq_out;
    __device__ __forceinline__ void operator()(const Frame& F, int row, int col, f32x4 v0, f32x4 v1) const {
        const int j = F.lane & 7;
        float t = ssq_in[(size_t)row * 16 + 2 * j] + ssq_in[(size_t)row * 16 + 2 * j + 1];
        t += __shfl_xor(t, 1); t += __shfl_xor(t, 2); t += __shfl_xor(t, 4);
        const float rs = rsqrtf(t * (1.f / 1024.f) + EPS);
        float* op = hf + (size_t)row * 1024 + col; const f32x4 h0 = *(const f32x4*)op, h1 = *(const f32x4*)(op + 4);
        float p[8]; bf8_to_f32(*(const v4u*)(pe + (size_t)row * 1024 + col), p);
        f32x4 o0, o1;
#pragma unroll
        for (int e = 0; e < 4; ++e) { o0[e] = h0[e] + p[e] * sigmoid_f(v0[e] * rs); o1[e] = h1[e] + p[4 + e] * sigmoid_f(v1[e] * rs); }
        *(f32x4*)op = o0; *(f32x4*)(op + 4) = o1;
        float s = ((o0[0] * o0[0] + o0[1] * o0[1]) + (o0[2] * o0[2] + o0[3] * o0[3])) + ((o1[0] * o1[0] + o1[1] * o1[1]) + (o1[2] * o1[2] + o1[3] * o1[3]));
        s += __shfl_xor(s, 1); s += __shfl_xor(s, 2); s += __shfl_xor(s, 4);
        if (j == 0) ssq_out[(size_t)row * 16 + (col >> 6)] = s; } };
constexpr int N_PHASES = 10;
#ifndef DN_CHUNKED
#define DN_CHUNKED 0
#endif
__global__ void __launch_bounds__(NWAVES * 64, 2) mk_fwd(Args args) {
    extern __shared__ __attribute__((aligned(16))) unsigned char lds[];
    Frame F;
    F.lds = (LAS unsigned char*)lds;
    F.MISC = (volatile LAS unsigned*)(F.lds + MISC_OFF);
    F.tid = threadIdx.x; F.lane = F.tid & 63; F.wave = __builtin_amdgcn_readfirstlane(F.tid >> 6);
    F.G = gridDim.x;
    { const int bx = blockIdx.x; const int vcu = (F.G % 8 == 0) ? (bx % 8) * (F.G / 8) + bx / 8 : bx; F.gw = vcu * NWAVES + F.wave; F.NGW = F.G * NWAVES; }
    F.ctl = (gu32*)(args.dws + WS_CTL);
    for (int u = F.tid; u < (LDS_BYTES - LDSCTL_OFF) / 4; u += NWAVES * 64) ((LAS unsigned*)(F.lds + LDSCTL_OFF))[u] = 0u;
    __syncthreads();
    XcdBarrier bar = xcd_barrier_post((unsigned*)(F.ctl + CW_BAR) + args.li * XCD_BAR_WORDS, F.MISC + 8);
    const int lo = args.ph_lo, hi = args.ph_hi;
#define IN(k) (lo <= (k) && (k) < hi)
#define SEAM(k) do { if (IN(k) && IN((k) + 1)) xcd_barrier(bar); } while (0)
#define out (args.dout)
#define hf (args.dout + O_Y)
#define ws (args.dws)
#define nbuf ((bf16*)(args.dws + WS_NBUF))
#define big ((bf16*)(args.dws + WS_BIG))
#define act ((bf16*)(args.dws + WS_ACT))
#define Wt_in ((bf16*)(args.dws + WS_WIN))
#define Wt_out ((bf16*)(args.dws + WS_WOUT))
#define Wt_up ((bf16*)(args.dws + WS_WUP))
#define Wt_down ((bf16*)(args.dws + WS_WDOWN))
#define Wt_gate ((bf16*)(args.dws + WS_WGATE))
#define Wt_ple ((bf16*)(args.dws + WS_WPLE))
#define gb ((float*)(args.dws + WS_GB))
#define trig ((float2*)(args.dws + WS_TRIG))
#define pe ((bf16*)(args.dws + WS_PE))
#define pb ((bf16*)(args.dws + WS_PB))
#define fr_ret_p ((unsigned char*)(args.dout + O_Y))
#define fr_ret_s (fr_ret_p + (size_t)1024 * RET_FRAG_P)
    constexpr int DN_SPLIT = 480;
#define fr_dn_lo (args.dws + WS_NBUF)
#define fr_dn_hi (args.dws + WS_FRHI)
#define fr_dn_s (fr_dn_hi + (size_t)(1024 - DN_SPLIT) * DN_FRAG_P)
#define glast_p ((float*)(args.dws + WS_GLAST))
#define glast_s (glast_p + 1024)
#define ssqa ((float*)(args.dws + WS_SSQA))
#define ssqb ((float*)(args.dws + WS_SSQB))
#define RTBL ((LAS float*)(F.lds + RING_BYTES))
#define usb ((bf16*)(args.dws + WS_US))
#define ubb ((float*)(args.dws + WS_UB))
    using pg8::Gemm; using pg8::StaticOrder; using pg8::EpiStore; using pg8::EpiResid; using pg8::EpiPle; using pg8::EpiResidN; using pg8::EpiScaleStore; using pg8::EpiPleN; using pg8::EpiFfnAct;
    const int bx = blockIdx.x;

    if (IN(0)) {
        trig_phase(F, trig);
        LAS float* scr = (LAS float*)(F.lds + RING_OFF + F.wave * 16384);
        constexpr int I_IN = 16 * 128, I_OUT = 16 * 32;
        for (int rp_ = 0; rp_ < ((args.pad & 1) ? 2 : 1); ++rp_)
        for (int it = F.gw; it < I_IN + I_OUT; it += F.NGW) {
            int r = it;
            if (r < I_IN) { const int kb = r / 128, nb = r % 128; transpose_item(args.in[I_WIN], 4104, proj_orig_col(32 * nb), D, Wt_in, 32 * nb, 64 * kb, scr, F.lane, nullptr); continue; } r -= I_IN;
            { const int kb = r / 32, nb = r % 32; transpose_item(args.in[I_WOUT], D, 32 * nb, D, Wt_out, 32 * nb, 64 * kb, scr, F.lane, nullptr); }
        }
        __syncthreads();
        for (int rp_ = 0; rp_ < ((args.pad & 2) ? 2 : 1); ++rp_)
        rows_norm_phase<0>(F, args.in[I_XP], args.in[I_XS], args.in[I_ATTN_NW], nbuf, args.in[I_WIN], args.in[I_ALOG], args.in[I_DTB], gb, (LAS float*)(F.lds + RING_OFF));
    }
    SEAM(0);
    if (IN(1)) {
        Gemm g{nbuf, Wt_in, TP, NPROJ, D, D, D}; StaticOrder S; S.init(TP, NPROJ, F.G, bx);
        EpiStore E{big, NPROJ};
        pg8::gemm_phase<EpiStore, StaticOrder, true, true>(F.lds + RING_OFF, g, S, E);
        tail_gemm(F, nbuf + (size_t)TP * D, D, Wt_in, D, D, NPROJ / 64, 16 * (NPROJ / 64), TailStore{big + (size_t)TP * NPROJ, NPROJ});
    }
    SEAM(1);
    if (IN(2)) {
        for (int rp_ = 0; rp_ < ((args.pad & 4) ? 2 : 1); ++rp_)
        for (int it = bx; it < 1024; it += F.G) { const int bh = it >> 5, c = it & 31;
            dn_prep_item<64>(F, true, bh >> 2, bh & 3, c, big, gb, args.in[I_DN_CONVW], args.in[I_ST_CONV],
                             it < DN_SPLIT ? fr_dn_lo + (size_t)it * DN_FRAG_P : fr_dn_hi + (size_t)(it - DN_SPLIT) * DN_FRAG_P, glast_p + it, out); }
        for (int rp_ = 0; rp_ < ((args.pad & 8) ? 2 : 1); ++rp_)
        for (int it = bx; it < 1024; it += F.G) { const int bh = it >> 5, c = it & 31; ret_prep_item<64>(F, true, bh >> 2, bh & 3, c, big, trig, fr_ret_p + (size_t)it * RET_FRAG_P); }
        for (int rp_ = 0; rp_ < ((args.pad & 16) ? 2 : 1); ++rp_)
        for (int it = bx; it < 512; it += F.G) dn_prep_item<8>(F, false, it >> 2, it & 3, 0, big, gb, args.in[I_DN_CONVW], args.in[I_ST_CONV], fr_dn_s + (size_t)it * DN_FRAG_S, glast_s + it, out);
        for (int rp_ = 0; rp_ < ((args.pad & 32) ? 2 : 1); ++rp_)
        for (int it = bx; it < 512; it += F.G) ret_prep_item<8>(F, false, it >> 2, it & 3, 0, big, trig, fr_ret_s + (size_t)it * RET_FRAG_S);
    }
    SEAM(2);
    if (IN(3)) {
        if (bx < 32) dn_stream(F, bx >> 2, bx & 3, fr_dn_lo, fr_dn_hi, DN_SPLIT, glast_p, big, args.in[I_DN_NW], out);
        else if (bx < 64) ret_stream(F, (bx - 32) >> 2, bx & 3, fr_ret_p + (size_t)(bx - 32) * 32 * RET_FRAG_P, big, args.in[I_RET_NW], out);
        else {
            const int tm = (bx - 64) * 2 + (F.wave >> 2);
#pragma unroll 1
            for (int k = 0; k < 3; ++k) {
                const int idx = tm + 384 * k;
                if (idx < 512) dn_sample_item(F, true, idx >> 2, idx & 3, fr_dn_s + (size_t)idx * DN_FRAG_S, glast_s[idx], big, args.in[I_DN_NW], args.in[I_ST_DN], out);
                else { const int it = idx - 512; const bool active = it < 512;
                    ret_sample_item(F, active, it >> 2, it & 3, fr_ret_s + (size_t)(active ? it : 0) * RET_FRAG_S, big, args.in[I_RET_NW], args.in[I_ST_RET], out); }
            }
            {
                __syncthreads();
                int ln = F.lane; asm volatile("" : "+v"(ln));
                LAS float* scr = (LAS float*)(F.lds + RING_OFF + F.wave * 16384);
                constexpr int I_UP = 16 * 176, I_DOWN = 44 * 32, I_GATE = 16 * 32, I_PLEI = 4 * 32;
                const int gw3 = (bx - 64) * NWAVES + F.wave, ngw3 = (F.G - 64) * NWAVES;
                for (int it = gw3; it < I_UP + I_DOWN + I_GATE + I_PLEI; it += ngw3) {
                    int r = it;
                    if (r < I_UP) { const int kb = r / 176, nb = r % 176; transpose_item(args.in[I_WUP], NUP, up_orig_col(32 * nb), D, Wt_up, 32 * nb, 64 * kb, scr, ln, args.in[I_FFN_NW]); continue; } r -= I_UP;
                    if (r < I_DOWN) { const int kb = r / 32, nb = r % 32; transpose_item(args.in[I_WDOWN], D, 32 * nb, DFF, Wt_down, 32 * nb, 64 * kb, scr, ln, nullptr); continue; } r -= I_DOWN;
                    if (r < I_GATE) { const int kb = r / 32, nb = r % 32; transpose_item(args.in[I_WGATE], D, 32 * nb, D, Wt_gate, 32 * nb, 64 * kb, scr, ln, args.in[I_PLE_NW]); continue; } r -= I_GATE;
                    { const int kb = r / 32, nb = r % 32; transpose_item(args.in[I_WPLE], D, 32 * nb, PLE, Wt_ple, 32 * nb, 64 * kb, scr, ln, nullptr); }
                }
            }
        }
    }
    SEAM(3);
    if (IN(4)) {
        Gemm g{big, Wt_out, TP, D, D, NPROJ, D}; StaticOrder S; S.init(TP, D, F.G, bx);
        EpiResidN E{hf, args.in[I_XP], args.in[I_XS], nbuf, ssqa};
        pg8::gemm_phase<EpiResidN, StaticOrder, true, true>(F.lds + RING_OFF, g, S, E);
        tail_gemm(F, big + (size_t)TP * NPROJ, NPROJ, Wt_out, D, D, 16, 256, TailResidN{hf + (size_t)TP * D, args.in[I_XS], nbuf + (size_t)TP * D, ssqa + (size_t)TP * 16});
        const float* pp = args.in[I_PP]; const float* ps = args.in[I_PS];
        const size_t n4 = (size_t)T * PLE / 4, np4 = (size_t)TP * PLE / 4;
        for (size_t i = (size_t)bx * 512 + F.tid; i < n4; i += (size_t)F.G * 512) {
            const f32x4 v = i < np4 ? ((const f32x4*)pp)[i] : ((const f32x4*)ps)[i - np4];
            uint2 o; o.x = pk2(v[0], v[1]); o.y = pk2(v[2], v[3]); ((uint2*)pb)[i] = o;
        }
    }
    SEAM(4);
    if (IN(5)) {
        Gemm g{nbuf, Wt_up, T, NUP, D, D, D}; StaticOrder S; S.init(T, NUP, F.G, bx);
        build_rstd_tables(F, S, ssqa, 0, RTBL);
        EpiFfnAct E{act, usb, ubb, args.in[I_FFN_CW], args.in[I_FFN_CB], RTBL};
        pg8::gemm_phase<EpiFfnAct, StaticOrder, true, true>(F.lds + RING_OFF, g, S, E);
    }
    SEAM(5);
    if (IN(6)) {
        ffn_fixup_phase(F, ubb, args.in[I_FFN_CW], args.in[I_FFN_CB], act, out);
        act_phase(F, usb, TP, TS, args.in[I_FFN_CW], args.in[I_FFN_CB], args.in[I_ST_FFN], act, out);
        Gemm g{pb, Wt_ple, TP, D, PLE, PLE, PLE}; StaticOrder S; S.init(TP, D, F.G, bx);
        EpiStore E{pe, D};
        pg8::gemm_phase<EpiStore, StaticOrder, true, true>(F.lds + RING_OFF, g, S, E);
        tail_gemm(F, pb + (size_t)TP * PLE, PLE, Wt_ple, PLE, PLE, 16, 256, TailStore{pe + (size_t)TP * D, D});
    }
    SEAM(6);
    if (IN(7)) {
        Gemm g{act, Wt_down, TP, D, DFF, DFF, DFF}; StaticOrder S; S.init(TP, D, F.G, bx);
        EpiResidN E{hf, nullptr, nullptr, nbuf, ssqb};
        pg8::gemm_phase<EpiResidN, StaticOrder, true, true>(F.lds + RING_OFF, g, S, E);
        tail_gemm(F, act + (size_t)TP * DFF, DFF, Wt_down, DFF, DFF, 16, 256, TailResidN{hf + (size_t)TP * D, nullptr, nbuf + (size_t)TP * D, ssqb + (size_t)TP * 16});
    }
    SEAM(7);
    if (IN(8)) {
        Gemm g{nbuf, Wt_gate, TP, D, D, D, D}; StaticOrder S; S.init(TP, D, F.G, bx);
        build_rstd_tables(F, S, ssqb, 0, RTBL);
        EpiPleN E{hf, pe, RTBL, ssqa};
        pg8::gemm_phase<EpiPleN, StaticOrder, true, true>(F.lds + RING_OFF, g, S, E);
        tail_gemm(F, nbuf + (size_t)TP * D, D, Wt_gate, D, D, 16, 256, TailPle{hf + (size_t)TP * D, pe + (size_t)TP * D, ssqb + (size_t)TP * 16, ssqa + (size_t)TP * 16});
    }
    SEAM(8);
    if (IN(9)) final_norm_phase2(F, hf, ssqa, args.in[I_FINAL_NW]);
#undef IN
#undef SEAM
#undef out
#undef hf
#undef ws
#undef nbuf
#undef big
#undef act
#undef Wt_in
#undef Wt_out
#undef Wt_up
#undef Wt_down
#undef Wt_gate
#undef Wt_ple
#undef gb
#undef trig
#undef pe
#undef pb
#undef fr_ret_p
#undef fr_ret_s
#undef fr_dn_lo
#undef fr_dn_hi
#undef fr_dn_s
#undef glast_p
#undef glast_s
#undef ssqa
#undef ssqb
#undef RTBL
#undef usb
#undef ubb
}

extern "C" void kernel_launch(void* const* d_in, const int* in_sizes, int n_in, void* d_out, int out_size, void* d_ws, size_t ws_size, hipStream_t stream) {
    static int grid = 0;
    if (grid == 0) {
        int dev = 0, cus = 0;
        if (n_in != 25 || ws_size < WS_END) { fprintf(stderr, "kernel_launch: unexpected n_in %d / ws_size %zu\n", n_in, ws_size); grid = -1; return; }
        if (hipGetDevice(&dev) != hipSuccess || hipDeviceGetAttribute(&cus, hipDeviceAttributeMultiprocessorCount, dev) != hipSuccess) { grid = -1; return; }
        if (hipFuncSetAttribute((const void*)mk_fwd, hipFuncAttributeMaxDynamicSharedMemorySize, LDS_BYTES) != hipSuccess) { fprintf(stderr, "kernel_launch: hipFuncSetAttribute failed\n"); grid = -1; return; }
        (void)hipGetLastError();
        grid = cus;
    }
    if (grid < 0) return;
    (void)hipMemsetAsync((char*)d_ws + WS_CTL, 0, CTL_ZERO_BYTES, stream);
    Args a{};
    for (int i = 0; i < 25; ++i) a.in[i] = (const float*)d_in[i];
    a.dout = (float*)d_out; a.dws = (unsigned char*)d_ws;
#ifndef PROBE_PAD
#define PROBE_PAD 0
#endif
    a.pad = PROBE_PAD;
    a.ph_lo = 0; a.ph_hi = N_PHASES; a.li = 0;
    hipLaunchKernelGGL(mk_fwd, dim3(grid), dim3(NWAVES * 64), LDS_BYTES, stream, a);
}
```
